# Optimizing an MI355X kernel written in HIP

```python
import math
import jax, jax.numpy as jnp
from jax import lax
import numpy as np

D_MODEL = 2048
BATCH = 4
SEQ = 2048
DEPTH = 1
DEC_BATCH = 128
DEC_SEQ = 1
PAST_LEN = 16384
PAGE_SIZE = 128

RET_WIDTH = 1024
RET_HEADS = 8
RET_DK = RET_WIDTH // RET_HEADS
RET_DV = RET_WIDTH // RET_HEADS
RET_CHUNK = 128
ROPE_BASE = 10000.0
S5_WIDTH = 1024
S5_GROUP = 16
S5_GROUPS = S5_WIDTH // S5_GROUP
S5_P = 64
S5_CHUNK = 128
DT_MIN = 1e-3
DT_MAX = 1e-1
EPS = 1e-6
IN_COLS = 4 * RET_WIDTH + 2 * S5_WIDTH + 2 * D_MODEL

kernel_name = 'hybrid_retention_s5_gated_step'

F32 = jnp.float32


def rmsnorm(x, g):
    xf = x.astype(F32)
    y = xf * lax.rsqrt(jnp.mean(xf * xf, axis=-1, keepdims=True) + EPS) * g.astype(F32)
    return y.astype(x.dtype)


def rope(x, pos):
    half = x.shape[-1] // 2
    inv = ROPE_BASE ** (-jnp.arange(half, dtype=F32) / half)
    ang = pos.astype(F32)[:, None] * inv[None, :]
    cos = jnp.cos(ang)[None, :, None, :]
    sin = jnp.sin(ang)[None, :, None, :]
    x1, x2 = x[..., :half], x[..., half:]
    return jnp.concatenate([x1 * cos - x2 * sin, x1 * sin + x2 * cos], axis=-1)


def ret_log_gamma():
    return jnp.log(1.0 - 2.0 ** (-5.0 - jnp.arange(RET_HEADS, dtype=F32)))


def retention_chunk(q, k, v, s0, lg):
    c = q.shape[2]
    idx = jnp.arange(c, dtype=F32)
    diff = idx[:, None] - idx[None, :]
    mask = jnp.where(diff[None] >= 0, jnp.exp(jnp.maximum(diff, 0.0)[None] * lg[:, None, None]), 0.0)
    scores = jnp.einsum('bhqd,bhkd->bhqk', q, k) * mask[None]
    inner = jnp.einsum('bhqk,bhkv->bhqv', scores, v)
    q_dec = q * jnp.exp((idx[None, :] + 1.0) * lg[:, None])[None, :, :, None]
    cross = jnp.einsum('bhqd,bhdv->bhqv', q_dec, s0)
    k_dec = k * jnp.exp((c - 1.0 - idx[None, :]) * lg[:, None])[None, :, :, None]
    s_new = jnp.exp(c * lg)[None, :, None, None] * s0 + jnp.einsum('bhkd,bhkv->bhdv', k_dec, v)
    return inner + cross, s_new


def retention(q, k, v, pos, s0):
    bn, L, _ = q.shape
    q = rope(q.reshape(bn, L, RET_HEADS, RET_DK).astype(F32), pos)
    k = rope(k.reshape(bn, L, RET_HEADS, RET_DK).astype(F32), pos) * (RET_DK ** -0.5)
    v = v.reshape(bn, L, RET_HEADS, RET_DV).astype(F32)
    lg = ret_log_gamma()
    c = RET_CHUNK if L % RET_CHUNK == 0 else L
    nc = L // c

    def to_chunks(t):
        return t.reshape(bn, nc, c, RET_HEADS, t.shape[-1]).transpose(1, 0, 3, 2, 4)

    def step(s, qkv):
        qc, kc, vc = qkv
        o, s = retention_chunk(qc, kc, vc, s, lg)
        return s, o

    s_fin, o = lax.scan(step, s0.astype(F32), (to_chunks(q), to_chunks(k), to_chunks(v)))
    o = o.transpose(1, 0, 3, 2, 4).reshape(bn, L, RET_HEADS, RET_DV)
    mu = jnp.mean(o, axis=-1, keepdims=True)
    var = jnp.mean(jnp.square(o - mu), axis=-1, keepdims=True)
    o = (o - mu) * lax.rsqrt(var + EPS)
    return o.reshape(bn, L, RET_WIDTH), s_fin


def s5_combine(e1, e2):
    a1r, a1i, b1r, b1i = e1
    a2r, a2i, b2r, b2i = e2
    ar = a1r * a2r - a1i * a2i
    ai = a1r * a2i + a1i * a2r
    br = a2r * b1r - a2i * b1i + b2r
    bi = a2r * b1i + a2i * b1r + b2i
    return ar, ai, br, bi


def s5(u, x0r, x0i, lam_re, lam_im, log_dt, b_re, b_im, c_re, c_im, d_skip, w_glu, b_glu):
    bn, L, _ = u.shape
    u = u.reshape(bn, L, S5_GROUPS, S5_GROUP).astype(F32)
    lr, li = lam_re.astype(F32), lam_im.astype(F32)
    dt = jnp.exp(log_dt.astype(F32))[:, None]
    mag = jnp.exp(lr * dt)
    abar_r = mag * jnp.cos(li * dt)
    abar_i = mag * jnp.sin(li * dt)
    nr, ni = abar_r - 1.0, abar_i
    den = lr * lr + li * li
    coef_r = (nr * lr + ni * li) / den
    coef_i = (ni * lr - nr * li) / den
    br, bi = b_re.astype(F32), b_im.astype(F32)
    bbar_r = coef_r[:, :, None] * br - coef_i[:, :, None] * bi
    bbar_i = coef_r[:, :, None] * bi + coef_i[:, :, None] * br
    cr, ci = c_re.astype(F32), c_im.astype(F32)
    dsk = d_skip.astype(F32)
    c = S5_CHUNK if L % S5_CHUNK == 0 else L
    nc = L // c
    uc = u.reshape(bn, nc, c, S5_GROUPS, S5_GROUP).transpose(1, 0, 2, 3, 4)

    def step(carry, u_c):
        xr0, xi0 = carry
        bur = jnp.einsum('gpn,bcgn->bcgp', bbar_r, u_c)
        bui = jnp.einsum('gpn,bcgn->bcgp', bbar_i, u_c)
        ar = jnp.broadcast_to(abar_r, bur.shape)
        ai = jnp.broadcast_to(abar_i, bur.shape)
        A_r, A_i, X_r, X_i = lax.associative_scan(s5_combine, (ar, ai, bur, bui), axis=1)
        xr = X_r + A_r * xr0[:, None] - A_i * xi0[:, None]
        xi = X_i + A_r * xi0[:, None] + A_i * xr0[:, None]
        y = (jnp.einsum('gnp,bcgp->bcgn', cr, xr) - jnp.einsum('gnp,bcgp->bcgn', ci, xi)
             + dsk[None, None] * u_c)
        return (xr[:, -1], xi[:, -1]), y

    (sr, si), y = lax.scan(step, (x0r.astype(F32), x0i.astype(F32)), uc)
    y = y.transpose(1, 0, 2, 3, 4).reshape(bn, L, S5_WIDTH)
    y = jax.nn.gelu(y)
    y = y * jax.nn.sigmoid(y @ w_glu.astype(F32) + b_glu.astype(F32))
    return y, sr, si


def layer(x, pos, s_ret, s_re, s_im, g_pre, w_in, w_pa, w_pb, w_out, g_post,
          lam_re, lam_im, log_dt, b_re, b_im, c_re, c_im, d_skip, w_glu, b_glu):
    h = rmsnorm(x, g_pre)
    proj = h @ w_in
    splits = np.cumsum([RET_WIDTH, RET_WIDTH, RET_WIDTH, RET_WIDTH, S5_WIDTH, S5_WIDTH, D_MODEL]).tolist()
    q, k, v, za, ub, zb, ga, gb = jnp.split(proj, splits, axis=-1)
    ya, s_ret_new = retention(q, k, v, pos, s_ret)
    ya = (ya * jax.nn.silu(za.astype(F32))).astype(x.dtype) @ w_pa
    yb, s_re_new, s_im_new = s5(ub, s_re, s_im, lam_re, lam_im, log_dt, b_re, b_im, c_re, c_im, d_skip, w_glu, b_glu)
    yb = (yb * jax.nn.silu(zb.astype(F32))).astype(x.dtype) @ w_pb
    merged = jax.nn.sigmoid(ga) * ya + jax.nn.sigmoid(gb) * yb
    out = merged @ w_out
    return x + rmsnorm(out, g_post), s_ret_new, s_re_new, s_im_new


def setup_inputs(seed: int = 0) -> dict:
    key = jax.random.key(seed)
    ks = jax.random.split(key, 24)
    nrm = jax.random.normal
    n = jnp.arange(S5_P, dtype=F32)
    return {
        'x_prompt': nrm(ks[0], (BATCH, SEQ, D_MODEL), F32),
        'x_sample': nrm(ks[1], (DEC_BATCH, DEC_SEQ, D_MODEL), F32),
        'state_ret': 0.5 * nrm(ks[2], (DEPTH, DEC_BATCH, RET_HEADS, RET_DK, RET_DV), F32),
        'state_s5_re': 0.1 * nrm(ks[3], (DEPTH, DEC_BATCH, S5_GROUPS, S5_P), F32),
        'state_s5_im': 0.1 * nrm(ks[4], (DEPTH, DEC_BATCH, S5_GROUPS, S5_P), F32),
        'g_pre': 1.0 + 0.05 * nrm(ks[5], (DEPTH, D_MODEL), F32),
        'w_in': nrm(ks[6], (DEPTH, D_MODEL, IN_COLS), F32) * D_MODEL ** -0.5,
        'w_pa': nrm(ks[7], (DEPTH, RET_WIDTH, D_MODEL), F32) * RET_WIDTH ** -0.5,
        'w_pb': nrm(ks[8], (DEPTH, S5_WIDTH, D_MODEL), F32) * S5_WIDTH ** -0.5,
        'w_out': nrm(ks[9], (DEPTH, D_MODEL, D_MODEL), F32) * D_MODEL ** -0.5,
        'g_post': 1.0 + 0.05 * nrm(ks[10], (DEPTH, D_MODEL), F32),
        's5_lam_re': -0.5 + 0.01 * nrm(ks[11], (DEPTH, S5_GROUPS, S5_P), F32),
        's5_lam_im': math.pi * n + 0.01 * nrm(ks[12], (DEPTH, S5_GROUPS, S5_P), F32),
        's5_log_dt': jax.random.uniform(ks[13], (DEPTH, S5_GROUPS), F32, math.log(DT_MIN), math.log(DT_MAX)),
        's5_b_re': nrm(ks[14], (DEPTH, S5_GROUPS, S5_P, S5_GROUP), F32) * (2 * S5_GROUP) ** -0.5,
        's5_b_im': nrm(ks[15], (DEPTH, S5_GROUPS, S5_P, S5_GROUP), F32) * (2 * S5_GROUP) ** -0.5,
        's5_c_re': nrm(ks[16], (DEPTH, S5_GROUPS, S5_GROUP, S5_P), F32) * S5_P ** -0.5,
        's5_c_im': nrm(ks[17], (DEPTH, S5_GROUPS, S5_GROUP, S5_P), F32) * S5_P ** -0.5,
        's5_d': nrm(ks[18], (DEPTH, S5_GROUPS, S5_GROUP), F32),
        's5_w_glu': nrm(ks[19], (DEPTH, S5_WIDTH, S5_WIDTH), F32) * S5_WIDTH ** -0.5,
        's5_b_glu': 0.01 * nrm(ks[20], (DEPTH, S5_WIDTH), F32),
    }


def reference(x_prompt, x_sample, state_ret, state_s5_re, state_s5_im, g_pre, w_in, w_pa, w_pb, w_out, g_post,
              s5_lam_re, s5_lam_im, s5_log_dt, s5_b_re, s5_b_im, s5_c_re, s5_c_im, s5_d, s5_w_glu, s5_b_glu):
    bp, lp, _ = x_prompt.shape
    ds = x_sample.shape[1]
    pos_p = jnp.arange(lp, dtype=jnp.int32)
    pos_s = PAST_LEN + jnp.arange(ds, dtype=jnp.int32)
    hp, hs = x_prompt, x_sample
    rp, rep, imp, rs, res, ims = [], [], [], [], [], []
    for l in range(DEPTH):
        w = (g_pre[l], w_in[l], w_pa[l], w_pb[l], w_out[l], g_post[l], s5_lam_re[l], s5_lam_im[l], s5_log_dt[l],
             s5_b_re[l], s5_b_im[l], s5_c_re[l], s5_c_im[l], s5_d[l], s5_w_glu[l], s5_b_glu[l])
        zr = jnp.zeros((bp, RET_HEADS, RET_DK, RET_DV), F32)
        zs = jnp.zeros((bp, S5_GROUPS, S5_P), F32)
        hp, a, b, c = layer(hp, pos_p, zr, zs, zs, *w)
        rp.append(a); rep.append(b); imp.append(c)
        hs, a, b, c = layer(hs, pos_s, state_ret[l], state_s5_re[l], state_s5_im[l], *w)
        rs.append(a); res.append(b); ims.append(c)
    return (hp, hs, jnp.stack(rp), jnp.stack(rep), jnp.stack(imp), jnp.stack(rs), jnp.stack(res), jnp.stack(ims))
```

```cpp
#include <hip/hip_runtime.h>
#include <cstdio>
#include <cstdint>

#ifndef MK_N_LAUNCHES
#define MK_N_LAUNCHES 7
#endif
#ifndef PROBE_SEQ
#define PROBE_SEQ 0, 1, 2, 130, 130, 130, 3, 4, 5, 6
#endif
#ifndef REP_PHASE
#define REP_PHASE -1
#endif

namespace pg8 {
#define PG8_LAS __attribute__((address_space(3)))
typedef unsigned short bf16_t;
typedef short bf16x8 __attribute__((ext_vector_type(8)));
typedef float f32x4 __attribute__((ext_vector_type(4)));
typedef float f32x2 __attribute__((ext_vector_type(2)));
typedef unsigned u32x4 __attribute__((ext_vector_type(4)));
typedef unsigned u32x2 __attribute__((ext_vector_type(2)));
constexpr int BM = 256, BK = 64, HALF = 128, HTB = HALF * BK * 2, STAGE_BYTES = 8 * HTB, NXCD = 8, WGM = 8;

__host__ __device__ __forceinline__ int lds_byte(int r, int c) { const int st = (r >> 4) * 2 + (c >> 5), rr = r & 15, cc = c & 31, ob = rr * 64 + cc * 2; return st * 1024 + (ob ^ (((ob >> 9) & 1) << 5)); }
__host__ __device__ __forceinline__ void stage_rc(int b, int& R, int& C) { const int st = b / 1024, sb = b % 1024, swz = sb ^ (((sb >> 9) & 1) << 5); R = (st >> 1) * 16 + swz / 64; C = (st & 1) * 32 + (swz % 64) / 2; }
__host__ __device__ __forceinline__ int perm32(int rho) { const int n = rho >> 4, i = rho & 15; return 8 * (i >> 2) + 4 * n + (i & 3); }

struct Unit { int pm, pn, z; };
struct Gemm { const bf16_t* A0; const bf16_t* B0; const bf16_t* A1; const bf16_t* B1; int K; };

struct StaticOrder {
    int nM, nN, nwg, G, c;
    __host__ __device__ void init(int M, int N, int G_, int c_) { nM = M / BM; nN = N / BM; nwg = nM * nN; G = G_; c = c_; }
    __host__ __device__ bool next(int i, Unit& u) const {
        const long L = (long)i * G + c; if (L >= nwg) return false;
        int wgid = (int)L; { const int q = nwg / NXCD, r = nwg % NXCD, xcd = wgid % NXCD, off = wgid / NXCD; wgid = (xcd < r ? xcd * (q + 1) : r * (q + 1) + (xcd - r) * q) + off; }
        const int nig = WGM * nN, gid = wgid / nig, fm = gid * WGM, gsz = (nM - fm) < WGM ? (nM - fm) : WGM;
        u.pm = fm + ((wgid % nig) % gsz); u.pn = (wgid % nig) / gsz; u.z = 0; return true;
    }
    __host__ __device__ int kofs(const Unit&, int) const { return 0; }
    __host__ __device__ int ktiles(const Unit&, int K) const { return K / BK; }
};
struct ProjOrder {
    StaticOrder so; int G, c;
    __host__ __device__ void init(int M, int N, int G_, int c_) { so.init(M, N, G_, c_); G = G_; c = c_; }
    __host__ __device__ bool next(int i, Unit& u) const {
        const long L = (long)i * G + c;
        if (L < so.nwg) return so.next(i, u);
        const int si = (int)(L - so.nwg); if (si >= 4 * so.nN) return false;
        u.pm = so.nM; u.pn = si % so.nN; u.z = 1 + si / so.nN; return true;
    }
    __host__ __device__ int kofs(const Unit& u, int) const { return u.z ? (u.z - 1) * 512 : 0; }
    __host__ __device__ int ktiles(const Unit& u, int K) const { return u.z ? 512 / BK : K / BK; }
};
struct PairOrder {
    int nM, nN, ntile, G, c;
    __host__ __device__ void init(int M, int N, int G_, int c_) { nM = M / BM; nN = N / BM; ntile = nM * nN; G = G_; c = c_; }
    __host__ __device__ bool next(int i, Unit& u) const {
        const long T = (long)(i >> 1) * G + c; if (T >= ntile) return false;
        u.pm = (int)(T % nM); u.pn = (int)(T / nM); u.z = i & 1; return true;
    }
    __host__ __device__ int kofs(const Unit&, int) const { return 0; }
    __host__ __device__ int ktiles(const Unit&, int K) const { return K / BK; }
};

__device__ __forceinline__ unsigned cvt_pk_bf16(float lo, float hi) { unsigned r; asm volatile("v_cvt_pk_bf16_f32 %0, %1, %2" : "=v"(r) : "v"(lo), "v"(hi)); return r; }
__device__ __forceinline__ float bf_lo(unsigned w) { return __uint_as_float(w << 16); }
__device__ __forceinline__ float bf_hi(unsigned w) { return __uint_as_float(w & 0xffff0000u); }
__device__ __forceinline__ float sigmoidf_(float x) { return __builtin_amdgcn_rcpf(1.0f + __expf(-x)); }

template <class Epi, class Sched, bool ALIGN_EPI = false, bool SP2 = false>
__device__ __forceinline__ void gemm_phase(PG8_LAS unsigned char* lds, const Gemm g, const Sched& S, const Epi& E) {
    const int tid = threadIdx.x, wid = __builtin_amdgcn_readfirstlane(tid >> 6), lane = tid & 63, wr = wid >> 2, wc = wid & 3, fr = lane & 15, fq = lane >> 4;
    const int K = g.K;
    unsigned voffA[2], voffB[2];
#pragma unroll
    for (int i = 0; i < 2; ++i) { int R, C; stage_rc(tid * 16 + i * 8192, R, C); const int Rb = Epi::PERM ? ((R & ~31) + perm32(R & 31)) : R;
        voffA[i] = (unsigned)(R * K + C) * 2u; voffB[i] = (unsigned)(Rb * K + C) * 2u; }
    const size_t kstep = (size_t)(BK * 2);
    const size_t hstep = (size_t)HALF * K * 2;
    const size_t tstep = 2 * hstep;
    const unsigned ldsw = (unsigned)wid * 1024u;
    const int aoff = lds_byte(wr * 64 + fr, fq * 8), boff = lds_byte(wc * 32 + fr, fq * 8);
#define PG8_SA(b, h) (((b) * 2 + (h)) * HTB)
#define PG8_SB(b, h) ((4 + (b) * 2 + (h)) * HTB)
#define PG8_STAGE(bufoff, gbase, voff) do { _Pragma("unroll") for (int _i = 0; _i < 2; ++_i) \
        __builtin_amdgcn_global_load_lds((const unsigned*)((const char*)(gbase) + (voff)[_i]), (PG8_LAS unsigned*)(lds + (bufoff) + ldsw + _i * 8192), 16, 0, 0); } while (0)
#define PG8_LDA(dst, b, h) do { _Pragma("unroll") for (int m = 0; m < 4; ++m) _Pragma("unroll") for (int k = 0; k < 2; ++k) dst[m][k] = *(const PG8_LAS bf16x8*)(lds + PG8_SA(b, h) + aoff + m * 2048 + k * 1024); } while (0)
#define PG8_LDB(dst, b, h) do { _Pragma("unroll") for (int n = 0; n < 2; ++n) _Pragma("unroll") for (int k = 0; k < 2; ++k) dst[n][k] = *(const PG8_LAS bf16x8*)(lds + PG8_SB(b, h) + boff + n * 2048 + k * 1024); } while (0)
#define PG8_MMA(ai, bj, At, Bt) do { __builtin_amdgcn_s_setprio(1); _Pragma("unroll") for (int m = 0; m < 4; ++m) _Pragma("unroll") for (int n = 0; n < 2; ++n) _Pragma("unroll") for (int k = 0; k < 2; ++k) \
        acc[ai][bj][m][n] = __builtin_amdgcn_mfma_f32_16x16x32_bf16(Bt[n][k], At[m][k], acc[ai][bj][m][n], 0, 0, 0); __builtin_amdgcn_s_setprio(0); } while (0)
#define PG8_WAIT_V(n) asm volatile("s_waitcnt vmcnt(" #n ")" ::: "memory")
#define PG8_WAIT_L(n) asm volatile("s_waitcnt lgkmcnt(" #n ")" ::: "memory")
#define PG8_BAR __builtin_amdgcn_s_barrier()
#define PG8_SCHED __builtin_amdgcn_sched_barrier(0)
#define PG8_PA(u) ((const char*)(((u).z && g.A1) ? g.A1 : g.A0) + (size_t)(u).pm * tstep + (size_t)S.kofs(u, K) * 2)
#define PG8_PB(u) ((const char*)(((u).z && g.B1) ? g.B1 : g.B0) + (size_t)(u).pn * tstep + (size_t)S.kofs(u, K) * 2)
    Unit cur, nxt; int ui = 0;
    if (!S.next(0, cur)) return;
    f32x4 acc[2][2][4][2];
#pragma unroll
    for (int a = 0; a < 2; ++a)
#pragma unroll
        for (int b = 0; b < 2; ++b)
#pragma unroll
            for (int m = 0; m < 4; ++m)
#pragma unroll
                for (int n = 0; n < 2; ++n) acc[a][b][m][n] = (f32x4){0.f, 0.f, 0.f, 0.f};
    bf16x8 At[4][2], B0[2][2], B1[2][2];
    const char* cA = PG8_PA(cur); const char* cB = PG8_PB(cur);
    if constexpr (SP2) {
        PG8_STAGE(PG8_SB(0, 0), cB, voffB); PG8_STAGE(PG8_SB(0, 1), cB + hstep, voffB); PG8_STAGE(PG8_SA(0, 0), cA, voffA); PG8_STAGE(PG8_SA(0, 1), cA + hstep, voffA);
        if (wr == 1) PG8_BAR;
        PG8_WAIT_V(2); PG8_BAR;
        PG8_STAGE(PG8_SB(1, 0), cB + kstep, voffB); PG8_STAGE(PG8_SA(1, 0), cA + kstep, voffA); PG8_STAGE(PG8_SB(1, 1), cB + hstep + kstep, voffB);
        PG8_WAIT_V(6); PG8_BAR;
    } else {
        PG8_STAGE(PG8_SB(0, 0), cB, voffB); PG8_STAGE(PG8_SA(0, 0), cA, voffA); PG8_STAGE(PG8_SB(0, 1), cB + hstep, voffB); PG8_STAGE(PG8_SA(0, 1), cA + hstep, voffA);
        if (wr == 1) PG8_BAR;
        PG8_WAIT_V(4); PG8_BAR;
        PG8_STAGE(PG8_SB(1, 0), cB + kstep, voffB); PG8_STAGE(PG8_SA(1, 0), cA + kstep, voffA); PG8_STAGE(PG8_SB(1, 1), cB + hstep + kstep, voffB);
        PG8_WAIT_V(6); PG8_BAR;
    }
    for (;;) {
        const bool has_next = S.next(ui + 1, nxt);
        const char* nA = has_next ? PG8_PA(nxt) : cA; const char* nB = has_next ? PG8_PB(nxt) : cB;
        const int nt = S.ktiles(cur, K);
        for (int t = 0; t < nt; t += 2) {
            if constexpr (Epi::MIDHOOK) { if (t == nt / 2) E.mid(acc, cur, wr, wc, fr, fq); }
            const bool last = (t == nt - 2);
            const char* a1 = cA + (size_t)(t + 1) * kstep;
            const char* a2 = last ? nA : cA + (size_t)(t + 2) * kstep; const char* b2 = last ? nB : cB + (size_t)(t + 2) * kstep;
            const char* a3 = a2 + kstep; const char* b3 = b2 + kstep;
            if constexpr (SP2) {
            PG8_LDB(B0, 0, 0); PG8_LDB(B1, 0, 1); PG8_SCHED; PG8_LDA(At, 0, 0); PG8_STAGE(PG8_SA(1, 1), a1 + hstep, voffA);
            PG8_WAIT_V(8); PG8_WAIT_L(0); PG8_BAR; PG8_MMA(0, 0, At, B0); PG8_MMA(0, 1, At, B1); PG8_BAR; PG8_SCHED;
            PG8_LDA(At, 0, 1); PG8_STAGE(PG8_SB(0, 0), b2, voffB); PG8_STAGE(PG8_SB(0, 1), b2 + hstep, voffB); PG8_STAGE(PG8_SA(0, 0), a2, voffA);
            PG8_WAIT_V(8); PG8_WAIT_L(0); PG8_BAR; PG8_MMA(1, 0, At, B0); PG8_MMA(1, 1, At, B1); PG8_BAR; PG8_SCHED;
            PG8_LDB(B0, 1, 0); PG8_LDB(B1, 1, 1); PG8_SCHED; PG8_LDA(At, 1, 0); PG8_STAGE(PG8_SA(0, 1), a2 + hstep, voffA);
            PG8_WAIT_V(8); PG8_WAIT_L(0); PG8_BAR; PG8_MMA(0, 0, At, B0); PG8_MMA(0, 1, At, B1); PG8_BAR; PG8_SCHED;
            PG8_LDA(At, 1, 1); PG8_STAGE(PG8_SB(1, 0), b3, voffB); PG8_STAGE(PG8_SB(1, 1), b3 + hstep, voffB); PG8_STAGE(PG8_SA(1, 0), a3, voffA);
            PG8_WAIT_V(8); PG8_WAIT_L(0); PG8_BAR; PG8_MMA(1, 0, At, B0); PG8_MMA(1, 1, At, B1); PG8_BAR; PG8_SCHED;
            } else {
            PG8_LDB(B0, 0, 0); PG8_SCHED; PG8_LDA(At, 0, 0); PG8_STAGE(PG8_SA(1, 1), a1 + hstep, voffA);
            PG8_WAIT_L(8); PG8_BAR; PG8_WAIT_L(0); PG8_MMA(0, 0, At, B0); PG8_BAR; PG8_SCHED;
            PG8_LDB(B1, 0, 1); PG8_STAGE(PG8_SB(0, 0), b2, voffB);
            PG8_BAR; PG8_WAIT_L(0); PG8_MMA(0, 1, At, B1); PG8_BAR;
            PG8_LDA(At, 0, 1); PG8_STAGE(PG8_SA(0, 0), a2, voffA);
            PG8_BAR; PG8_WAIT_L(0); PG8_MMA(1, 0, At, B0); PG8_BAR; PG8_SCHED;
            PG8_STAGE(PG8_SB(0, 1), b2 + hstep, voffB);
            PG8_WAIT_V(6); PG8_BAR; PG8_MMA(1, 1, At, B1); PG8_BAR;
            PG8_LDB(B0, 1, 0); PG8_SCHED; PG8_LDA(At, 1, 0); PG8_STAGE(PG8_SA(0, 1), a2 + hstep, voffA);
            PG8_WAIT_L(8); PG8_BAR; PG8_WAIT_L(0); PG8_MMA(0, 0, At, B0); PG8_BAR; PG8_SCHED;
            PG8_LDB(B1, 1, 1); PG8_STAGE(PG8_SB(1, 0), b3, voffB);
            PG8_BAR; PG8_WAIT_L(0); PG8_MMA(0, 1, At, B1); PG8_BAR;
            PG8_LDA(At, 1, 1); PG8_STAGE(PG8_SA(1, 0), a3, voffA);
            PG8_BAR; PG8_WAIT_L(0); PG8_MMA(1, 0, At, B0); PG8_BAR; PG8_SCHED;
            PG8_STAGE(PG8_SB(1, 1), b3 + hstep, voffB);
            PG8_WAIT_V(6); PG8_BAR; PG8_MMA(1, 1, At, B1); PG8_BAR;
            }
        }
        if constexpr (ALIGN_EPI) { if (wr == 0) PG8_BAR; }
        if constexpr (!Epi::AFTER_DRAIN) E(acc, cur, wr, wc, fr, fq);
        if (!has_next) break;
#pragma unroll
        for (int a = 0; a < 2; ++a)
#pragma unroll
            for (int b = 0; b < 2; ++b)
#pragma unroll
                for (int m = 0; m < 4; ++m)
#pragma unroll
                    for (int n = 0; n < 2; ++n) acc[a][b][m][n] = (f32x4){0.f, 0.f, 0.f, 0.f};
        cur = nxt; cA = nA; cB = nB; ++ui;
        if constexpr (ALIGN_EPI) { if (wr == 1) PG8_BAR; }
    }
    PG8_WAIT_V(0);
    __builtin_amdgcn_s_waitcnt(0x0F70);
    if constexpr (!ALIGN_EPI) { if (wr == 0) PG8_BAR; }
    PG8_BAR;
    if constexpr (Epi::AFTER_DRAIN) E.fused(acc, cur, wr, wc, fr, fq, lds, wid, lane);
#undef PG8_SA
#undef PG8_SB
#undef PG8_STAGE
#undef PG8_LDA
#undef PG8_LDB
#undef PG8_MMA
#undef PG8_WAIT_V
#undef PG8_WAIT_L
#undef PG8_BAR
#undef PG8_SCHED
#undef PG8_PA
#undef PG8_PB
}
}

constexpr int NWAVES = 8, NTHR = NWAVES * 64;
constexpr int DM = 2048, SEQ = 2048, NBATCH = 4, MP = NBATCH * SEQ, MS = 128, MV = MP + MS, MPAD = 8448;
constexpr int RW = 1024, NH = 8, DK = 128, SW = 1024, SG = 64, SP = 64, SN = 16;
constexpr int INC = 10240;
constexpr int POS_S = 16384;
constexpr float EPSF = 1e-6f;
constexpr int N_PHASES = 7;

constexpr size_t O_YP = 0, O_YS = O_YP + (size_t)MP * DM, O_RP = O_YS + (size_t)MS * DM, O_REP = O_RP + (size_t)NBATCH * NH * DK * DK,
                 O_IMP = O_REP + (size_t)NBATCH * SG * SP, O_RS = O_IMP + (size_t)NBATCH * SG * SP, O_RES = O_RS + (size_t)MS * NH * DK * DK,
                 O_IMS = O_RES + (size_t)MS * SG * SP, O_END = O_IMS + (size_t)MS * SG * SP;
static_assert(O_END == 35422208, "output size");

constexpr size_t MiB = 1u << 20;
constexpr size_t WS_CTL = 0, CTL_ZERO_BYTES = 64 * 1024;
constexpr size_t WS_WIN = 1 * MiB;
constexpr size_t WS_WPA = WS_WIN + 40 * MiB;
constexpr size_t WS_WPB = WS_WPA + 4 * MiB;
constexpr size_t WS_WOUT = WS_WPB + 4 * MiB;
constexpr size_t WS_WGLU = WS_WOUT + 8 * MiB;
constexpr size_t WS_TAB = WS_WGLU + 2 * MiB;
constexpr size_t ACT1 = (size_t)MPAD * 1024 * 2;
constexpr size_t WS_H = WS_TAB + 2 * MiB;
constexpr size_t WS_Q = WS_H + 2 * ACT1, WS_K = WS_Q + ACT1, WS_V = WS_K + ACT1, WS_ZA = WS_V + ACT1, WS_UB = WS_ZA + ACT1, WS_ZB = WS_UB + ACT1;
constexpr size_t WS_GA = WS_ZB + ACT1, WS_GB = WS_GA + 2 * ACT1, WS_END = WS_GB + 2 * ACT1;
constexpr size_t WS_G8A = WS_GA, WS_G8B = WS_GA + 16 * MiB;
constexpr size_t WS_GAS = WS_GA + 40 * MiB, WS_GBS = WS_GAS + 1 * MiB;
constexpr size_t WS_AAB = WS_H;
constexpr size_t WS_Y = WS_GA + 44 * MiB;
constexpr size_t WS_MRG = WS_K;
constexpr size_t WS_OUT = WS_GA;
constexpr size_t WS_PS = WS_END;
constexpr size_t PS_SLAB = (size_t)MS * INC;
constexpr size_t WS_XS = WS_PS + 4 * PS_SLAB * 4;
constexpr size_t WS_XS2 = WS_XS + (size_t)MP * 8 * 4;
constexpr size_t WS_END2 = WS_XS2 + (size_t)MS * 128 * 4;
static_assert(WS_END2 <= 300 * MiB, "ws map");
constexpr size_t TB_COS = 0, TB_SIN = TB_COS + 2049 * 64 * 4, TB_AR = TB_SIN + 2049 * 64 * 4, TB_AI = TB_AR + 64 * 64 * 4,
                 TB_BR = TB_AI + 64 * 64 * 4, TB_BI = TB_BR + 64 * 64 * 16 * 4, TB_END = TB_BI + 64 * 64 * 16 * 4;
static_assert(TB_END <= 2 * MiB && (TB_SIN % 16) == 0 && (TB_AR % 16) == 0, "tables");

constexpr int CW_TMO = 0;
constexpr int CW_SEAM = 16384;
constexpr int CW_BAR = 4096;

constexpr int RING_BYTES = 131072, LDSCTL_OFF = RING_BYTES, MISC_OFF = LDSCTL_OFF + 320, LDS_BYTES = 147456;

#define GAS __attribute__((address_space(1)))
#define LAS __attribute__((address_space(3)))
typedef unsigned short bf16;
typedef unsigned v4u __attribute__((ext_vector_type(4)));
typedef unsigned v2u __attribute__((ext_vector_type(2)));
typedef float f32x4 __attribute__((ext_vector_type(4)));
typedef GAS unsigned gu32;
#define RLX_AGENT __ATOMIC_RELAXED, __HIP_MEMORY_SCOPE_AGENT
#define LDS_WAIT() asm volatile("s_waitcnt lgkmcnt(0)" ::: "memory")
#define VM_WAIT() asm volatile("s_waitcnt vmcnt(0)" ::: "memory")
__device__ __forceinline__ unsigned f2bf(float f) { unsigned u = __builtin_bit_cast(unsigned, f); return (u + 0x7fffu + ((u >> 16) & 1u)) >> 16; }
__device__ __forceinline__ unsigned pk2(float lo, float hi) { return f2bf(lo) | (f2bf(hi) << 16); }
__device__ __forceinline__ float bf2f(bf16 v) { return __uint_as_float((unsigned)v << 16); }

#define XB_TMO      128
#define XB_XCNT(j)  (256  + 64 * (j))
#define XB_XSUB(j)  (1280 + 64 * (j))
#define XB_XGEN(j)  (2304 + 64 * (j))
#define XB_TOP      3328
#define XB_TOPGEN   3392
#define XCD_BAR_WORDS 3456
#define XB_SPIN_CAP (1u << 20)
__device__ __forceinline__ unsigned xb_ld(unsigned* p)              { return __hip_atomic_load(p, __ATOMIC_RELAXED, __HIP_MEMORY_SCOPE_AGENT); }
__device__ __forceinline__ unsigned xb_add(unsigned* p, unsigned v) { return __hip_atomic_fetch_add(p, v, __ATOMIC_RELAXED, __HIP_MEMORY_SCOPE_AGENT); }
__device__ __forceinline__ unsigned xb_xcc_id() { return (unsigned)__builtin_amdgcn_s_getreg((3 << 11) | 20) & 0xFu; }
#define XB_SPIN(cond, bar) do { unsigned _sp = 0; while (cond) { __builtin_amdgcn_s_sleep(1); \
    if ((++_sp & 255u) == 0u) { if (xb_ld(&(bar)[XB_TMO])) break; if (_sp > XB_SPIN_CAP) { atomicAdd(&(bar)[XB_TMO], 1u); break; } } } } while (0)
struct XcdBarrier { unsigned* bar; unsigned x; volatile LAS unsigned* st; };
__device__ __forceinline__ XcdBarrier xcd_barrier_post(unsigned* bar, volatile LAS unsigned* st) {
    XcdBarrier b; b.bar = bar; b.x = xb_xcc_id(); b.st = st;
    if (threadIdx.x == 0) (void)xb_add(&bar[XB_XCNT(b.x)], 1u);
    return b;
}
__device__ __forceinline__ void xcd_barrier_complete(unsigned* bar, unsigned x, unsigned& nloc, unsigned& nx) {
    const unsigned G = gridDim.x * gridDim.y * gridDim.z;
    unsigned sum, cnt, mine, sp = 0u;
    for (;;) {
        sum = 0u; cnt = 0u; mine = 0u;
#pragma unroll
        for (unsigned j = 0; j < 16; ++j) { const unsigned c = xb_ld(&bar[XB_XCNT(j)]); sum += c; cnt += (c > 0u) ? 1u : 0u; mine = (j == x) ? c : mine; }
        if (sum == G) break;
        __builtin_amdgcn_s_sleep(1);
        if ((++sp & 255u) == 0u) { if (xb_ld(&bar[XB_TMO])) break; if (sp > XB_SPIN_CAP) { atomicAdd(&bar[XB_TMO], 1u); break; } }
    }
    nloc = mine > 0u ? mine : 1u; nx = cnt > 0u ? cnt : 1u;
}
__device__ __forceinline__ void xcd_barrier(const XcdBarrier& b) {
    asm volatile("s_waitcnt vmcnt(0)" ::: "memory");
    __syncthreads();
    if (threadIdx.x == 0) {
        unsigned* bar = b.bar;
        __builtin_amdgcn_s_waitcnt(0);
        unsigned nloc = b.st[0], nx = b.st[1];
        if (nloc == 0u) { xcd_barrier_complete(bar, b.x, nloc, nx); b.st[0] = nloc; b.st[1] = nx; }
        const unsigned old = xb_add(&bar[XB_XSUB(b.x)], 1u);
        const unsigned gen = old / nloc;
        if (old + 1u == (gen + 1u) * nloc) {
            __builtin_amdgcn_fence(__ATOMIC_RELEASE, "agent");
            asm volatile("s_waitcnt vmcnt(0)" ::: "memory");
            const unsigned og = xb_add(&bar[XB_TOP], 1u);
            const unsigned tg = og / nx;
            if (og + 1u == (tg + 1u) * nx) xb_add(&bar[XB_TOPGEN], 1u);
            else XB_SPIN(xb_ld(&bar[XB_TOPGEN]) == tg, bar);
            __builtin_amdgcn_fence(__ATOMIC_ACQUIRE, "agent");
            xb_add(&bar[XB_XGEN(b.x)], 1u);
            asm volatile("s_waitcnt vmcnt(0)" ::: "memory");
        } else {
            XB_SPIN(xb_ld(&bar[XB_XGEN(b.x)]) == gen, bar);
            __builtin_amdgcn_fence(__ATOMIC_ACQUIRE, "agent");
            asm volatile("s_waitcnt vmcnt(0)" ::: "memory");
        }
    }
    __syncthreads();
}

struct Args { const float* in[21]; float* out; unsigned char* ws; int ph_lo, ph_hi, li, pad; };
struct Frame {
    LAS unsigned char* lds;
    volatile LAS unsigned* MISC;
    int tid, lane, wave, vcu, G;
    float* out; unsigned char* ws;
};
#define FIN(i) (args.in[i])
template <int CTRL, int RMASK> __device__ __forceinline__ float dpp_f(float v) { return __builtin_bit_cast(float, __builtin_amdgcn_update_dpp(0, __builtin_bit_cast(int, v), CTRL, RMASK, 0xF, false)); }
__device__ __forceinline__ float wave_sum(float v) {
    v += dpp_f<0xB1, 0xF>(v);
    v += dpp_f<0x4E, 0xF>(v);
    v += dpp_f<0x141, 0xF>(v);
    v += dpp_f<0x140, 0xF>(v);
    v += dpp_f<0x142, 0xA>(v);
    v += dpp_f<0x143, 0xC>(v);
    return __builtin_bit_cast(float, __builtin_amdgcn_readlane(__builtin_bit_cast(int, v), 63));
}
__device__ __forceinline__ float gelu_tanh(float x) {
    const float u = 0.7978845608028654f * (x + 0.044715f * x * x * x);
    const float e = __expf(2.0f * u);
    const float th = 1.0f - 2.0f * __builtin_amdgcn_rcpf(e + 1.0f);
    return 0.5f * x * (1.0f + th);
}
__device__ __forceinline__ float sigmoidf_(float x) { return __builtin_amdgcn_rcpf(1.0f + __expf(-x)); }

__device__ __forceinline__ int win_rowmap(int n) {
    if (n >= 2048) return n;
    const int head = n >> 7, d = n & 127, nn = d >> 6, dd = d & 63, wc = dd >> 4, fq = (dd >> 2) & 3, j = dd & 3;
    return head * 128 + 32 * wc + 8 * fq + 4 * nn + j;
}
__device__ __forceinline__ void p0_tr_load(float (&wv)[32], const float* W, int N, int item, int lane) {
    const int nblk = N / 32, kb = item / nblk, nb = item % nblk, k0 = 64 * kb, n0 = 32 * nb;
#pragma unroll
    for (int i = 0; i < 32; ++i) wv[i] = __builtin_nontemporal_load(W + (size_t)(k0 + 2 * i + (lane >> 5)) * N + n0 + (lane & 31));
}
template <bool MAPQ>
__device__ __forceinline__ void p0_tr_finish(const float (&wv)[32], int K, int N, bf16* WT, LAS float* scr, int item, int lane, int kofs = 0) {
    const int nblk = N / 32, kb = item / nblk, nb = item % nblk, k0 = 64 * kb, n0 = 32 * nb;
#pragma unroll
    for (int i = 0; i < 32; ++i) scr[(2 * i + (lane >> 5)) * 33 + (lane & 31)] = wv[i];
    LDS_WAIT(); asm volatile("" ::: "memory");
    const int c = lane & 7;
#pragma unroll
    for (int j = 0; j < 4; ++j) { const int n = (lane >> 3) + 8 * j; const LAS float* s = scr + (8 * c) * 33 + n;
        v4u o; o.x = pk2(s[0 * 33], s[1 * 33]); o.y = pk2(s[2 * 33], s[3 * 33]); o.z = pk2(s[4 * 33], s[5 * 33]); o.w = pk2(s[6 * 33], s[7 * 33]);
        const int drow = MAPQ ? win_rowmap(n0 + n) : (n0 + n);
        *(GAS v4u*)(WT + (size_t)drow * K + kofs + k0 + 8 * c) = o; }
    LDS_WAIT(); asm volatile("" ::: "memory");
}
template <bool MAPQ>
__device__ __forceinline__ void p0_transpose_item(const float* W, int K, int N, bf16* WT, LAS float* scr, int item, int lane, int kofs = 0) {
    float wv[32]; p0_tr_load(wv, W, N, item, lane); p0_tr_finish<MAPQ>(wv, K, N, WT, scr, item, lane, kofs);
}
__device__ __forceinline__ void rms_row_load(f32x4 (&v)[8], const float* xrow, int lane) {
    const GAS f32x4* xr = (const GAS f32x4*)xrow + lane;
#pragma unroll
    for (int j = 0; j < 8; ++j) v[j] = __builtin_nontemporal_load(xr + 64 * j);
}
__device__ __forceinline__ void rms_row_finish(const f32x4 (&v)[8], const float* g, bf16* orow, int lane) {
    const GAS f32x4* gr = (const GAS f32x4*)g + lane; float s = 0.f;
#pragma unroll
    for (int j = 0; j < 8; ++j) s += (v[j].x * v[j].x + v[j].y * v[j].y) + (v[j].z * v[j].z + v[j].w * v[j].w);
    const float rstd = 1.0f / sqrtf(wave_sum(s) * (1.f / DM) + EPSF);
    GAS unsigned long long* o8 = (GAS unsigned long long*)orow + lane;
#pragma unroll
    for (int j = 0; j < 8; ++j) { const f32x4 gg = gr[64 * j];
        o8[64 * j] = (unsigned long long)pk2(v[j].x * rstd * gg.x, v[j].y * rstd * gg.y) | ((unsigned long long)pk2(v[j].z * rstd * gg.z, v[j].w * rstd * gg.w) << 32); }
}
__device__ __forceinline__ void p0_prologue(Frame& F, const Args& args) {
    LAS float* scr = (LAS float*)(F.lds + F.wave * 16384);
    const int gw = F.vcu * NWAVES + F.wave, NGW = F.G * NWAVES;
    constexpr int I_IN = (DM / 64) * (INC / 32), I_PA = (RW / 64) * (DM / 32), I_PB = I_PA, I_OUT = (DM / 64) * (DM / 32), I_GLU = (SW / 64) * (SW / 32);
    constexpr int NITEMS = I_IN + I_PA + I_PB + I_OUT + I_GLU;
    bf16* WinT = (bf16*)(F.ws + WS_WIN); bf16* WgluT = (bf16*)(F.ws + WS_WGLU);
    (void)NITEMS;
    { float wa[32], wb[32]; int it = gw;
      if (it < I_IN) p0_tr_load(wa, args.in[6], INC, it, F.lane);
      for (; it < I_IN; it += NGW) {
          const bool hasn = it + NGW < I_IN;
          if (hasn) p0_tr_load(wb, args.in[6], INC, it + NGW, F.lane);
          p0_tr_finish<true>(wa, DM, INC, WinT, scr, it, F.lane);
          if (hasn) {
#pragma unroll
              for (int i = 0; i < 32; ++i) wa[i] = wb[i]; }
      } }
    for (int it = gw; it < I_GLU; it += NGW) p0_transpose_item<false>(args.in[19], SW, SW, WgluT, scr, it, F.lane);
    bf16* H = (bf16*)(F.ws + WS_H);
    { f32x4 ra[8], rb[8]; int m = gw;
#define XROW(mm) ((mm) < MP ? args.in[0] + (size_t)(mm) * DM : args.in[1] + (size_t)((mm) - MP) * DM)
      if (m < MV) rms_row_load(ra, XROW(m), F.lane);
      for (; m < MV; m += NGW) {
          const bool hasn = m + NGW < MV;
          if (hasn) rms_row_load(rb, XROW(m + NGW), F.lane);
          rms_row_finish(ra, args.in[5], H + (size_t)m * DM, F.lane);
          if (hasn) {
#pragma unroll
              for (int j = 0; j < 8; ++j) ra[j] = rb[j]; }
      }
#undef XROW
    }
    for (int m = MV + gw; m < MPAD; m += NGW) { GAS unsigned long long* o8 = (GAS unsigned long long*)(H + (size_t)m * DM) + F.lane;
#pragma unroll
        for (int j = 0; j < 8; ++j) o8[64 * j] = 0ull; }
    const int gt = F.vcu * NTHR + F.tid, NGT = F.G * NTHR;
    float* tcos = (float*)(F.ws + WS_TAB + TB_COS); float* tsin = (float*)(F.ws + WS_TAB + TB_SIN);
    for (int i = gt; i < 2049 * 64; i += NGT) {
        const int pi = i >> 6, d = i & 63; const double pos = (pi == 2048) ? (double)POS_S : (double)pi;
        const double inv = exp((double)d * (-9.210340371976184 / 64.0)), ang = pos * inv;
        const double red = ang - 6.283185307179586476925 * rint(ang * 0.15915494309189533577);
        float sn, cs; sincosf((float)red, &sn, &cs);
        tcos[i] = cs; tsin[i] = sn;
    }
    float* tar = (float*)(F.ws + WS_TAB + TB_AR); float* tai = (float*)(F.ws + WS_TAB + TB_AI);
    float* tbr = (float*)(F.ws + WS_TAB + TB_BR); float* tbi = (float*)(F.ws + WS_TAB + TB_BI);
    for (int i = (F.tid < 16 ? F.vcu * 16 + F.tid : SG * SP); i < SG * SP; i += F.G * 16) {
        const int g = i >> 6;
        const double lr = (double)args.in[11][i], li = (double)args.in[12][i], dt = exp((double)args.in[13][g]);
        const double ang = li * dt, red = ang - 6.283185307179586476925 * rint(ang * 0.15915494309189533577);
        float sn, cs; sincosf((float)red, &sn, &cs);
        const double mag = exp(lr * dt), ar = mag * (double)cs, ai = mag * (double)sn;
        const double nr = ar - 1.0, ni = ai, den = lr * lr + li * li;
        const double cr = (nr * lr + ni * li) / den, ci = (ni * lr - nr * li) / den;
        tar[i] = (float)ar; tai[i] = (float)ai;
        for (int n = 0; n < SN; ++n) { const double br = (double)args.in[14][i * SN + n], bi = (double)args.in[15][i * SN + n];
            tbr[i * SN + n] = (float)(cr * br - ci * bi); tbi[i * SN + n] = (float)(cr * bi + ci * br); }
    }
}

__device__ __forceinline__ void p1_convert_rest(Frame& F, const Args& args, int idx, int nidle) {
    LAS float* scr = (LAS float*)(F.lds + F.wave * 16384);
    constexpr int I_PA = (RW / 64) * (DM / 32), I_PB = I_PA, I_OUT = (DM / 64) * (DM / 32);
    bf16* WpT = (bf16*)(F.ws + WS_WPA); bf16* WoutT = (bf16*)(F.ws + WS_WOUT);
    for (int it = idx * NWAVES + F.wave; it < I_PA + I_PB + I_OUT; it += nidle * NWAVES) {
        int r = it;
        if (r < I_PA) { p0_transpose_item<false>(args.in[7], 2 * RW, DM, WpT, scr, r, F.lane, 0); continue; } r -= I_PA;
        if (r < I_PB) { p0_transpose_item<false>(args.in[8], 2 * RW, DM, WpT, scr, r, F.lane, RW); continue; } r -= I_PB;
        p0_transpose_item<false>(args.in[9], DM, DM, WoutT, scr, r, F.lane);
    }
}
using pg8::Unit; using pg8::cvt_pk_bf16; using pg8::bf_lo; using pg8::bf_hi;
struct EpiProj {
    static constexpr bool MIDHOOK = false, AFTER_DRAIN = false, PERM = true;
    bf16 *Q, *K, *V, *ZA, *UB, *ZB, *GA, *GB; const float* tcos; const float* tsin; float* PS;
    __device__ __forceinline__ void operator()(const f32x4 (&acc)[2][2][4][2], const Unit& u, int wr, int wc, int fr, int fq) const {
        asm volatile("" : "+v"(fr), "+v"(fq));
        const int row0 = u.pm * 256 + wr * 64 + fr;
        const int seg = u.pn >> 2;
        if (u.z) {
            float* slab = PS + (size_t)(u.z - 1) * PS_SLAB + (size_t)(wr * 64 + fr) * INC + u.pn * 256 + wc * 32 + 8 * fq;
#pragma unroll
            for (int m = 0; m < 4; ++m)
#pragma unroll
                for (int bj = 0; bj < 2; ++bj) { *(f32x4*)(slab + (size_t)m * 16 * INC + bj * 128) = acc[0][bj][m][0]; *(f32x4*)(slab + (size_t)m * 16 * INC + bj * 128 + 4) = acc[0][bj][m][1]; }
            return;
        }
        if (seg < 2) {
            bf16* base = seg == 0 ? Q : K;
            const int head0 = (u.pn & 3) * 2, d0 = 16 * wc + 4 * fq;
            float lgh[2];
#pragma unroll
            for (int bj = 0; bj < 2; ++bj) lgh[bj] = seg == 0 ? 0.f : log2f(1.0f - exp2f(-5.0f - (float)(head0 + bj)));
            f32x4 csq[2][4], snq[2][4];
#pragma unroll
            for (int ai = 0; ai < 2; ++ai)
#pragma unroll
                for (int m = 0; m < 4; ++m) { const int row = row0 + ai * 128 + m * 16; const int pi = row < MP ? (row & (SEQ - 1)) : 2048;
                    csq[ai][m] = *(const f32x4*)(tcos + pi * 64 + d0); snq[ai][m] = *(const f32x4*)(tsin + pi * 64 + d0); }
#pragma unroll
            for (int ai = 0; ai < 2; ++ai)
#pragma unroll
                for (int m = 0; m < 4; ++m) {
                    const int row = row0 + ai * 128 + m * 16;
                    const float sl1 = row < MP ? (float)((row & 127) + 1) : 1.0f;
                    const f32x4 cs = csq[ai][m], sn = snq[ai][m];
#pragma unroll
                    for (int bj = 0; bj < 2; ++bj) {
                        const float sc = seg == 0 ? 1.0f : 0.08838834764831845f * exp2f(-sl1 * lgh[bj]);
                        const f32x4 x1 = acc[ai][bj][m][0], x2 = acc[ai][bj][m][1];
                        const f32x4 o1 = (x1 * cs - x2 * sn) * sc, o2 = (x1 * sn + x2 * cs) * sc;
                        bf16* p = base + (size_t)row * RW + (head0 + bj) * 128 + d0;
                        v2u w1, w2; w1.x = cvt_pk_bf16(o1[0], o1[1]); w1.y = cvt_pk_bf16(o1[2], o1[3]); w2.x = cvt_pk_bf16(o2[0], o2[1]); w2.y = cvt_pk_bf16(o2[2], o2[3]);
                        *(v2u*)p = w1; *(v2u*)(p + 64) = w2;
                    }
                }
        } else {
            const int sb = seg < 6 ? seg : (seg & ~1);
            bf16* base = (bf16*)((unsigned char*)Q + (size_t)sb * ACT1);
            const int ldc = seg < 6 ? 1024 : 2048, colt = (u.pn - 4 * sb) * 256;
            const int act = seg >= 6 ? 2 : ((seg == 3 || seg == 5) ? 1 : 0);
            const int col0 = colt + wc * 32 + 8 * fq;
            if (seg >= 6) {
                unsigned char* gt = (unsigned char*)Q + (WS_G8A - WS_Q) + (seg >= 8 ? (WS_G8B - WS_G8A) : 0) + (size_t)(u.pm * 8 + ((u.pn - 24) & 7)) * 65536 + (size_t)(((wr * 4 + wc) * 64) + fq * 16 + fr) * 8;
#pragma unroll
                for (int ai = 0; ai < 2; ++ai)
#pragma unroll
                    for (int m = 0; m < 4; ++m)
#pragma unroll
                        for (int bj = 0; bj < 2; ++bj) { const f32x4 v0 = acc[ai][bj][m][0], v1 = acc[ai][bj][m][1]; unsigned q[8];
#pragma unroll
                            for (int e = 0; e < 4; ++e) { q[e] = (unsigned)(sigmoidf_(v0[e]) * 255.0f + 0.5f); q[4 + e] = (unsigned)(sigmoidf_(v1[e]) * 255.0f + 0.5f); }
                            v2u w; w.x = q[0] | (q[1] << 8) | (q[2] << 16) | (q[3] << 24); w.y = q[4] | (q[5] << 8) | (q[6] << 16) | (q[7] << 24);
                            *(v2u*)(gt + (size_t)((ai * 4 + m) * 2 + bj) * 4096) = w; }
                return;
            }
#pragma unroll
            for (int ai = 0; ai < 2; ++ai)
#pragma unroll
                for (int m = 0; m < 4; ++m) { bf16* rowp = base + (size_t)(row0 + ai * 128 + m * 16) * ldc + col0;
#pragma unroll
                    for (int bj = 0; bj < 2; ++bj) { f32x4 v0 = acc[ai][bj][m][0], v1 = acc[ai][bj][m][1];
                        if (act != 0) {
#pragma unroll
                            for (int e = 0; e < 4; ++e) { const float s0 = sigmoidf_(v0[e]), s1 = sigmoidf_(v1[e]); v0[e] = act == 1 ? v0[e] * s0 : s0; v1[e] = act == 1 ? v1[e] * s1 : s1; }
                        }
                        v4u w; w.x = cvt_pk_bf16(v0[0], v0[1]); w.y = cvt_pk_bf16(v0[2], v0[3]); w.z = cvt_pk_bf16(v1[0], v1[1]); w.w = cvt_pk_bf16(v1[2], v1[3]);
                        if (seg == 4) {
                            const int col = col0 + bj * 128, g = col >> 4, half = (col >> 3) & 1;
                            *(v4u*)(base + ((size_t)g * MPAD + (row0 + ai * 128 + m * 16)) * 16 + 8 * half) = w;
                        } else *(v4u*)(rowp + bj * 128) = w; } }
        }
    }
};
struct EpiGlu {
    static constexpr bool MIDHOOK = false, AFTER_DRAIN = false, PERM = true;
    const bf16* Y; const bf16* ZB; bf16* AB; const float* bias;
    __device__ __forceinline__ void operator()(const f32x4 (&acc)[2][2][4][2], const Unit& u, int wr, int wc, int fr, int fq) const {
        const int row0 = u.pm * 256 + wr * 64 + fr, col0 = u.pn * 256 + wc * 32 + 8 * fq;
        f32x4 bq[2][2];
#pragma unroll
        for (int bj = 0; bj < 2; ++bj) { bq[bj][0] = *(const f32x4*)(bias + col0 + bj * 128); bq[bj][1] = *(const f32x4*)(bias + col0 + bj * 128 + 4); }
#pragma unroll
        for (int ai = 0; ai < 2; ++ai) {
            v4u yq[4][2], zq[4][2];
#pragma unroll
            for (int m = 0; m < 4; ++m)
#pragma unroll
                for (int bj = 0; bj < 2; ++bj) { const size_t off = (size_t)(row0 + ai * 128 + m * 16) * SW + col0 + bj * 128; yq[m][bj] = *(const v4u*)(Y + off); zq[m][bj] = *(const v4u*)(ZB + off); }
#pragma unroll
            for (int m = 0; m < 4; ++m)
#pragma unroll
                for (int bj = 0; bj < 2; ++bj) { const size_t off = (size_t)(row0 + ai * 128 + m * 16) * SW + col0 + bj * 128;
                    const v4u yv = yq[m][bj], zv = zq[m][bj];
                    const f32x4 g0 = acc[ai][bj][m][0] + bq[bj][0], g1 = acc[ai][bj][m][1] + bq[bj][1];
                    float o[8];
                    o[0] = bf_lo(yv.x) * sigmoidf_(g0[0]) * bf_lo(zv.x); o[1] = bf_hi(yv.x) * sigmoidf_(g0[1]) * bf_hi(zv.x);
                    o[2] = bf_lo(yv.y) * sigmoidf_(g0[2]) * bf_lo(zv.y); o[3] = bf_hi(yv.y) * sigmoidf_(g0[3]) * bf_hi(zv.y);
                    o[4] = bf_lo(yv.z) * sigmoidf_(g1[0]) * bf_lo(zv.z); o[5] = bf_hi(yv.z) * sigmoidf_(g1[1]) * bf_hi(zv.z);
                    o[6] = bf_lo(yv.w) * sigmoidf_(g1[2]) * bf_lo(zv.w); o[7] = bf_hi(yv.w) * sigmoidf_(g1[3]) * bf_hi(zv.w);
                    v4u w; w.x = cvt_pk_bf16(o[0], o[1]); w.y = cvt_pk_bf16(o[2], o[3]); w.z = cvt_pk_bf16(o[4], o[5]); w.w = cvt_pk_bf16(o[6], o[7]);
                    *(v4u*)(AB + (size_t)(row0 + ai * 128 + m * 16) * (2 * SW) + SW + col0 + bj * 128) = w; }
        }
    }
};
struct EpiMerge {
    static constexpr bool MIDHOOK = true, AFTER_DRAIN = false, PERM = true;
    const unsigned char* G8A; const unsigned char* G8B; bf16* MRG;
    __device__ __forceinline__ void mid(f32x4 (&acc)[2][2][4][2], const Unit& u, int wr, int wc, int fr, int fq) const {
        asm volatile("" : "+v"(fr), "+v"(fq));
        const size_t toff = (size_t)(u.pm * 8 + u.pn) * 65536 + (size_t)(((wr * 4 + wc) * 64) + fq * 16 + fr) * 8;
#pragma unroll
        for (int ai = 0; ai < 2; ++ai) {
            v2u ga[4][2], gb[4][2];
#pragma unroll
            for (int m = 0; m < 4; ++m)
#pragma unroll
                for (int bj = 0; bj < 2; ++bj) { ga[m][bj] = *(const v2u*)(G8A + toff + (size_t)((ai * 4 + m) * 2 + bj) * 4096); gb[m][bj] = *(const v2u*)(G8B + toff + (size_t)((ai * 4 + m) * 2 + bj) * 4096); }
#pragma unroll
            for (int m = 0; m < 4; ++m)
#pragma unroll
                for (int bj = 0; bj < 2; ++bj)
#pragma unroll
                    for (int e = 0; e < 4; ++e) {
                        const unsigned a0 = (ga[m][bj].x >> (8 * e)) & 255u, a1 = (ga[m][bj].y >> (8 * e)) & 255u, b0 = (gb[m][bj].x >> (8 * e)) & 255u, b1 = (gb[m][bj].y >> (8 * e)) & 255u;
                        acc[ai][bj][m][0][e] *= (float)a0 * __builtin_amdgcn_rcpf((float)(b0 ? b0 : 1u));
                        acc[ai][bj][m][1][e] *= (float)a1 * __builtin_amdgcn_rcpf((float)(b1 ? b1 : 1u)); }
        }
    }
    __device__ __forceinline__ void operator()(const f32x4 (&acc)[2][2][4][2], const Unit& u, int wr, int wc, int fr, int fq) const {
        asm volatile("" : "+v"(fr), "+v"(fq));
        const int row0 = u.pm * 256 + wr * 64 + fr, col0 = u.pn * 256 + wc * 32 + 8 * fq;
        const size_t toff = (size_t)(u.pm * 8 + u.pn) * 65536 + (size_t)(((wr * 4 + wc) * 64) + fq * 16 + fr) * 8;
        v2u gb[2][4][2];
#pragma unroll
        for (int ai = 0; ai < 2; ++ai)
#pragma unroll
            for (int m = 0; m < 4; ++m)
#pragma unroll
                for (int bj = 0; bj < 2; ++bj) gb[ai][m][bj] = *(const v2u*)(G8B + toff + (size_t)((ai * 4 + m) * 2 + bj) * 4096);
        const float k255 = 1.0f / 255.0f;
#pragma unroll
        for (int ai = 0; ai < 2; ++ai)
#pragma unroll
            for (int m = 0; m < 4; ++m)
#pragma unroll
                for (int bj = 0; bj < 2; ++bj) { float o[8];
#pragma unroll
                    for (int e = 0; e < 4; ++e) { const unsigned b0 = (gb[ai][m][bj].x >> (8 * e)) & 255u, b1 = (gb[ai][m][bj].y >> (8 * e)) & 255u;
                        o[e] = acc[ai][bj][m][0][e] * ((float)(b0 ? b0 : 1u) * k255); o[4 + e] = acc[ai][bj][m][1][e] * ((float)(b1 ? b1 : 1u) * k255); }
                    v4u w; w.x = cvt_pk_bf16(o[0], o[1]); w.y = cvt_pk_bf16(o[2], o[3]); w.z = cvt_pk_bf16(o[4], o[5]); w.w = cvt_pk_bf16(o[6], o[7]);
                    *(v4u*)(MRG + (size_t)(row0 + ai * 128 + m * 16) * DM + col0 + bj * 128) = w; }
    }
};
struct EpiOutBf16 {
    static constexpr bool MIDHOOK = false, AFTER_DRAIN = false, PERM = true;
    bf16* C; int ldc;
    __device__ __forceinline__ void operator()(const f32x4 (&acc)[2][2][4][2], const Unit& u, int wr, int wc, int fr, int fq) const {
        const int row0 = u.pm * 256 + wr * 64 + fr, col0 = u.pn * 256 + wc * 32 + 8 * fq;
#pragma unroll
        for (int ai = 0; ai < 2; ++ai)
#pragma unroll
            for (int m = 0; m < 4; ++m) { bf16* rowp = C + (size_t)(row0 + ai * 128 + m * 16) * ldc + col0;
#pragma unroll
                for (int bj = 0; bj < 2; ++bj) { const f32x4 v0 = acc[ai][bj][m][0], v1 = acc[ai][bj][m][1];
                    v4u w; w.x = cvt_pk_bf16(v0[0], v0[1]); w.y = cvt_pk_bf16(v0[2], v0[3]); w.z = cvt_pk_bf16(v1[0], v1[1]); w.w = cvt_pk_bf16(v1[2], v1[3]);
                    *(v4u*)(rowp + bj * 128) = w; } }
    }
};

typedef float f32x16 __attribute__((ext_vector_type(16)));
typedef float f32x2v __attribute__((ext_vector_type(2)));
typedef short bf16x8 __attribute__((ext_vector_type(8)));
typedef short s16x4 __attribute__((ext_vector_type(4)));
typedef __bf16 bf16x2_t __attribute__((ext_vector_type(2)));
#define MFMA32(a, b, c) __builtin_amdgcn_mfma_f32_32x32x16_bf16((a), (b), (c), 0, 0, 0)
#define MFMA16(a, b, c) __builtin_amdgcn_mfma_f32_16x16x32_bf16((a), (b), (c), 0, 0, 0)
__device__ __forceinline__ unsigned cvtpk(float lo, float hi) { f32x2v v = {lo, hi}; bf16x2_t b = __builtin_convertvector(v, bf16x2_t); return __builtin_bit_cast(unsigned, b); }
__device__ __forceinline__ v2u pk4(const f32x4 v) { v2u w; w.x = cvtpk(v[0], v[1]); w.y = cvtpk(v[2], v[3]); return w; }
__device__ __forceinline__ s16x4 lds_tr(LAS unsigned char* p) { return __builtin_bit_cast(s16x4, __builtin_amdgcn_ds_read_tr16_b64_v4i16((LAS s16x4*)p)); }
__device__ __forceinline__ bf16x8 cat8(s16x4 lo, s16x4 hi) { return (bf16x8){lo[0], lo[1], lo[2], lo[3], hi[0], hi[1], hi[2], hi[3]}; }
__device__ __forceinline__ bf16x8 pack8(const f32x16& x, int s) {
    v4u p; p.x = cvtpk(x[8 * s], x[8 * s + 1]); p.y = cvtpk(x[8 * s + 2], x[8 * s + 3]); p.z = cvtpk(x[8 * s + 4], x[8 * s + 5]); p.w = cvtpk(x[8 * s + 6], x[8 * s + 7]);
    return __builtin_bit_cast(bf16x8, p);
}
__device__ __forceinline__ void glds16(const void* g, LAS unsigned char* l) { __builtin_amdgcn_global_load_lds((const unsigned*)g, (LAS unsigned*)l, 16, 0, 0); }
__device__ __forceinline__ void glds16_asm(const void* gsrc, unsigned lds_dst) { unsigned keep;
    asm volatile("s_mov_b32 %0, m0\n\ts_mov_b32 m0, %2\n\ts_nop 0\n\tglobal_load_lds_dwordx4 %1, off\n\ts_mov_b32 m0, %0" : "=&s"(keep) : "v"(gsrc), "s"(lds_dst) : "memory"); }
__device__ __forceinline__ unsigned swz16(unsigned row) { return ((row & 3u) << 2) | ((row >> 2) & 3u); }
__device__ __forceinline__ unsigned off_b(unsigned row, unsigned ch) { return 256u * row + 16u * (ch ^ swz16(row)); }

__device__ __forceinline__ int launder(int x) { asm volatile("" : "+v"(x)); return x; }
constexpr int RT_STAT = RING_BYTES + 1024;
__device__ __forceinline__ void ret_stage(LAS unsigned char* buf, const bf16* KSg, const bf16* Vg, size_t tok0, int hcol, int wave, int lane) {
#pragma unroll
    for (int i = 0; i < 2; ++i) {
        const unsigned slot = (unsigned)(wave * 64 + lane + 512 * i), row = slot >> 4, cp = slot & 15u, ch = cp ^ swz16(row);
        const size_t go = (tok0 + row) * RW + hcol + ch * 8;
        const unsigned dst = (unsigned)(size_t)buf + (unsigned)((wave * 64 + 512 * i) * 16);
        glds16_asm(KSg + go, (unsigned)__builtin_amdgcn_readfirstlane((int)dst));
        glds16_asm(Vg + go, (unsigned)__builtin_amdgcn_readfirstlane((int)(dst + 16384u)));
    }
}
template <bool KROW> __device__ __forceinline__ unsigned tr_base(int lane, unsigned c, unsigned t) {
    const unsigned h = lane >> 5, blk = (lane >> 4) & 1, q = (lane & 15) >> 2, p = lane & 3;
    const unsigned rowl = KROW ? (8 * t + 4 * h + q) : (8 * h + 4 * t + q), sw = (q << 2) | (KROW ? (2 * t + h) : (2 * h + t));
    return 256u * rowl + 16u * ((4 * c + 2 * blk + (p >> 1)) ^ sw) + 8u * (p & 1);
}
__device__ __forceinline__ void ret_state_update(f32x16 (&accS)[2], LAS unsigned char* buf, const unsigned (&ba)[2], const unsigned (&bb)[2][2]) {
#pragma unroll
    for (int ks = 0; ks < 4; ++ks) {
        const bf16x8 A = cat8(lds_tr(buf + ba[0] + 4096 * ks), lds_tr(buf + ba[1] + 4096 * ks));
#pragma unroll
        for (int e2 = 0; e2 < 2; ++e2) {
            const bf16x8 B = cat8(lds_tr(buf + 16384 + bb[e2][0] + 4096 * ks), lds_tr(buf + 16384 + bb[e2][1] + 4096 * ks));
            accS[e2] = MFMA32(A, B, accS[e2]); }
    }
}
__device__ __forceinline__ void ret_unit(Frame& F, int b, int hd, int j, bool primed, int nj) {
    LAS unsigned char* lds = F.lds;
    const bf16* Qg = (const bf16*)(F.ws + WS_Q); const bf16* KSg = (const bf16*)(F.ws + WS_K); const bf16* Vg = (const bf16*)(F.ws + WS_V);
    const int w = F.wave; int lane = launder(F.lane); int h = lane >> 5, r = lane & 31;
    const int hi2 = w >> 1, eh = w & 1;
    const float lg2 = log2f(1.0f - exp2f(-5.0f - (float)hd)), g128 = exp2f(128.0f * lg2);
    const size_t tokb = (size_t)b * SEQ; const int hcol = hd * DK;
    f32x16 accS[2], accO[2];
#pragma unroll
    for (int i = 0; i < 16; ++i) { accS[0][i] = 0.f; accS[1][i] = 0.f; accO[0][i] = 0.f; accO[1][i] = 0.f; }
    bf16x8 qf[8]; v2u zq[2][4];
    { const bf16* qrow = Qg + (tokb + 128 * (size_t)j + 32 * hi2 + r) * RW + hcol + 4 * h;
#pragma unroll
      for (int ks = 0; ks < 8; ++ks) { const v2u lo = *(const v2u*)(qrow + 16 * ks), hi = *(const v2u*)(qrow + 16 * ks + 8); v4u t; t.x = lo.x; t.y = lo.y; t.z = hi.x; t.w = hi.y; qf[ks] = __builtin_bit_cast(bf16x8, t); }
      const bf16* zrow = (const bf16*)(F.ws + WS_ZA) + (tokb + 128 * (size_t)j + 32 * hi2 + r) * RW + hcol + 4 * h;
#pragma unroll
      for (int e2 = 0; e2 < 2; ++e2)
#pragma unroll
        for (int g4 = 0; g4 < 4; ++g4) zq[e2][g4] = *(const v2u*)(zrow + 32 * (2 * eh + e2) + 8 * g4); }
    unsigned ba[2], bb[2][2];
#pragma unroll
    for (int t = 0; t < 2; ++t) { ba[t] = tr_base<false>(lane, hi2, t); bb[0][t] = tr_base<false>(lane, 2 * eh, t); bb[1][t] = tr_base<false>(lane, 2 * eh + 1, t); }
    const int nprev = 2 * j, NS = nprev + 2;
#define RT_SLOT(n) (lds + (((n) & 3) << 15))
    if (!primed) {
        ret_stage(RT_SLOT(0), KSg, Vg, tokb, hcol, w, lane);
        ret_stage(RT_SLOT(1), KSg, Vg, tokb + 64, hcol, w, lane);
        if (NS > 2) ret_stage(RT_SLOT(2), KSg, Vg, tokb + 128, hcol, w, lane);
    }
    if (NS > 2) asm volatile("s_waitcnt vmcnt(8)" ::: "memory"); else asm volatile("s_waitcnt vmcnt(0)" ::: "memory");
    __builtin_amdgcn_s_barrier(); asm volatile("" ::: "memory");
    for (int n = 0; n < nprev; ++n) {
        const bool more = n + 3 < NS;
        if (more) ret_stage(RT_SLOT(n + 3), KSg, Vg, tokb + 64 * (size_t)(n + 3), hcol, w, lane);
        ret_state_update(accS, RT_SLOT(n), ba, bb);
        if (n & 1) { accS[0] = accS[0] * g128; accS[1] = accS[1] * g128; }
        if (more) asm volatile("s_waitcnt vmcnt(8) lgkmcnt(0)" ::: "memory"); else asm volatile("s_waitcnt vmcnt(0) lgkmcnt(0)" ::: "memory");
        __builtin_amdgcn_s_barrier(); asm volatile("" ::: "memory");
    }
    LAS unsigned char* sx = RT_SLOT(nprev + 2);
    lane = launder(F.lane); h = lane >> 5; r = lane & 31;
#pragma unroll
    for (int e2 = 0; e2 < 2; ++e2)
#pragma unroll
        for (int s = 0; s < 2; ++s) *(LAS bf16x8*)(sx + ((hi2 * 4 + 2 * eh + e2) * 2 + s) * 1024 + lane * 16) = pack8(accS[e2], s);
    LDS_WAIT(); __syncthreads();
    const int tt = hi2;
    unsigned rrow, rx, rc[2];
    { const unsigned sw = swz16((unsigned)r); rrow = 256u * r + 8u * h; rx = 32u * (sw >> 1); rc[0] = 16u * (sw & 1); rc[1] = 16u * ((sw & 1) ^ 1); }
    unsigned bv[2][2];
#pragma unroll
    for (int t = 0; t < 2; ++t) { bv[0][t] = tr_base<true>(lane, 2 * eh, t); bv[1][t] = tr_base<true>(lane, 2 * eh + 1, t); }
#pragma unroll
    for (int sg = 0; sg < 2; ++sg) {
        const int n = nprev + sg;
        LAS unsigned char* buf = RT_SLOT(n);
#pragma unroll
        for (int st2 = 0; st2 < 2; ++st2) {
            const int st = 2 * sg + st2;
            if (st <= tt) {
                const unsigned rb = 32 * st2;
                f32x16 X;
#pragma unroll
                for (int i = 0; i < 16; ++i) X[i] = 0.f;
#pragma unroll
                for (int ks = 0; ks < 8; ++ks) {
                    const unsigned ax = rrow + ((32u * ks) ^ rx) + 256u * rb;
                    const v2u lo = *(const LAS v2u*)(buf + ax + rc[0]), hi = *(const LAS v2u*)(buf + ax + rc[1]);
                    v4u t; t.x = lo.x; t.y = lo.y; t.z = hi.x; t.w = hi.y;
                    X = MFMA32(__builtin_bit_cast(bf16x8, t), qf[ks], X);
                }
                if (st == tt) {
#pragma unroll
                    for (int i = 0; i < 16; ++i) { const int srow = (i & 3) + 8 * (i >> 2) + 4 * h; X[i] = srow > r ? 0.f : X[i]; }
                }
#pragma unroll
                for (int s = 0; s < 2; ++s) {
                    const bf16x8 xb = pack8(X, s);
#pragma unroll
                    for (int e2 = 0; e2 < 2; ++e2) {
                        const bf16x8 A = cat8(lds_tr(buf + 16384 + bv[e2][0] + 256 * (rb + 16 * s)), lds_tr(buf + 16384 + bv[e2][1] + 256 * (rb + 16 * s)));
                        accO[e2] = MFMA32(A, xb, accO[e2]); }
                }
            }
        }
        if (sg == 0) {
#pragma unroll
            for (int e2 = 0; e2 < 2; ++e2)
#pragma unroll
                for (int dt = 0; dt < 4; ++dt)
#pragma unroll
                    for (int s = 0; s < 2; ++s) {
                        const bf16x8 A = *(const LAS bf16x8*)(sx + ((dt * 4 + 2 * eh + e2) * 2 + s) * 1024 + lane * 16);
                        accO[e2] = MFMA32(A, qf[2 * dt + s], accO[e2]); }
        }
        if (j == 15) ret_state_update(accS, buf, ba, bb);
    }
#undef RT_SLOT
    if (j == 15) {
        float* So = F.out + O_RP + (size_t)(b * NH + hd) * DK * DK;
#pragma unroll
        for (int e2 = 0; e2 < 2; ++e2)
#pragma unroll
            for (int i = 0; i < 16; ++i) So[(size_t)(32 * hi2 + (i & 3) + 8 * (i >> 2) + 4 * h) * DK + 32 * (2 * eh + e2) + r] = accS[e2][i] * g128;
    }
    lane = launder(F.lane); h = lane >> 5; r = lane & 31;
    if (nj >= 0) {
        __syncthreads();
        ret_stage(lds, KSg, Vg, tokb, hcol, w, lane);
        ret_stage(lds + 32768, KSg, Vg, tokb + 64, hcol, w, lane);
        if (2 * nj + 2 > 2) ret_stage(lds + 65536, KSg, Vg, tokb + 128, hcol, w, lane);
    }
    bf16* AA = (bf16*)(F.ws + WS_AAB);
    const float sc = exp2f((float)(32 * tt + r + 1) * lg2);
    float s1 = 0.f, s2 = 0.f;
#pragma unroll
    for (int e2 = 0; e2 < 2; ++e2)
#pragma unroll
        for (int i = 0; i < 16; ++i) { const float o = accO[e2][i] * sc; accO[e2][i] = o; s1 += o; s2 += o * o; }
    s1 += __shfl_xor(s1, 32); s2 += __shfl_xor(s2, 32);
    LAS f32x2v* stat = (LAS f32x2v*)(lds + RT_STAT);
    if (h == 0) stat[(32 * tt + r) * 2 + eh] = (f32x2v){s1, s2};
    LDS_WAIT(); __syncthreads();
    { const f32x2v a = stat[(32 * tt + r) * 2], c = stat[(32 * tt + r) * 2 + 1];
      const float mean = (a.x + c.x) * (1.0f / 128.0f), var = fmaxf((a.y + c.y) * (1.0f / 128.0f) - mean * mean, 0.f), rstd = 1.0f / sqrtf(var + EPSF);
      const size_t ro = (tokb + 128 * (size_t)j + 32 * tt + r) * (2 * RW) + hcol;
#pragma unroll
      for (int e2 = 0; e2 < 2; ++e2)
#pragma unroll
        for (int g4 = 0; g4 < 4; ++g4) { const int e0 = 32 * (2 * eh + e2) + 8 * g4 + 4 * h;
            const v2u zv = zq[e2][g4];
            const float o0 = (accO[e2][4 * g4] - mean) * rstd * bf_lo(zv.x), o1 = (accO[e2][4 * g4 + 1] - mean) * rstd * bf_hi(zv.x);
            const float o2 = (accO[e2][4 * g4 + 2] - mean) * rstd * bf_lo(zv.y), o3 = (accO[e2][4 * g4 + 3] - mean) * rstd * bf_hi(zv.y);
            v2u wv; wv.x = cvtpk(o0, o1); wv.y = cvtpk(o2, o3); *(v2u*)(AA + ro + e0) = wv; } }
    __syncthreads();
}
__device__ __forceinline__ float ps_sum(const float* PS, int b, int n) {
    const float* p = PS + (size_t)b * INC + n; return (p[0] + p[PS_SLAB]) + (p[2 * PS_SLAB] + p[3 * PS_SLAB]);
}
__device__ __forceinline__ void ret_sample_load(f32x4 (&S)[8], float (&px)[2], const float* S0, const float* PS, int v, int tid) {
    const int cg = tid & 31, rg = tid >> 5, b = v / NH, h = v % NH, d = tid & 127, part = tid >> 7;
#pragma unroll
    for (int i = 0; i < 8; ++i) S[i] = __builtin_nontemporal_load((const f32x4*)(S0 + (size_t)(rg + 16 * i) * DK + 4 * cg));
    if (part < 2) { const int dl = d & 63, c1 = 32 * (dl >> 4) + 8 * ((dl >> 2) & 3) + (dl & 3), nb = part * 1024 + h * 128; px[0] = ps_sum(PS, b, nb + c1); px[1] = ps_sum(PS, b, nb + c1 + 4); }
    else { px[0] = ps_sum(PS, b, part * 1024 + h * 128 + d); px[1] = 0.f; }
}
__device__ __forceinline__ void ret_sample_unit(Frame& F, int b, int h, f32x4 (&S)[8], const float (&px)[2], float* Sout) {
    bf16* AA = (bf16*)(F.ws + WS_AAB);
    float* sq = (float*)(F.lds); float* sk = sq + 128; float* sv = sk + 128; float* sz = sv + 128; float* red = sz + 128; float* stat = red + 16 * 128;
    const int tid = launder(F.tid) & 511, cg = tid & 31, rg = tid >> 5;
    const float gam = 1.0f - exp2f(-5.0f - (float)h);
    const size_t ro = (size_t)(MP + b) * (2 * RW) + h * DK;
    { const int d = tid & 127, part = tid >> 7;
      if (part < 2) { const int dl = d & 63;
          const float x1 = px[0], x2 = px[1];
          const float cs = ((const float*)(F.ws + WS_TAB + TB_COS))[2048 * 64 + dl], sn = ((const float*)(F.ws + WS_TAB + TB_SIN))[2048 * 64 + dl];
          const float o = d < 64 ? x1 * cs - x2 * sn : x1 * sn + x2 * cs;
          if (part == 0) sq[d] = o; else sk[d] = o * (0.08838834764831845f / gam);
      } else { const float x = px[0]; if (part == 2) sv[d] = x; else sz[d] = x * sigmoidf_(x); } }
    __syncthreads();
    const f32x4 vv = *(const f32x4*)(sv + 4 * cg); f32x4 o = (f32x4){0.f, 0.f, 0.f, 0.f};
#pragma unroll
    for (int i = 0; i < 8; ++i) { const float kk = sk[rg + 16 * i], qq = sq[rg + 16 * i]; S[i] = (S[i] + vv * kk) * gam; o += S[i] * qq;
        __builtin_nontemporal_store(S[i], (f32x4*)(Sout + (size_t)(rg + 16 * i) * DK + 4 * cg)); }
    *(f32x4*)(red + rg * 128 + 4 * cg) = o;
    __syncthreads();
    float ov = 0.f;
    if (tid < 128) {
#pragma unroll
        for (int rr = 0; rr < 16; ++rr) ov += red[rr * 128 + tid];
        const float t1 = wave_sum(ov); if (F.lane == 0) stat[F.wave] = t1;
    }
    __syncthreads();
    float dv_ = 0.f;
    if (tid < 128) { const float mu = (stat[0] + stat[1]) * (1.0f / 128.0f); dv_ = ov - mu; const float t2 = wave_sum(dv_ * dv_); if (F.lane == 0) stat[2 + F.wave] = t2; }
    __syncthreads();
    if (tid < 128) { const float var = (stat[2] + stat[3]) * (1.0f / 128.0f); const float on = dv_ * (1.0f / sqrtf(var + EPSF));
        AA[ro + tid] = (bf16)f2bf(on * sz[tid]); }
    __syncthreads();
}
__device__ __forceinline__ void s5_sample_wave(Frame& F, const Args& args, int g, int b0, int bstep) {
    bf16* Y = (bf16*)(F.ws + WS_Y);
    const int p = launder(F.lane) & 63, gp = g * SP + p;
    const float* PSl = (const float*)(F.ws + WS_PS) + (size_t)(p >> 4) * PS_SLAB + 4096 + g * SN + (p & 15);
    float uq[4], xq[4], yq[4];
#pragma unroll
    for (int k = 0; k < 4; ++k) { const int b = b0 + k * bstep; uq[k] = 0.f; xq[k] = 0.f; yq[k] = 0.f;
        if (b < MS) { uq[k] = PSl[(size_t)b * INC]; xq[k] = args.in[3][(size_t)(b * SG + g) * SP + p]; yq[k] = args.in[4][(size_t)(b * SG + g) * SP + p]; } }
    float br[SN], bi[SN], crv[SN], civ[SN];
    { const f32x4* tb = (const f32x4*)((const float*)(F.ws + WS_TAB + TB_BR) + (size_t)gp * SN); const f32x4* ti = (const f32x4*)((const float*)(F.ws + WS_TAB + TB_BI) + (size_t)gp * SN);
#pragma unroll
      for (int q4 = 0; q4 < 4; ++q4) { const f32x4 a = tb[q4], c = ti[q4]; br[4 * q4] = a[0]; br[4 * q4 + 1] = a[1]; br[4 * q4 + 2] = a[2]; br[4 * q4 + 3] = a[3]; bi[4 * q4] = c[0]; bi[4 * q4 + 1] = c[1]; bi[4 * q4 + 2] = c[2]; bi[4 * q4 + 3] = c[3]; } }
#pragma unroll
    for (int n = 0; n < SN; ++n) { crv[n] = args.in[16][(g * SN + n) * SP + p]; civ[n] = args.in[17][(g * SN + n) * SP + p]; }
    const float ar = ((const float*)(F.ws + WS_TAB + TB_AR))[gp], ai = ((const float*)(F.ws + WS_TAB + TB_AI))[gp];
    const float dnv = args.in[18][g * SN + (p & 15)];
    for (int bb = b0; bb < MS; bb += 4 * bstep) {
        if (bb != b0) {
#pragma unroll
            for (int k = 0; k < 4; ++k) { const int b = bb + k * bstep;
                if (b < MS) { uq[k] = PSl[(size_t)b * INC]; xq[k] = args.in[3][(size_t)(b * SG + g) * SP + p]; yq[k] = args.in[4][(size_t)(b * SG + g) * SP + p]; } }
        }
#pragma unroll
        for (int k = 0; k < 4; ++k) { const int b = bb + k * bstep;
            if (b < MS) {
                float un = uq[k]; un += __shfl_xor(un, 16); un += __shfl_xor(un, 32);
                const float x0r = xq[k], x0i = yq[k];
                float bur = 0.f, bui = 0.f;
#pragma unroll
                for (int n = 0; n < SN; ++n) { const float u = __builtin_bit_cast(float, __builtin_amdgcn_readlane(__builtin_bit_cast(int, un), n)); bur += br[n] * u; bui += bi[n] * u; }
                const float xr = ar * x0r - ai * x0i + bur, xi = ar * x0i + ai * x0r + bui;
                float yv = 0.f;
#pragma unroll
                for (int n = 0; n < SN; ++n) { const float sm = wave_sum(crv[n] * xr - civ[n] * xi); if ((p & 15) == n) yv = sm; }
                F.out[O_RES + (size_t)(b * SG + g) * SP + p] = xr; F.out[O_IMS + (size_t)(b * SG + g) * SP + p] = xi;
                if (p < 16) { const float y = yv + dnv * un; Y[(size_t)(MP + b) * SW + g * SN + p] = (bf16)f2bf(gelu_tanh(y)); }
            }
        }
    }
}
constexpr int S5_XLOC = 0, S5_XIN = 8192, S5_XIM = 32768;
__device__ __forceinline__ void s5_unit(Frame& F, const Args& args, int b, int g) {
    LAS unsigned char* lds = F.lds;
    const bf16* UBg = (const bf16*)(F.ws + WS_UB) + (size_t)g * MPAD * 16; bf16* Y = (bf16*)(F.ws + WS_Y);
    const float* tar = (const float*)(F.ws + WS_TAB + TB_AR); const float* tai = (const float*)(F.ws + WS_TAB + TB_AI);
    const float* tbr = (const float*)(F.ws + WS_TAB + TB_BR); const float* tbi = (const float*)(F.ws + WS_TAB + TB_BI);
    const int w = F.wave, lane = launder(F.lane), c = lane & 31, h = lane >> 5;
    const size_t rb = (size_t)b * SEQ;
    bf16x8 bfr[4];
#pragma unroll
    for (int f = 0; f < 4; ++f) { const float* src = ((f >> 1) ? tbi : tbr) + (size_t)(g * SP + c + 32 * (f & 1)) * SN + 8 * h;
        const f32x4 v0 = *(const f32x4*)src, v1 = *(const f32x4*)(src + 4);
        v4u t; t.x = cvtpk(v0[0], v0[1]); t.y = cvtpk(v0[2], v0[3]); t.z = cvtpk(v1[0], v1[1]); t.w = cvtpk(v1[2], v1[3]); bfr[f] = __builtin_bit_cast(bf16x8, t); }
    float ar[2], ai[2];
#pragma unroll
    for (int ps = 0; ps < 2; ++ps) { ar[ps] = tar[g * SP + c + 32 * ps]; ai[ps] = tai[g * SP + c + 32 * ps]; }
    const int rho = lane & 31, hr = (rho >> 2) & 1, ir = (rho & 3) + 4 * (rho >> 3);
    const bf16* arow = UBg + (rb + 128 * (size_t)(2 * w + hr) + ir) * 16 + 8 * h;
    f32x16 zero16;
#pragma unroll
    for (int i = 0; i < 16; ++i) zero16[i] = 0.f;
    float xr[2] = {0.f, 0.f}, xi[2] = {0.f, 0.f};
    bf16x8 afr[8];
#pragma unroll
    for (int blk = 0; blk < 8; ++blk) afr[blk] = *(const bf16x8*)(arow + (size_t)blk * 256);
#pragma unroll
    for (int blk = 0; blk < 8; ++blk) {
        const bf16x8 A = afr[blk];
        f32x16 bu[4];
#pragma unroll
        for (int f = 0; f < 4; ++f) bu[f] = MFMA32(A, bfr[f], zero16);
#pragma unroll
        for (int i = 0; i < 16; ++i)
#pragma unroll
            for (int ps = 0; ps < 2; ++ps) { const float nr = fmaf(ar[ps], xr[ps], fmaf(-ai[ps], xi[ps], bu[ps][i])), ni = fmaf(ar[ps], xi[ps], fmaf(ai[ps], xr[ps], bu[2 + ps][i])); xr[ps] = nr; xi[ps] = ni; }
    }
    LAS f32x2v* xloc = (LAS f32x2v*)(lds + S5_XLOC); LAS f32x2v* xin = (LAS f32x2v*)(lds + S5_XIN);
#pragma unroll
    for (int ps = 0; ps < 2; ++ps) xloc[(2 * w + h) * 64 + c + 32 * ps] = (f32x2v){xr[ps], xi[ps]};
    LDS_WAIT(); __syncthreads();
    if (w == 0) {
        float a_r = tar[g * SP + lane], a_i = tai[g * SP + lane];
#pragma unroll
        for (int k = 0; k < 7; ++k) { const float nr = a_r * a_r - a_i * a_i, ni = 2.0f * a_r * a_i; a_r = nr; a_i = ni; }
        float sr = 0.f, si = 0.f;
        for (int sgm = 0; sgm < 16; ++sgm) { xin[sgm * 64 + lane] = (f32x2v){sr, si}; const f32x2v l = xloc[sgm * 64 + lane];
            const float nr = a_r * sr - a_i * si + l.x, ni = a_r * si + a_i * sr + l.y; sr = nr; si = ni; }
        F.out[O_REP + (size_t)(b * SG + g) * SP + lane] = sr; F.out[O_IMP + (size_t)(b * SG + g) * SP + lane] = si;
    }
    LDS_WAIT(); __syncthreads();
#pragma unroll
    for (int ps = 0; ps < 2; ++ps) { const f32x2v v = xin[(2 * w + h) * 64 + c + 32 * ps]; xr[ps] = v.x; xi[ps] = v.y; }
    bf16x8 cfr[4];
    { const int n = lane & 15, kq = lane >> 4;
#pragma unroll
      for (int ks = 0; ks < 4; ++ks) { const float* src = ((ks >> 1) ? args.in[17] : args.in[16]) + (size_t)(g * SN + n) * SP + 32 * (ks & 1) + 8 * kq; const float sgn = (ks >> 1) ? -1.0f : 1.0f;
          const f32x4 v0 = *(const f32x4*)src * sgn, v1 = *(const f32x4*)(src + 4) * sgn;
          v4u t; t.x = cvtpk(v0[0], v0[1]); t.y = cvtpk(v0[2], v0[3]); t.z = cvtpk(v1[0], v1[1]); t.w = cvtpk(v1[2], v1[3]); cfr[ks] = __builtin_bit_cast(bf16x8, t); } }
    const int tq = lane & 15, nq = lane >> 4;
    const f32x4 dn = *(const f32x4*)(args.in[18] + g * SN + 4 * nq);
    LAS unsigned char* xim = lds + S5_XIM + w * 8192;
    v2u uvs[8][2];
#pragma unroll
    for (int blk = 0; blk < 8; ++blk)
#pragma unroll
        for (int sq = 0; sq < 2; ++sq) uvs[blk][sq] = *(const v2u*)(UBg + (rb + 128 * (size_t)(2 * w + sq) + 16 * blk + tq) * 16 + 4 * nq);
#pragma unroll
    for (int blk = 0; blk < 8; ++blk) {
        const bf16x8 A = afr[blk];
        f32x16 bu[4];
#pragma unroll
        for (int f = 0; f < 4; ++f) bu[f] = MFMA32(A, bfr[f], zero16);
#pragma unroll
        for (int i = 0; i < 16; ++i)
#pragma unroll
            for (int ps = 0; ps < 2; ++ps) { const float nr = fmaf(ar[ps], xr[ps], fmaf(-ai[ps], xi[ps], bu[ps][i])), ni = fmaf(ar[ps], xi[ps], fmaf(ai[ps], xr[ps], bu[2 + ps][i])); xr[ps] = nr; xi[ps] = ni; bu[ps][i] = nr; bu[2 + ps][i] = ni; }
#pragma unroll
        for (int f = 0; f < 4; ++f) { LAS unsigned char* dst = xim + h * 4096 + ((f >> 1) * 64 + (f & 1) * 32 + c) * 32;
            *(LAS bf16x8*)dst = pack8(bu[f], 0); *(LAS bf16x8*)(dst + 16) = pack8(bu[f], 1); }
        LDS_WAIT(); asm volatile("" ::: "memory");
#pragma unroll
        for (int sq = 0; sq < 2; ++sq) {
            f32x4 yT = (f32x4){0.f, 0.f, 0.f, 0.f};
#pragma unroll
            for (int ks = 0; ks < 4; ++ks) {
                LAS unsigned char* base = xim + sq * 4096 + (32 * ks + 8 * nq + (tq >> 2)) * 32 + 8 * (tq & 3);
                const bf16x8 B = cat8(lds_tr(base), lds_tr(base + 4 * 32));
                yT = MFMA16(cfr[ks], B, yT);
            }
            const size_t row = rb + 128 * (size_t)(2 * w + sq) + 16 * blk + tq;
            const v2u uv = uvs[blk][sq];
            const float y0 = gelu_tanh(yT[0] + dn[0] * bf_lo(uv.x)), y1 = gelu_tanh(yT[1] + dn[1] * bf_hi(uv.x)), y2 = gelu_tanh(yT[2] + dn[2] * bf_lo(uv.y)), y3 = gelu_tanh(yT[3] + dn[3] * bf_hi(uv.y));
            v2u wv; wv.x = cvtpk(y0, y1); wv.y = cvtpk(y2, y3); *(v2u*)(Y + row * SW + g * SN + 4 * nq) = wv;
        }
        LDS_WAIT(); asm volatile("" ::: "memory");
    }
    __syncthreads();
}
__device__ __forceinline__ void p2_phase(Frame& F, const Args& args, int mask) {
    if (mask & 1) for (int pu = F.vcu; pu < 256; pu += F.G) { const int bh = pu >> 3, jj = pu & 7; for (int k2 = 0; k2 < 2; ++k2) ret_unit(F, bh >> 3, bh & 7, k2 ? 15 - jj : jj, k2 != 0, k2 ? -1 : 15 - jj); }
    if (mask & 2) for (int u5 = F.vcu; u5 < NBATCH * SG; u5 += F.G) s5_unit(F, args, u5 >> 6, u5 & 63);
    (void)0;
    const float* PSr = (const float*)(F.ws + WS_PS);
    const int it0 = F.vcu * NTHR + F.tid, its = F.G * NTHR;
    f32x4 xs[2][4];
    if (mask & 8) {
#pragma unroll
      for (int k = 0; k < 2; ++k) { const int it = it0 + k * its;
        if (it < MS * (5120 / 4)) { const float* p = PSr + (size_t)(it / 1280) * INC + 5120 + 4 * (it % 1280);
#pragma unroll
          for (int sl = 0; sl < 4; ++sl) xs[k][sl] = *(const f32x4*)(p + (size_t)sl * PS_SLAB); } }
    }
    const int gw = F.vcu * NWAVES + F.wave, NGW = F.G * NWAVES;
    if (mask & 8) { if (NGW % SG == 0) s5_sample_wave(F, args, gw % SG, gw / SG, NGW / SG); else for (int v = gw; v < MS * SG; v += NGW) s5_sample_wave(F, args, v % SG, v / SG, MS); }
    if (mask & 8) {
      for (int it = it0, k = 0; it < MS * (5120 / 4); it += its, ++k) { const int b = it / 1280, n = 5120 + 4 * (it % 1280);
        f32x4 x;
        if (k == 0) x = (xs[0][0] + xs[0][1]) + (xs[0][2] + xs[0][3]);
        else if (k == 1) x = (xs[1][0] + xs[1][1]) + (xs[1][2] + xs[1][3]);
        else { const float* p = PSr + (size_t)b * INC + n; x = (*(const f32x4*)p + *(const f32x4*)(p + PS_SLAB)) + (*(const f32x4*)(p + 2 * PS_SLAB) + *(const f32x4*)(p + 3 * PS_SLAB)); }
        f32x4 o; for (int e = 0; e < 4; ++e) { const float sg = sigmoidf_(x[e]); o[e] = n < 6144 ? x[e] * sg : sg; }
        bf16* dst = n < 6144 ? (bf16*)(F.ws + WS_ZB) + (size_t)(MP + b) * SW + (n - 5120) : (n < 8192 ? (bf16*)(F.ws + WS_GAS) + (size_t)b * DM + (n - 6144) : (bf16*)(F.ws + WS_GBS) + (size_t)b * DM + (n - 8192));
        *(v2u*)dst = pk4(o); } }
}

template <int NT>
__device__ __forceinline__ void sk_acc(f32x4 (&acc)[NT], const bf16* X, const bf16* Wt, int K, int n0, int wave, int lane) {
    const int kq = lane >> 4;
    const bf16* xp = X + (size_t)(16 * wave + (lane & 15)) * K + 8 * kq;
    const bf16* wp = Wt + (size_t)(n0 + (lane & 15)) * K + 8 * kq;
#pragma unroll
    for (int nt = 0; nt < NT; ++nt) acc[nt] = (f32x4){0.f, 0.f, 0.f, 0.f};
#pragma unroll 8
    for (int ks = 0; ks < K / 32; ++ks) {
        const bf16x8 a = *(const bf16x8*)(xp + 32 * ks);
#pragma unroll
        for (int nt = 0; nt < NT; ++nt) { const bf16x8 bw = *(const bf16x8*)(wp + (size_t)nt * 16 * K + 32 * ks); acc[nt] = MFMA16(bw, a, acc[nt]); }
    }
}
__device__ __forceinline__ f32x4 ld4bf(const bf16* p) { const v2u w = *(const v2u*)p; return (f32x4){bf_lo(w.x), bf_hi(w.x), bf_lo(w.y), bf_hi(w.y)}; }
__device__ __forceinline__ void p3_sample_ret(Frame& F, const Args& args, int idx, int nidle, int v0, int v1) {
    f32x4 Scur[8], Snxt[8]; float pc[2], pn[2];
    const float* PS = (const float*)(F.ws + WS_PS);
    int v = v0 + idx;
    if (v < v1) ret_sample_load(Scur, pc, args.in[2] + (size_t)v * DK * DK, PS, v, F.tid);
    for (; v < v1; v += nidle) {
        const bool hasn = v + nidle < v1;
        if (hasn) ret_sample_load(Snxt, pn, args.in[2] + (size_t)(v + nidle) * DK * DK, PS, v + nidle, F.tid);
        ret_sample_unit(F, v / NH, v % NH, Scur, pc, F.out + O_RS + (size_t)v * DK * DK);
        if (hasn) { pc[0] = pn[0]; pc[1] = pn[1];
#pragma unroll
            for (int i = 0; i < 8; ++i) Scur[i] = Snxt[i]; }
    }
}
__device__ __forceinline__ void sk_p3(Frame& F, const Args& args, int idx, int nidle);
template <int KS4>
__device__ __forceinline__ void skw_acc(f32x4 (&acc)[4], const bf16* X, const bf16* Wt, int K, int k0, int n0, int lane) {
    const int kq = lane >> 4;
    const bf16* xp = X + (size_t)(lane & 15) * K + k0 + 8 * kq;
    const bf16* wp = Wt + (size_t)(n0 + (lane & 15)) * K + k0 + 8 * kq;
    bf16x8 af[KS4][4], wf[KS4];
#pragma unroll
    for (int ks = 0; ks < KS4; ++ks) { wf[ks] = *(const bf16x8*)(wp + 32 * ks);
#pragma unroll
        for (int mt = 0; mt < 4; ++mt) af[ks][mt] = *(const bf16x8*)(xp + (size_t)mt * 16 * K + 32 * ks); }
#pragma unroll
    for (int ks = 0; ks < KS4; ++ks)
#pragma unroll
        for (int mt = 0; mt < 4; ++mt) acc[mt] = MFMA16(wf[ks], af[ks][mt], acc[mt]);
}
__device__ __forceinline__ f32x4 skw_reduce(Frame& F, const f32x4 (&acc)[4], int lane) {
    LAS f32x4* red = (LAS f32x4*)F.lds;
#pragma unroll
    for (int mt = 0; mt < 4; ++mt) red[(F.wave * 64 + 16 * mt + (lane & 15)) * 4 + (lane >> 4)] = acc[mt];
    LDS_WAIT(); __syncthreads();
    f32x4 sum = (f32x4){0.f, 0.f, 0.f, 0.f};
    if (F.tid < 256) {
#pragma unroll
        for (int wv = 0; wv < 8; ++wv) sum += red[wv * 256 + F.tid]; }
    LDS_WAIT(); __syncthreads();
    return sum;
}
__device__ __forceinline__ void sk_p3(Frame& F, const Args& args, int idx, int nidle) {
    for (int task = idx; task < 2 * (SW / 16); task += nidle) {
        const int ct = task >> 1, r0 = 64 * (task & 1);
        const int lane = launder(F.lane) & 63; f32x4 acc[4];
#pragma unroll
        for (int mt = 0; mt < 4; ++mt) acc[mt] = (f32x4){0.f, 0.f, 0.f, 0.f};
        skw_acc<4>(acc, (const bf16*)(F.ws + WS_Y) + (size_t)(MP + r0) * SW, (const bf16*)(F.ws + WS_WGLU), SW, 128 * F.wave, 16 * ct, lane);
        const f32x4 gsum = skw_reduce(F, acc, lane);
        const int tid = launder(F.tid) & 511;
        if (tid < 256) { const int m = r0 + (tid >> 2), n = 16 * ct + 4 * (tid & 3); const size_t off = (size_t)(MP + m) * SW + n;
            const f32x4 gg = gsum + *(const f32x4*)(args.in[20] + n), yv = ld4bf((const bf16*)(F.ws + WS_Y) + off), zv = ld4bf((const bf16*)(F.ws + WS_ZB) + off);
            f32x4 o; for (int e = 0; e < 4; ++e) o[e] = yv[e] * sigmoidf_(gg[e]) * zv[e];
            *(v2u*)((bf16*)(F.ws + WS_AAB) + (size_t)(MP + m) * (2 * SW) + SW + n) = pk4(o); }
    }
}
__device__ __forceinline__ void sk_p4(Frame& F) {
    for (int task = F.vcu; task < 2 * (DM / 16); task += F.G) {
        const int ct = task >> 1, r0 = 64 * (task & 1);
        const int lane = launder(F.lane) & 63; f32x4 acc[4];
        const bf16* X = (const bf16*)(F.ws + WS_AAB) + (size_t)(MP + r0) * 2 * RW;
#pragma unroll
        for (int mt = 0; mt < 4; ++mt) acc[mt] = (f32x4){0.f, 0.f, 0.f, 0.f};
        skw_acc<4>(acc, X, (const bf16*)(F.ws + WS_WPA), 2 * RW, 128 * F.wave, 16 * ct, lane);
        const f32x4 ya = skw_reduce(F, acc, lane);
#pragma unroll
        for (int mt = 0; mt < 4; ++mt) acc[mt] = (f32x4){0.f, 0.f, 0.f, 0.f};
        skw_acc<4>(acc, X, (const bf16*)(F.ws + WS_WPA), 2 * RW, RW + 128 * F.wave, 16 * ct, lane);
        const f32x4 yb = skw_reduce(F, acc, lane);
        const int tid = launder(F.tid) & 511;
        if (tid < 256) { const size_t goff = (size_t)(r0 + (tid >> 2)) * DM + 16 * ct + 4 * (tid & 3), off = goff + (size_t)MP * DM;
            const f32x4 o = ld4bf((const bf16*)(F.ws + WS_GAS) + goff) * ya + ld4bf((const bf16*)(F.ws + WS_GBS) + goff) * yb;
            *(v2u*)((bf16*)(F.ws + WS_MRG) + off) = pk4(o); }
    }
}
__device__ __forceinline__ void sk_p5(Frame& F) {
    for (int task = F.vcu; task < 2 * (DM / 16); task += F.G) {
        const int ct = task >> 1, r0 = 64 * (task & 1);
        const int lane = launder(F.lane) & 63; f32x4 acc[4];
        const bf16* X = (const bf16*)(F.ws + WS_MRG) + (size_t)(MP + r0) * DM;
#pragma unroll
        for (int mt = 0; mt < 4; ++mt) acc[mt] = (f32x4){0.f, 0.f, 0.f, 0.f};
        skw_acc<4>(acc, X, (const bf16*)(F.ws + WS_WOUT), DM, 256 * F.wave, 16 * ct, lane);
        skw_acc<4>(acc, X, (const bf16*)(F.ws + WS_WOUT), DM, 256 * F.wave + 128, 16 * ct, lane);
        const f32x4 o = skw_reduce(F, acc, lane);
        const int tid = launder(F.tid) & 511;
        if (tid < 256) *(v2u*)((bf16*)(F.ws + WS_OUT) + (size_t)(MP + r0 + (tid >> 2)) * DM + 16 * ct + 4 * (tid & 3)) = pk4(o);
    }
}

__device__ __forceinline__ void p6_load(v2u (&ov)[8], f32x4 (&xv)[8], const bf16* OUT, const Args& args, int m, int lane) {
    const float* xrow = m < MP ? args.in[0] + (size_t)m * DM : args.in[1] + (size_t)(m - MP) * DM;
    const GAS v2u* orow = (const GAS v2u*)(OUT + (size_t)m * DM) + lane; const GAS f32x4* xr = (const GAS f32x4*)xrow + lane;
#pragma unroll
    for (int j = 0; j < 8; ++j) { ov[j] = orow[64 * j]; xv[j] = __builtin_nontemporal_load(xr + 64 * j); }
}
__device__ __forceinline__ void p6_final(Frame& F, const Args& args) {
    const bf16* OUT = (const bf16*)(F.ws + WS_OUT);
    const int gw = F.vcu * NWAVES + F.wave, NGW = F.G * NWAVES;
    f32x4 gq[8];
    { const GAS f32x4* gr = (const GAS f32x4*)args.in[10] + F.lane;
#pragma unroll
      for (int j = 0; j < 8; ++j) gq[j] = gr[64 * j]; }
    v2u oa[8], ob[8]; f32x4 xa[8], xb[8];
    int m = gw;
    if (m < MV) p6_load(oa, xa, OUT, args, m, F.lane);
    for (; m < MV; m += NGW) {
        const bool hasn = m + NGW < MV;
        if (hasn) p6_load(ob, xb, OUT, args, m + NGW, F.lane);
        float* yrow = m < MP ? F.out + O_YP + (size_t)m * DM : F.out + O_YS + (size_t)(m - MP) * DM;
        f32x4 v[8]; float s = 0.f;
#pragma unroll
        for (int j = 0; j < 8; ++j) { v[j] = (f32x4){bf_lo(oa[j].x), bf_hi(oa[j].x), bf_lo(oa[j].y), bf_hi(oa[j].y)}; s += (v[j].x * v[j].x + v[j].y * v[j].y) + (v[j].z * v[j].z + v[j].w * v[j].w); }
        const float rstd = 1.0f / sqrtf(wave_sum(s) * (1.f / DM) + EPSF);
        GAS f32x4* yo = (GAS f32x4*)yrow + F.lane;
#pragma unroll
        for (int j = 0; j < 8; ++j) __builtin_nontemporal_store(xa[j] + v[j] * rstd * gq[j], yo + 64 * j);
        if (hasn) {
#pragma unroll
            for (int j = 0; j < 8; ++j) { oa[j] = ob[j]; xa[j] = xb[j]; } }
    }
}

__global__ void __launch_bounds__(NTHR, 2) fwd_kernel(Args args) {
    extern __shared__ __attribute__((aligned(16))) unsigned char lds[];
    Frame F;
    F.lds = (LAS unsigned char*)lds;
    F.MISC = (volatile LAS unsigned*)(F.lds + MISC_OFF);
    F.tid = threadIdx.x; F.lane = F.tid & 63; F.wave = __builtin_amdgcn_readfirstlane(F.tid >> 6);
    F.G = gridDim.x; { const int bx = blockIdx.x; F.vcu = (F.G % 8 == 0) ? (bx % 8) * (F.G / 8) + bx / 8 : bx; }
    F.out = args.out; F.ws = args.ws;
    for (int u = F.tid; u < (LDS_BYTES - LDSCTL_OFF) / 4; u += NTHR) ((LAS unsigned*)(F.lds + LDSCTL_OFF))[u] = 0u;
    __syncthreads();
    unsigned* ctl = (unsigned*)(args.ws + WS_CTL);
    XcdBarrier bar; bar.bar = ctl + CW_BAR + args.li * XCD_BAR_WORDS; bar.x = 0; bar.st = nullptr;
    const int lo = args.ph_lo, hi = args.ph_hi;
    if (hi - lo > 1) bar = xcd_barrier_post(ctl + CW_BAR + args.li * XCD_BAR_WORDS, F.MISC + 8);
#define IN(k) (lo <= (k) && (k) < hi)
#define BOTH(k) (IN(k) && IN((k) + 1))
#define GRID_BAR() xcd_barrier(bar)

    if (IN(0)) for (int rep = 0; rep < (REP_PHASE == 0 ? 2 : 1); ++rep) { p0_prologue(F, args); if (BOTH(0)) GRID_BAR(); }

    if (IN(1)) for (int rep = 0; rep < (REP_PHASE == 1 ? 2 : 1); ++rep) {
        pg8::Gemm g{(const bf16*)(F.ws + WS_H), (const bf16*)(F.ws + WS_WIN), nullptr, nullptr, DM};
        pg8::ProjOrder S; S.init(MP, INC, F.G, (int)blockIdx.x);
        EpiProj E{(bf16*)(F.ws + WS_Q), (bf16*)(F.ws + WS_K), (bf16*)(F.ws + WS_V), (bf16*)(F.ws + WS_ZA), (bf16*)(F.ws + WS_UB), (bf16*)(F.ws + WS_ZB), (bf16*)(F.ws + WS_GA), (bf16*)(F.ws + WS_GB),
                  (const float*)(F.ws + WS_TAB + TB_COS), (const float*)(F.ws + WS_TAB + TB_SIN), (float*)(F.ws + WS_PS)};
        { const int nun = MP / 256 * (INC / 256) + 4 * (INC / 256), rem = nun % F.G;
          if (rem == 0) p1_convert_rest(F, args, (int)blockIdx.x, F.G); else if ((int)blockIdx.x >= rem) p1_convert_rest(F, args, (int)blockIdx.x - rem, F.G - rem);
          __syncthreads(); }
        pg8::gemm_phase<EpiProj, pg8::ProjOrder, true, true>(F.lds, g, S, E);
        if (BOTH(1)) GRID_BAR();
    }

    if (IN(2)) for (int rep = 0; rep < (REP_PHASE == 2 ? 2 : 1); ++rep) { p2_phase(F, args, args.pad ? args.pad : 15); if (BOTH(2)) GRID_BAR(); }

    if (IN(3)) for (int rep = 0; rep < (REP_PHASE == 3 ? 2 : 1); ++rep) {
        pg8::Gemm g{(const bf16*)(F.ws + WS_Y), (const bf16*)(F.ws + WS_WGLU), nullptr, nullptr, SW};
        pg8::StaticOrder S; S.init(MP, SW, F.G, (int)blockIdx.x);
        EpiGlu E{(const bf16*)(F.ws + WS_Y), (const bf16*)(F.ws + WS_ZB), (bf16*)(F.ws + WS_AAB), args.in[20]};
        pg8::gemm_phase<EpiGlu, pg8::StaticOrder, true, true>(F.lds, g, S, E);
        if (F.G > 128) { if ((int)blockIdx.x >= 128) sk_p3(F, args, (int)blockIdx.x - 128, F.G - 128); } else sk_p3(F, args, (int)blockIdx.x, F.G);
        if (F.G == 256) { if ((int)blockIdx.x >= 128) p3_sample_ret(F, args, (int)blockIdx.x - 128, 128, 0, 768); else p3_sample_ret(F, args, (int)blockIdx.x, 128, 768, MS * NH); }
        else if (F.G > 128) { if ((int)blockIdx.x >= 128) p3_sample_ret(F, args, (int)blockIdx.x - 128, F.G - 128, 0, MS * NH); } else p3_sample_ret(F, args, (int)blockIdx.x, F.G, 0, MS * NH);
        if (BOTH(3)) GRID_BAR();
    }

    if (IN(4)) for (int rep = 0; rep < (REP_PHASE == 4 ? 2 : 1); ++rep) {
        pg8::Gemm g{(const bf16*)(F.ws + WS_AAB), (const bf16*)(F.ws + WS_WPA), nullptr, nullptr, 2 * RW};
        pg8::StaticOrder S; S.init(MP, DM, F.G, (int)blockIdx.x);
        EpiMerge E{(const unsigned char*)(F.ws + WS_G8A), (const unsigned char*)(F.ws + WS_G8B), (bf16*)(F.ws + WS_MRG)};
        sk_p4(F);
        pg8::gemm_phase<EpiMerge, pg8::StaticOrder, true, true>(F.lds, g, S, E);
        if (BOTH(4)) GRID_BAR();
    }

    const bool fuse5 = false;
    if (IN(5)) for (int rep = 0; rep < (REP_PHASE == 5 ? 2 : 1); ++rep) {
        pg8::Gemm g{(const bf16*)(F.ws + WS_MRG), (const bf16*)(F.ws + WS_WOUT), nullptr, nullptr, DM};
        pg8::StaticOrder S; S.init(MP, DM, F.G, (int)blockIdx.x);
        {
            EpiOutBf16 E{(bf16*)(F.ws + WS_OUT), DM};
            pg8::gemm_phase<EpiOutBf16, pg8::StaticOrder, true, true>(F.lds, g, S, E);
            sk_p5(F);
            if (BOTH(5)) GRID_BAR();
        }
    }

    if (IN(6) && !fuse5) for (int rep = 0; rep < (REP_PHASE == 6 ? 2 : 1); ++rep) { p6_final(F, args); if (REP_PHASE == 6 && rep == 0) GRID_BAR(); }
#undef IN
#undef BOTH
#undef GRID_BAR
}

extern "C" void kernel_launch(void* const* d_in, const int* in_sizes, int n_in, void* d_out, int out_size, void* d_ws, size_t ws_size, hipStream_t stream) {
    static int grid = 0;
    if (grid == 0) {
        if (n_in != 21 || out_size != (int)O_END || ws_size < WS_END2) { fprintf(stderr, "kernel_launch: unexpected shapes: n_in %d out %d ws %zu\n", n_in, out_size, ws_size); grid = -1; return; }
        int dev = 0, cus = 0, per_cu = 0;
        if (hipGetDevice(&dev) != hipSuccess || hipDeviceGetAttribute(&cus, hipDeviceAttributeMultiprocessorCount, dev) != hipSuccess) { grid = -1; return; }
        if (hipFuncSetAttribute((const void*)fwd_kernel, hipFuncAttributeMaxDynamicSharedMemorySize, LDS_BYTES) != hipSuccess) { fprintf(stderr, "kernel_launch: hipFuncSetAttribute failed\n"); grid = -1; return; }
        if (hipOccupancyMaxActiveBlocksPerMultiprocessor(&per_cu, (const void*)fwd_kernel, NTHR, LDS_BYTES) != hipSuccess || per_cu < 1) { fprintf(stderr, "kernel_launch: occupancy query says %d\n", per_cu); (void)hipGetLastError(); grid = -1; return; }
        grid = cus;
    }
    if (grid < 0) return;
    (void)hipMemsetAsync((char*)d_ws + WS_CTL, 0, CTL_ZERO_BYTES, stream);
    Args a{};
    for (int i = 0; i < 21; ++i) a.in[i] = (const float*)d_in[i];
    a.out = (float*)d_out; a.ws = (unsigned char*)d_ws;
#if MK_N_LAUNCHES == 1
    a.ph_lo = 0; a.ph_hi = N_PHASES; a.li = 0;
    hipLaunchKernelGGL(fwd_kernel, dim3(grid), dim3(NTHR), LDS_BYTES, stream, a);
#else
    { const int seq[] = {PROBE_SEQ};
      for (unsigned q = 0; q < sizeof(seq) / sizeof(seq[0]); ++q) { a.ph_lo = seq[q] & 15; a.ph_hi = (seq[q] & 15) + 1; a.li = 0; a.pad = seq[q] >> 4; hipLaunchKernelGGL(fwd_kernel, dim3(grid), dim3(NTHR), LDS_BYTES, stream, a); } }
#endif
}
```

```cpp
#include <hip/hip_runtime.h>
#include <cstdio>
#include <cstdint>

#ifndef MK_N_LAUNCHES
#define MK_N_LAUNCHES 1
#endif
#ifndef PROBE_SEQ
#define PROBE_SEQ 0, 1, 2, 3, 4, 5, 6
#endif
#ifndef REP_PHASE
#define REP_PHASE -1
#endif

namespace pg8 {
#define PG8_LAS __attribute__((address_space(3)))
typedef unsigned short bf16_t;
typedef short bf16x8 __attribute__((ext_vector_type(8)));
typedef float f32x4 __attribute__((ext_vector_type(4)));
typedef float f32x2 __attribute__((ext_vector_type(2)));
typedef unsigned u32x4 __attribute__((ext_vector_type(4)));
typedef unsigned u32x2 __attribute__((ext_vector_type(2)));
constexpr int BM = 256, BK = 64, HALF = 128, HTB = HALF * BK * 2, STAGE_BYTES = 8 * HTB, NXCD = 8, WGM = 8;

__host__ __device__ __forceinline__ int lds_byte(int r, int c) { const int st = (r >> 4) * 2 + (c >> 5), rr = r & 15, cc = c & 31, ob = rr * 64 + cc * 2; return st * 1024 + (ob ^ (((ob >> 9) & 1) << 5)); }
__host__ __device__ __forceinline__ void stage_rc(int b, int& R, int& C) { const int st = b / 1024, sb = b % 1024, swz = sb ^ (((sb >> 9) & 1) << 5); R = (st >> 1) * 16 + swz / 64; C = (st & 1) * 32 + (swz % 64) / 2; }
__host__ __device__ __forceinline__ int perm32(int rho) { const int n = rho >> 4, i = rho & 15; return 8 * (i >> 2) + 4 * n + (i & 3); }

struct Unit { int pm, pn, z; };
struct Gemm { const bf16_t* A0; const bf16_t* B0; const bf16_t* A1; const bf16_t* B1; int K; };

struct StaticOrder {
    int nM, nN, nwg, G, c;
    __host__ __device__ void init(int M, int N, int G_, int c_) { nM = M / BM; nN = N / BM; nwg = nM * nN; G = G_; c = c_; }
    __host__ __device__ bool next(int i, Unit& u) const {
        const long L = (long)i * G + c; if (L >= nwg) return false;
        int wgid = (int)L; { const int q = nwg / NXCD, r = nwg % NXCD, xcd = wgid % NXCD, off = wgid / NXCD; wgid = (xcd < r ? xcd * (q + 1) : r * (q + 1) + (xcd - r) * q) + off; }
        const int nig = WGM * nN, gid = wgid / nig, fm = gid * WGM, gsz = (nM - fm) < WGM ? (nM - fm) : WGM;
        u.pm = fm + ((wgid % nig) % gsz); u.pn = (wgid % nig) / gsz; u.z = 0; return true;
    }
    __host__ __device__ int kofs(const Unit&, int) const { return 0; }
    __host__ __device__ int ktiles(const Unit&, int K) const { return K / BK; }
};
struct ProjOrder {
    StaticOrder so; int G, c;
    __host__ __device__ void init(int M, int N, int G_, int c_) { so.init(M, N, G_, c_); G = G_; c = c_; }
    __host__ __device__ bool next(int i, Unit& u) const {
        const long L = (long)i * G + c;
        if (L < so.nwg) return so.next(i, u);
        const int si = (int)(L - so.nwg); if (si >= 4 * so.nN) return false;
        u.pm = so.nM; u.pn = si % so.nN; u.z = 1 + si / so.nN; return true;
    }
    __host__ __device__ int kofs(const Unit& u, int) const { return u.z ? (u.z - 1) * 512 : 0; }
    __host__ __device__ int ktiles(const Unit& u, int K) const { return u.z ? 512 / BK : K / BK; }
};
struct PairOrder {
    int nM, nN, ntile, G, c;
    __host__ __device__ void init(int M, int N, int G_, int c_) { nM = M / BM; nN = N / BM; ntile = nM * nN; G = G_; c = c_; }
    __host__ __device__ bool next(int i, Unit& u) const {
        const long T = (long)(i >> 1) * G + c; if (T >= ntile) return false;
        u.pm = (int)(T % nM); u.pn = (int)(T / nM); u.z = i & 1; return true;
    }
    __host__ __device__ int kofs(const Unit&, int) const { return 0; }
    __host__ __device__ int ktiles(const Unit&, int K) const { return K / BK; }
};

__device__ __forceinline__ unsigned cvt_pk_bf16(float lo, float hi) { unsigned r; asm volatile("v_cvt_pk_bf16_f32 %0, %1, %2" : "=v"(r) : "v"(lo), "v"(hi)); return r; }
__device__ __forceinline__ float bf_lo(unsigned w) { return __uint_as_float(w << 16); }
__device__ __forceinline__ float bf_hi(unsigned w) { return __uint_as_float(w & 0xffff0000u); }
__device__ __forceinline__ float sigmoidf_(float x) { return __builtin_amdgcn_rcpf(1.0f + __expf(-x)); }

template <class Epi, class Sched, bool ALIGN_EPI = false, bool SP2 = false>
__device__ __forceinline__ void gemm_phase(PG8_LAS unsigned char* lds, const Gemm g, const Sched& S, const Epi& E) {
    const int tid = threadIdx.x, wid = __builtin_amdgcn_readfirstlane(tid >> 6), lane = tid & 63, wr = wid >> 2, wc = wid & 3, fr = lane & 15, fq = lane >> 4;
    const int K = g.K;
    unsigned voffA[2], voffB[2];
#pragma unroll
    for (int i = 0; i < 2; ++i) { int R, C; stage_rc(tid * 16 + i * 8192, R, C); const int Rb = Epi::PERM ? ((R & ~31) + perm32(R & 31)) : R;
        voffA[i] = (unsigned)(R * K + C) * 2u; voffB[i] = (unsigned)(Rb * K + C) * 2u; }
    const size_t kstep = (size_t)(BK * 2);
    const size_t hstep = (size_t)HALF * K * 2;
    const size_t tstep = 2 * hstep;
    const unsigned ldsw = (unsigned)wid * 1024u;
    const int aoff = lds_byte(wr * 64 + fr, fq * 8), boff = lds_byte(wc * 32 + fr, fq * 8);
#define PG8_SA(b, h) (((b) * 2 + (h)) * HTB)
#define PG8_SB(b, h) ((4 + (b) * 2 + (h)) * HTB)
#define PG8_STAGE(bufoff, gbase, voff) do { _Pragma("unroll") for (int _i = 0; _i < 2; ++_i) \
        __builtin_amdgcn_global_load_lds((const unsigned*)((const char*)(gbase) + (voff)[_i]), (PG8_LAS unsigned*)(lds + (bufoff) + ldsw + _i * 8192), 16, 0, 0); } while (0)
#define PG8_LDA(dst, b, h) do { _Pragma("unroll") for (int m = 0; m < 4; ++m) _Pragma("unroll") for (int k = 0; k < 2; ++k) dst[m][k] = *(const PG8_LAS bf16x8*)(lds + PG8_SA(b, h) + aoff + m * 2048 + k * 1024); } while (0)
#define PG8_LDB(dst, b, h) do { _Pragma("unroll") for (int n = 0; n < 2; ++n) _Pragma("unroll") for (int k = 0; k < 2; ++k) dst[n][k] = *(const PG8_LAS bf16x8*)(lds + PG8_SB(b, h) + boff + n * 2048 + k * 1024); } while (0)
#define PG8_MMA(ai, bj, At, Bt) do { __builtin_amdgcn_s_setprio(1); _Pragma("unroll") for (int m = 0; m < 4; ++m) _Pragma("unroll") for (int n = 0; n < 2; ++n) _Pragma("unroll") for (int k = 0; k < 2; ++k) \
        acc[ai][bj][m][n] = __builtin_amdgcn_mfma_f32_16x16x32_bf16(Bt[n][k], At[m][k], acc[ai][bj][m][n], 0, 0, 0); __builtin_amdgcn_s_setprio(0); } while (0)
#define PG8_WAIT_V(n) asm volatile("s_waitcnt vmcnt(" #n ")" ::: "memory")
#define PG8_WAIT_L(n) asm volatile("s_waitcnt lgkmcnt(" #n ")" ::: "memory")
#define PG8_BAR __builtin_amdgcn_s_barrier()
#define PG8_SCHED __builtin_amdgcn_sched_barrier(0)
#define PG8_PA(u) ((const char*)(((u).z && g.A1) ? g.A1 : g.A0) + (size_t)(u).pm * tstep + (size_t)S.kofs(u, K) * 2)
#define PG8_PB(u) ((const char*)(((u).z && g.B1) ? g.B1 : g.B0) + (size_t)(u).pn * tstep + (size_t)S.kofs(u, K) * 2)
    Unit cur, nxt; int ui = 0;
    if (!S.next(0, cur)) return;
    f32x4 acc[2][2][4][2];
#pragma unroll
    for (int a = 0; a < 2; ++a)
#pragma unroll
        for (int b = 0; b < 2; ++b)
#pragma unroll
            for (int m = 0; m < 4; ++m)
#pragma unroll
                for (int n = 0; n < 2; ++n) acc[a][b][m][n] = (f32x4){0.f, 0.f, 0.f, 0.f};
    bf16x8 At[4][2], B0[2][2], B1[2][2];
    const char* cA = PG8_PA(cur); const char* cB = PG8_PB(cur);
    if constexpr (SP2) {
        PG8_STAGE(PG8_SB(0, 0), cB, voffB); PG8_STAGE(PG8_SB(0, 1), cB + hstep, voffB); PG8_STAGE(PG8_SA(0, 0), cA, voffA); PG8_STAGE(PG8_SA(0, 1), cA + hstep, voffA);
        if (wr == 1) PG8_BAR;
        PG8_WAIT_V(2); PG8_BAR;
        PG8_STAGE(PG8_SB(1, 0), cB + kstep, voffB); PG8_STAGE(PG8_SA(1, 0), cA + kstep, voffA); PG8_STAGE(PG8_SB(1, 1), cB + hstep + kstep, voffB);
        PG8_WAIT_V(6); PG8_BAR;
    } else {
        PG8_STAGE(PG8_SB(0, 0), cB, voffB); PG8_STAGE(PG8_SA(0, 0), cA, voffA); PG8_STAGE(PG8_SB(0, 1), cB + hstep, voffB); PG8_STAGE(PG8_SA(0, 1), cA + hstep, voffA);
        if (wr == 1) PG8_BAR;
        PG8_WAIT_V(4); PG8_BAR;
        PG8_STAGE(PG8_SB(1, 0), cB + kstep, voffB); PG8_STAGE(PG8_SA(1, 0), cA + kstep, voffA); PG8_STAGE(PG8_SB(1, 1), cB + hstep + kstep, voffB);
        PG8_WAIT_V(6); PG8_BAR;
    }
    for (;;) {
        const bool has_next = S.next(ui + 1, nxt);
        const char* nA = has_next ? PG8_PA(nxt) : cA; const char* nB = has_next ? PG8_PB(nxt) : cB;
        const int nt = S.ktiles(cur, K);
        for (int t = 0; t < nt; t += 2) {
            if constexpr (Epi::MIDHOOK) { if (t == nt / 2) E.mid(acc, cur, wr, wc, fr, fq); }
            const bool last = (t == nt - 2);
            const char* a1 = cA + (size_t)(t + 1) * kstep;
            const char* a2 = last ? nA : cA + (size_t)(t + 2) * kstep; const char* b2 = last ? nB : cB + (size_t)(t + 2) * kstep;
            const char* a3 = a2 + kstep; const char* b3 = b2 + kstep;
            if constexpr (SP2) {
            PG8_LDB(B0, 0, 0); PG8_LDB(B1, 0, 1); PG8_SCHED; PG8_LDA(At, 0, 0); PG8_STAGE(PG8_SA(1, 1), a1 + hstep, voffA);
            PG8_WAIT_V(8); PG8_WAIT_L(0); PG8_BAR; PG8_MMA(0, 0, At, B0); PG8_MMA(0, 1, At, B1); PG8_BAR; PG8_SCHED;
            PG8_LDA(At, 0, 1); PG8_STAGE(PG8_SB(0, 0), b2, voffB); PG8_STAGE(PG8_SB(0, 1), b2 + hstep, voffB); PG8_STAGE(PG8_SA(0, 0), a2, voffA);
            PG8_WAIT_V(8); PG8_WAIT_L(0); PG8_BAR; PG8_MMA(1, 0, At, B0); PG8_MMA(1, 1, At, B1); PG8_BAR; PG8_SCHED;
            PG8_LDB(B0, 1, 0); PG8_LDB(B1, 1, 1); PG8_SCHED; PG8_LDA(At, 1, 0); PG8_STAGE(PG8_SA(0, 1), a2 + hstep, voffA);
            PG8_WAIT_V(8); PG8_WAIT_L(0); PG8_BAR; PG8_MMA(0, 0, At, B0); PG8_MMA(0, 1, At, B1); PG8_BAR; PG8_SCHED;
            PG8_LDA(At, 1, 1); PG8_STAGE(PG8_SB(1, 0), b3, voffB); PG8_STAGE(PG8_SB(1, 1), b3 + hstep, voffB); PG8_STAGE(PG8_SA(1, 0), a3, voffA);
            PG8_WAIT_V(8); PG8_WAIT_L(0); PG8_BAR; PG8_MMA(1, 0, At, B0); PG8_MMA(1, 1, At, B1); PG8_BAR; PG8_SCHED;
            } else {
            PG8_LDB(B0, 0, 0); PG8_SCHED; PG8_LDA(At, 0, 0); PG8_STAGE(PG8_SA(1, 1), a1 + hstep, voffA);
            PG8_WAIT_L(8); PG8_BAR; PG8_WAIT_L(0); PG8_MMA(0, 0, At, B0); PG8_BAR; PG8_SCHED;
            PG8_LDB(B1, 0, 1); PG8_STAGE(PG8_SB(0, 0), b2, voffB);
            PG8_BAR; PG8_WAIT_L(0); PG8_MMA(0, 1, At, B1); PG8_BAR;
            PG8_LDA(At, 0, 1); PG8_STAGE(PG8_SA(0, 0), a2, voffA);
            PG8_BAR; PG8_WAIT_L(0); PG8_MMA(1, 0, At, B0); PG8_BAR; PG8_SCHED;
            PG8_STAGE(PG8_SB(0, 1), b2 + hstep, voffB);
            PG8_WAIT_V(6); PG8_BAR; PG8_MMA(1, 1, At, B1); PG8_BAR;
            PG8_LDB(B0, 1, 0); PG8_SCHED; PG8_LDA(At, 1, 0); PG8_STAGE(PG8_SA(0, 1), a2 + hstep, voffA);
            PG8_WAIT_L(8); PG8_BAR; PG8_WAIT_L(0); PG8_MMA(0, 0, At, B0); PG8_BAR; PG8_SCHED;
            PG8_LDB(B1, 1, 1); PG8_STAGE(PG8_SB(1, 0), b3, voffB);
            PG8_BAR; PG8_WAIT_L(0); PG8_MMA(0, 1, At, B1); PG8_BAR;
            PG8_LDA(At, 1, 1); PG8_STAGE(PG8_SA(1, 0), a3, voffA);
            PG8_BAR; PG8_WAIT_L(0); PG8_MMA(1, 0, At, B0); PG8_BAR; PG8_SCHED;
            PG8_STAGE(PG8_SB(1, 1), b3 + hstep, voffB);
            PG8_WAIT_V(6); PG8_BAR; PG8_MMA(1, 1, At, B1); PG8_BAR;
            }
        }
        if constexpr (ALIGN_EPI) { if (wr == 0) PG8_BAR; }
        if constexpr (!Epi::AFTER_DRAIN) E(acc, cur, wr, wc, fr, fq);
        if (!has_next) break;
#pragma unroll
        for (int a = 0; a < 2; ++a)
#pragma unroll
            for (int b = 0; b < 2; ++b)
#pragma unroll
                for (int m = 0; m < 4; ++m)
#pragma unroll
                    for (int n = 0; n < 2; ++n) acc[a][b][m][n] = (f32x4){0.f, 0.f, 0.f, 0.f};
        cur = nxt; cA = nA; cB = nB; ++ui;
        if constexpr (ALIGN_EPI) { if (wr == 1) PG8_BAR; }
    }
    PG8_WAIT_V(0);
    __builtin_amdgcn_s_waitcnt(0x0F70);
    if constexpr (!ALIGN_EPI) { if (wr == 0) PG8_BAR; }
    PG8_BAR;
    if constexpr (Epi::AFTER_DRAIN) E.fused(acc, cur, wr, wc, fr, fq, lds, wid, lane);
#undef PG8_SA
#undef PG8_SB
#undef PG8_STAGE
#undef PG8_LDA
#undef PG8_LDB
#undef PG8_MMA
#undef PG8_WAIT_V
#undef PG8_WAIT_L
#undef PG8_BAR
#undef PG8_SCHED
#undef PG8_PA
#undef PG8_PB
}
}

constexpr int NWAVES = 8, NTHR = NWAVES * 64;
constexpr int DM = 2048, SEQ = 2048, NBATCH = 4, MP = NBATCH * SEQ, MS = 128, MV = MP + MS, MPAD = 8448;
constexpr int RW = 1024, NH = 8, DK = 128, SW = 1024, SG = 64, SP = 64, SN = 16;
constexpr int INC = 10240;
constexpr int POS_S = 16384;
constexpr float EPSF = 1e-6f;
constexpr int N_PHASES = 7;

constexpr size_t O_YP = 0, O_YS = O_YP + (size_t)MP * DM, O_RP = O_YS + (size_t)MS * DM, O_REP = O_RP + (size_t)NBATCH * NH * DK * DK,
                 O_IMP = O_REP + (size_t)NBATCH * SG * SP, O_RS = O_IMP + (size_t)NBATCH * SG * SP, O_RES = O_RS + (size_t)MS * NH * DK * DK,
                 O_IMS = O_RES + (size_t)MS * SG * SP, O_END = O_IMS + (size_t)MS * SG * SP;
static_assert(O_END == 35422208, "output size");

constexpr size_t MiB = 1u << 20;
constexpr size_t WS_CTL = 0, CTL_ZERO_BYTES = 64 * 1024;
constexpr size_t WS_WIN = 1 * MiB;
constexpr size_t WS_WPA = WS_WIN + 40 * MiB;
constexpr size_t WS_WPB = WS_WPA + 4 * MiB;
constexpr size_t WS_WOUT = WS_WPB + 4 * MiB;
constexpr size_t WS_WGLU = WS_WOUT + 8 * MiB;
constexpr size_t WS_TAB = WS_WGLU + 2 * MiB;
constexpr size_t ACT1 = (size_t)MPAD * 1024 * 2;
constexpr size_t WS_H = WS_TAB + 2 * MiB;
constexpr size_t WS_Q = WS_H + 2 * ACT1, WS_K = WS_Q + ACT1, WS_V = WS_K + ACT1, WS_ZA = WS_V + ACT1, WS_UB = WS_ZA + ACT1, WS_ZB = WS_UB + ACT1;
constexpr size_t WS_GA = WS_ZB + ACT1, WS_GB = WS_GA + 2 * ACT1, WS_END = WS_GB + 2 * ACT1;
constexpr size_t WS_G8A = WS_GA, WS_G8B = WS_GA + 16 * MiB;
constexpr size_t WS_GAS = WS_GA + 40 * MiB, WS_GBS = WS_GAS + 1 * MiB;
constexpr size_t WS_AAB = WS_H;
constexpr size_t WS_Y = WS_GA + 44 * MiB;
constexpr size_t WS_MRG = WS_K;
constexpr size_t WS_OUT = WS_GA;
constexpr size_t WS_PS = WS_END;
constexpr size_t WS_PART4 = WS_PS, WS_PART5 = WS_PS + 8 * MiB;
constexpr size_t PS_SLAB = (size_t)MS * INC;
constexpr size_t WS_XS = WS_PS + 4 * PS_SLAB * 4;
constexpr size_t WS_XS2 = WS_XS + (size_t)MP * 8 * 4;
constexpr size_t WS_END2 = WS_XS2 + (size_t)MS * 128 * 4;
static_assert(WS_END2 <= 300 * MiB, "ws map");
constexpr size_t TB_COS = 0, TB_SIN = TB_COS + 2049 * 64 * 4, TB_AR = TB_SIN + 2049 * 64 * 4, TB_AI = TB_AR + 64 * 64 * 4,
                 TB_BR = TB_AI + 64 * 64 * 4, TB_BI = TB_BR + 64 * 64 * 16 * 4, TB_END = TB_BI + 64 * 64 * 16 * 4;
static_assert(TB_END <= 2 * MiB && (TB_SIN % 16) == 0 && (TB_AR % 16) == 0, "tables");

constexpr int CW_TMO = 0;
constexpr int CW_SEAM = 16384;
constexpr int CW_SBD = MK_N_LAUNCHES == 1 ? 8192 : 49152;
constexpr int CW_BAR = 4096;

constexpr int RING_BYTES = 131072, LDSCTL_OFF = RING_BYTES, MISC_OFF = LDSCTL_OFF + 320, LDS_BYTES = 147456;

#define GAS __attribute__((address_space(1)))
#define LAS __attribute__((address_space(3)))
typedef unsigned short bf16;
typedef unsigned v4u __attribute__((ext_vector_type(4)));
typedef unsigned v2u __attribute__((ext_vector_type(2)));
typedef float f32x4 __attribute__((ext_vector_type(4)));
typedef GAS unsigned gu32;
#define RLX_AGENT __ATOMIC_RELAXED, __HIP_MEMORY_SCOPE_AGENT
#define LDS_WAIT() asm volatile("s_waitcnt lgkmcnt(0)" ::: "memory")
#define VM_WAIT() asm volatile("s_waitcnt vmcnt(0)" ::: "memory")
__device__ __forceinline__ unsigned f2bf(float f) { unsigned u = __builtin_bit_cast(unsigned, f); return (u + 0x7fffu + ((u >> 16) & 1u)) >> 16; }
__device__ __forceinline__ unsigned pk2(float lo, float hi) { return f2bf(lo) | (f2bf(hi) << 16); }
__device__ __forceinline__ float bf2f(bf16 v) { return __uint_as_float((unsigned)v << 16); }

#define XB_TMO      128
#define XB_XCNT(j)  (256  + 64 * (j))
#define XB_XSUB(j)  (1280 + 64 * (j))
#define XB_XGEN(j)  (2304 + 64 * (j))
#define XB_TOP      3328
#define XB_TOPGEN   3392
#define XCD_BAR_WORDS 3456
#define XB_SPIN_CAP (1u << 20)
__device__ __forceinline__ unsigned xb_ld(unsigned* p)              { return __hip_atomic_load(p, __ATOMIC_RELAXED, __HIP_MEMORY_SCOPE_AGENT); }
__device__ __forceinline__ unsigned xb_add(unsigned* p, unsigned v) { return __hip_atomic_fetch_add(p, v, __ATOMIC_RELAXED, __HIP_MEMORY_SCOPE_AGENT); }
__device__ __forceinline__ unsigned xb_xcc_id() { return (unsigned)__builtin_amdgcn_s_getreg((3 << 11) | 20) & 0xFu; }
#define XB_SPIN(cond, bar) do { unsigned _sp = 0; while (cond) { __builtin_amdgcn_s_sleep(1); \
    if ((++_sp & 255u) == 0u) { if (xb_ld(&(bar)[XB_TMO])) break; if (_sp > XB_SPIN_CAP) { atomicAdd(&(bar)[XB_TMO], 1u); break; } } } } while (0)
struct XcdBarrier { unsigned* bar; unsigned x; volatile LAS unsigned* st; };
__device__ __forceinline__ XcdBarrier xcd_barrier_post(unsigned* bar, volatile LAS unsigned* st) {
    XcdBarrier b; b.bar = bar; b.x = xb_xcc_id(); b.st = st;
    if (threadIdx.x == 0) (void)xb_add(&bar[XB_XCNT(b.x)], 1u);
    return b;
}
__device__ __forceinline__ void xcd_barrier_complete(unsigned* bar, unsigned x, unsigned& nloc, unsigned& nx) {
    const unsigned G = gridDim.x * gridDim.y * gridDim.z;
    unsigned sum, cnt, mine, sp = 0u;
    for (;;) {
        sum = 0u; cnt = 0u; mine = 0u;
#pragma unroll
        for (unsigned j = 0; j < 16; ++j) { const unsigned c = xb_ld(&bar[XB_XCNT(j)]); sum += c; cnt += (c > 0u) ? 1u : 0u; mine = (j == x) ? c : mine; }
        if (sum == G) break;
        __builtin_amdgcn_s_sleep(1);
        if ((++sp & 255u) == 0u) { if (xb_ld(&bar[XB_TMO])) break; if (sp > XB_SPIN_CAP) { atomicAdd(&bar[XB_TMO], 1u); break; } }
    }
    nloc = mine > 0u ? mine : 1u; nx = cnt > 0u ? cnt : 1u;
}
__device__ __forceinline__ void xcd_barrier(const XcdBarrier& b) {
    asm volatile("s_waitcnt vmcnt(0)" ::: "memory");
    __syncthreads();
    if (threadIdx.x == 0) {
        unsigned* bar = b.bar;
        __builtin_amdgcn_s_waitcnt(0);
        unsigned nloc = b.st[0], nx = b.st[1];
        if (nloc == 0u) { xcd_barrier_complete(bar, b.x, nloc, nx); b.st[0] = nloc; b.st[1] = nx; }
        const unsigned old = xb_add(&bar[XB_XSUB(b.x)], 1u);
        const unsigned gen = old / nloc;
        if (old + 1u == (gen + 1u) * nloc) {
            __builtin_amdgcn_fence(__ATOMIC_RELEASE, "agent");
            asm volatile("s_waitcnt vmcnt(0)" ::: "memory");
            const unsigned og = xb_add(&bar[XB_TOP], 1u);
            const unsigned tg = og / nx;
            if (og + 1u == (tg + 1u) * nx) xb_add(&bar[XB_TOPGEN], 1u);
            else XB_SPIN(xb_ld(&bar[XB_TOPGEN]) == tg, bar);
            __builtin_amdgcn_fence(__ATOMIC_ACQUIRE, "agent");
            xb_add(&bar[XB_XGEN(b.x)], 1u);
            asm volatile("s_waitcnt vmcnt(0)" ::: "memory");
        } else {
            XB_SPIN(xb_ld(&bar[XB_XGEN(b.x)]) == gen, bar);
            __builtin_amdgcn_fence(__ATOMIC_ACQUIRE, "agent");
            asm volatile("s_waitcnt vmcnt(0)" ::: "memory");
        }
    }
    __syncthreads();
}

#define SB_XCNT(j) (64 * (j))
#define SB_TOP     1024
#define SB_WORDS   1088
__device__ __forceinline__ void split_arrive(const XcdBarrier& b, unsigned* sb) {
    asm volatile("s_waitcnt vmcnt(0)" ::: "memory");
    __syncthreads();
    if (threadIdx.x == 0) {
        unsigned nloc = b.st[0], nx = b.st[1];
        if (nloc == 0u) { xcd_barrier_complete(b.bar, b.x, nloc, nx); b.st[0] = nloc; b.st[1] = nx; }
        const unsigned old = xb_add(&sb[SB_XCNT(b.x)], 1u);
        if (old + 1u == nloc) { __builtin_amdgcn_fence(__ATOMIC_RELEASE, "agent"); asm volatile("s_waitcnt vmcnt(0)" ::: "memory"); xb_add(&sb[SB_TOP], 1u); }
    }
}
__device__ __forceinline__ void split_wait(const XcdBarrier& b, unsigned* sb) {
    if (threadIdx.x == 0) {
        const unsigned need = b.st[1]; unsigned sp = 0u;
        while (xb_ld(&sb[SB_TOP]) < need) { __builtin_amdgcn_s_sleep(1); if (++sp > (1u << 22)) break; }
        __builtin_amdgcn_fence(__ATOMIC_ACQUIRE, "agent");
    }
    __syncthreads();
}
struct Args { const float* in[21]; float* out; unsigned char* ws; int ph_lo, ph_hi, li, pad; };
struct Frame {
    LAS unsigned char* lds;
    volatile LAS unsigned* MISC;
    int tid, lane, wave, vcu, G;
    float* out; unsigned char* ws;
};
#define FIN(i) (args.in[i])
template <int CTRL, int RMASK> __device__ __forceinline__ float dpp_f(float v) { return __builtin_bit_cast(float, __builtin_amdgcn_update_dpp(0, __builtin_bit_cast(int, v), CTRL, RMASK, 0xF, false)); }
__device__ __forceinline__ float wave_sum(float v) {
    v += dpp_f<0xB1, 0xF>(v);
    v += dpp_f<0x4E, 0xF>(v);
    v += dpp_f<0x141, 0xF>(v);
    v += dpp_f<0x140, 0xF>(v);
    v += dpp_f<0x142, 0xA>(v);
    v += dpp_f<0x143, 0xC>(v);
    return __builtin_bit_cast(float, __builtin_amdgcn_readlane(__builtin_bit_cast(int, v), 63));
}
__device__ __forceinline__ float gelu_tanh(float x) {
    const float u = 0.7978845608028654f * (x + 0.044715f * x * x * x);
    const float e = __expf(2.0f * u);
    const float th = 1.0f - 2.0f * __builtin_amdgcn_rcpf(e + 1.0f);
    return 0.5f * x * (1.0f + th);
}
__device__ __forceinline__ float sigmoidf_(float x) { return __builtin_amdgcn_rcpf(1.0f + __expf(-x)); }

__device__ __forceinline__ int win_rowmap(int n) {
    if (n >= 2048) return n;
    const int head = n >> 7, d = n & 127, nn = d >> 6, dd = d & 63, wc = dd >> 4, fq = (dd >> 2) & 3, j = dd & 3;
    return head * 128 + 32 * wc + 8 * fq + 4 * nn + j;
}
__device__ __forceinline__ void p0_tr_load(float (&wv)[32], const float* W, int N, int item, int lane) {
    const int nblk = N / 32, kb = item / nblk, nb = item % nblk, k0 = 64 * kb, n0 = 32 * nb;
#pragma unroll
    for (int i = 0; i < 32; ++i) wv[i] = __builtin_nontemporal_load(W + (size_t)(k0 + 2 * i + (lane >> 5)) * N + n0 + (lane & 31));
}
template <bool MAPQ>
__device__ __forceinline__ void p0_tr_finish(const float (&wv)[32], int K, int N, bf16* WT, LAS float* scr, int item, int lane, int kofs = 0) {
    const int nblk = N / 32, kb = item / nblk, nb = item % nblk, k0 = 64 * kb, n0 = 32 * nb;
#pragma unroll
    for (int i = 0; i < 32; ++i) scr[(2 * i + (lane >> 5)) * 33 + (lane & 31)] = wv[i];
    LDS_WAIT(); asm volatile("" ::: "memory");
    const int c = lane & 7;
#pragma unroll
    for (int j = 0; j < 4; ++j) { const int n = (lane >> 3) + 8 * j; const LAS float* s = scr + (8 * c) * 33 + n;
        v4u o; o.x = pk2(s[0 * 33], s[1 * 33]); o.y = pk2(s[2 * 33], s[3 * 33]); o.z = pk2(s[4 * 33], s[5 * 33]); o.w = pk2(s[6 * 33], s[7 * 33]);
        const int drow = MAPQ ? win_rowmap(n0 + n) : (n0 + n);
        *(GAS v4u*)(WT + (size_t)drow * K + kofs + k0 + 8 * c) = o; }
    LDS_WAIT(); asm volatile("" ::: "memory");
}
template <bool MAPQ>
__device__ __forceinline__ void p0_transpose_item(const float* W, int K, int N, bf16* WT, LAS float* scr, int item, int lane, int kofs = 0) {
    float wv[32]; p0_tr_load(wv, W, N, item, lane); p0_tr_finish<MAPQ>(wv, K, N, WT, scr, item, lane, kofs);
}
__device__ __forceinline__ void rms_row_load(f32x4 (&v)[8], const float* xrow, int lane) {
    const GAS f32x4* xr = (const GAS f32x4*)xrow + lane;
#pragma unroll
    for (int j = 0; j < 8; ++j) v[j] = __builtin_nontemporal_load(xr + 64 * j);
}
__device__ __forceinline__ void rms_row_finish(const f32x4 (&v)[8], const float* g, bf16* orow, int lane) {
    const GAS f32x4* gr = (const GAS f32x4*)g + lane; float s = 0.f;
#pragma unroll
    for (int j = 0; j < 8; ++j) s += (v[j].x * v[j].x + v[j].y * v[j].y) + (v[j].z * v[j].z + v[j].w * v[j].w);
    const float rstd = 1.0f / sqrtf(wave_sum(s) * (1.f / DM) + EPSF);
    GAS unsigned long long* o8 = (GAS unsigned long long*)orow + lane;
#pragma unroll
    for (int j = 0; j < 8; ++j) { const f32x4 gg = gr[64 * j];
        o8[64 * j] = (unsigned long long)pk2(v[j].x * rstd * gg.x, v[j].y * rstd * gg.y) | ((unsigned long long)pk2(v[j].z * rstd * gg.z, v[j].w * rstd * gg.w) << 32); }
}
__device__ __forceinline__ void p0_prologue(Frame& F, const Args& args) {
    LAS float* scr = (LAS float*)(F.lds + F.wave * 16384);
    const int gw = F.vcu * NWAVES + F.wave, NGW = F.G * NWAVES;
    constexpr int I_IN = (DM / 64) * (INC / 32), I_PA = (RW / 64) * (DM / 32), I_PB = I_PA, I_OUT = (DM / 64) * (DM / 32), I_GLU = (SW / 64) * (SW / 32);
    constexpr int NITEMS = I_IN + I_PA + I_PB + I_OUT + I_GLU;
    bf16* WinT = (bf16*)(F.ws + WS_WIN); bf16* WgluT = (bf16*)(F.ws + WS_WGLU);
    (void)NITEMS;
    { float wa[32], wb[32]; int it = gw;
      if (it < I_IN) p0_tr_load(wa, args.in[6], INC, it, F.lane);
      for (; it < I_IN; it += NGW) {
          const bool hasn = it + NGW < I_IN;
          if (hasn) p0_tr_load(wb, args.in[6], INC, it + NGW, F.lane);
          p0_tr_finish<true>(wa, DM, INC, WinT, scr, it, F.lane);
          if (hasn) {
#pragma unroll
              for (int i = 0; i < 32; ++i) wa[i] = wb[i]; }
      } }
    for (int it = gw; it < I_GLU; it += NGW) p0_transpose_item<false>(args.in[19], SW, SW, WgluT, scr, it, F.lane);
    bf16* H = (bf16*)(F.ws + WS_H);
    { f32x4 ra[8], rb[8]; int m = gw;
#define XROW(mm) ((mm) < MP ? args.in[0] + (size_t)(mm) * DM : args.in[1] + (size_t)((mm) - MP) * DM)
      if (m < MV) rms_row_load(ra, XROW(m), F.lane);
      for (; m < MV; m += NGW) {
          const bool hasn = m + NGW < MV;
          if (hasn) rms_row_load(rb, XROW(m + NGW), F.lane);
          rms_row_finish(ra, args.in[5], H + (size_t)m * DM, F.lane);
          if (hasn) {
#pragma unroll
              for (int j = 0; j < 8; ++j) ra[j] = rb[j]; }
      }
#undef XROW
    }
    for (int m = MV + gw; m < MPAD; m += NGW) { GAS unsigned long long* o8 = (GAS unsigned long long*)(H + (size_t)m * DM) + F.lane;
#pragma unroll
        for (int j = 0; j < 8; ++j) o8[64 * j] = 0ull; }
    const int gt = F.vcu * NTHR + F.tid, NGT = F.G * NTHR;
    float* tcos = (float*)(F.ws + WS_TAB + TB_COS); float* tsin = (float*)(F.ws + WS_TAB + TB_SIN);
    for (int i = gt; i < 2049 * 64; i += NGT) {
        const int pi = i >> 6, d = i & 63; const double pos = (pi == 2048) ? (double)POS_S : (double)pi;
        const double inv = exp((double)d * (-9.210340371976184 / 64.0)), ang = pos * inv;
        const double red = ang - 6.283185307179586476925 * rint(ang * 0.15915494309189533577);
        float sn, cs; sincosf((float)red, &sn, &cs);
        tcos[i] = cs; tsin[i] = sn;
    }
    float* tar = (float*)(F.ws + WS_TAB + TB_AR); float* tai = (float*)(F.ws + WS_TAB + TB_AI);
    float* tbr = (float*)(F.ws + WS_TAB + TB_BR); float* tbi = (float*)(F.ws + WS_TAB + TB_BI);
    for (int i = (F.tid < 16 ? F.vcu * 16 + F.tid : SG * SP); i < SG * SP; i += F.G * 16) {
        const int g = i >> 6;
        const double lr = (double)args.in[11][i], li = (double)args.in[12][i], dt = exp((double)args.in[13][g]);
        const double ang = li * dt, red = ang - 6.283185307179586476925 * rint(ang * 0.15915494309189533577);
        float sn, cs; sincosf((float)red, &sn, &cs);
        const double mag = exp(lr * dt), ar = mag * (double)cs, ai = mag * (double)sn;
        const double nr = ar - 1.0, ni = ai, den = lr * lr + li * li;
        const double cr = (nr * lr + ni * li) / den, ci = (ni * lr - nr * li) / den;
        tar[i] = (float)ar; tai[i] = (float)ai;
        for (int n = 0; n < SN; ++n) { const double br = (double)args.in[14][i * SN + n], bi = (double)args.in[15][i * SN + n];
            tbr[i * SN + n] = (float)(cr * br - ci * bi); tbi[i * SN + n] = (float)(cr * bi + ci * br); }
    }
}

__device__ __forceinline__ void p1_convert_rest(Frame& F, const Args& args, int idx, int nidle) {
    LAS float* scr = (LAS float*)(F.lds + F.wave * 16384);
    constexpr int I_PA = (RW / 64) * (DM / 32), I_PB = I_PA, I_OUT = (DM / 64) * (DM / 32);
    bf16* WpT = (bf16*)(F.ws + WS_WPA); bf16* WoutT = (bf16*)(F.ws + WS_WOUT);
    for (int it = idx * NWAVES + F.wave; it < I_PA + I_PB + I_OUT; it += nidle * NWAVES) {
        int r = it;
        if (r < I_PA) { p0_transpose_item<false>(args.in[7], 2 * RW, DM, WpT, scr, r, F.lane, 0); continue; } r -= I_PA;
        if (r < I_PB) { p0_transpose_item<false>(args.in[8], 2 * RW, DM, WpT, scr, r, F.lane, RW); continue; } r -= I_PB;
        p0_transpose_item<false>(args.in[9], DM, DM, WoutT, scr, r, F.lane);
    }
}
using pg8::Unit; using pg8::cvt_pk_bf16; using pg8::bf_lo; using pg8::bf_hi;
struct EpiProj {
    static constexpr bool MIDHOOK = false, AFTER_DRAIN = false, PERM = true;
    bf16 *Q, *K, *V, *ZA, *UB, *ZB, *GA, *GB; const float* tcos; const float* tsin; float* PS;
    __device__ __forceinline__ void operator()(const f32x4 (&acc)[2][2][4][2], const Unit& u, int wr, int wc, int fr, int fq) const {
        asm volatile("" : "+v"(fr), "+v"(fq));
        const int row0 = u.pm * 256 + wr * 64 + fr;
        const int seg = u.pn >> 2;
        if (u.z) {
            float* slab = PS + (size_t)(u.z - 1) * PS_SLAB + (size_t)(wr * 64 + fr) * INC + u.pn * 256 + wc * 32 + 8 * fq;
#pragma unroll
            for (int m = 0; m < 4; ++m)
#pragma unroll
                for (int bj = 0; bj < 2; ++bj) { *(f32x4*)(slab + (size_t)m * 16 * INC + bj * 128) = acc[0][bj][m][0]; *(f32x4*)(slab + (size_t)m * 16 * INC + bj * 128 + 4) = acc[0][bj][m][1]; }
            return;
        }
        if (seg < 2) {
            bf16* base = seg == 0 ? Q : K;
            const int head0 = (u.pn & 3) * 2, d0 = 16 * wc + 4 * fq;
            float lgh[2];
#pragma unroll
            for (int bj = 0; bj < 2; ++bj) lgh[bj] = seg == 0 ? 0.f : log2f(1.0f - exp2f(-5.0f - (float)(head0 + bj)));
            f32x4 csq[2][4], snq[2][4];
#pragma unroll
            for (int ai = 0; ai < 2; ++ai)
#pragma unroll
                for (int m = 0; m < 4; ++m) { const int row = row0 + ai * 128 + m * 16; const int pi = row < MP ? (row & (SEQ - 1)) : 2048;
                    csq[ai][m] = *(const f32x4*)(tcos + pi * 64 + d0); snq[ai][m] = *(const f32x4*)(tsin + pi * 64 + d0); }
#pragma unroll
            for (int ai = 0; ai < 2; ++ai)
#pragma unroll
                for (int m = 0; m < 4; ++m) {
                    const int row = row0 + ai * 128 + m * 16;
                    const float sl1 = row < MP ? (float)((row & 127) + 1) : 1.0f;
                    const f32x4 cs = csq[ai][m], sn = snq[ai][m];
#pragma unroll
                    for (int bj = 0; bj < 2; ++bj) {
                        const float sc = seg == 0 ? 1.0f : 0.08838834764831845f * exp2f(-sl1 * lgh[bj]);
                        const f32x4 x1 = acc[ai][bj][m][0], x2 = acc[ai][bj][m][1];
                        const f32x4 o1 = (x1 * cs - x2 * sn) * sc, o2 = (x1 * sn + x2 * cs) * sc;
                        bf16* p = base + (size_t)row * RW + (head0 + bj) * 128 + d0;
                        v2u w1, w2; w1.x = cvt_pk_bf16(o1[0], o1[1]); w1.y = cvt_pk_bf16(o1[2], o1[3]); w2.x = cvt_pk_bf16(o2[0], o2[1]); w2.y = cvt_pk_bf16(o2[2], o2[3]);
                        *(v2u*)p = w1; *(v2u*)(p + 64) = w2;
                    }
                }
        } else {
            const int sb = seg < 6 ? seg : (seg & ~1);
            bf16* base = (bf16*)((unsigned char*)Q + (size_t)sb * ACT1);
            const int ldc = seg < 6 ? 1024 : 2048, colt = (u.pn - 4 * sb) * 256;
            const int act = seg >= 6 ? 2 : ((seg == 3 || seg == 5) ? 1 : 0);
            const int col0 = colt + wc * 32 + 8 * fq;
            if (seg >= 6) {
                unsigned char* gt = (unsigned char*)Q + (WS_G8A - WS_Q) + (seg >= 8 ? (WS_G8B - WS_G8A) : 0) + (size_t)(u.pm * 8 + ((u.pn - 24) & 7)) * 65536 + (size_t)(((wr * 4 + wc) * 64) + fq * 16 + fr) * 8;
#pragma unroll
                for (int ai = 0; ai < 2; ++ai)
#pragma unroll
                    for (int m = 0; m < 4; ++m)
#pragma unroll
                        for (int bj = 0; bj < 2; ++bj) { const f32x4 v0 = acc[ai][bj][m][0], v1 = acc[ai][bj][m][1]; unsigned q[8];
#pragma unroll
                            for (int e = 0; e < 4; ++e) { q[e] = (unsigned)(sigmoidf_(v0[e]) * 255.0f + 0.5f); q[4 + e] = (unsigned)(sigmoidf_(v1[e]) * 255.0f + 0.5f); }
                            v2u w; w.x = q[0] | (q[1] << 8) | (q[2] << 16) | (q[3] << 24); w.y = q[4] | (q[5] << 8) | (q[6] << 16) | (q[7] << 24);
                            *(v2u*)(gt + (size_t)((ai * 4 + m) * 2 + bj) * 4096) = w; }
                return;
            }
#pragma unroll
            for (int ai = 0; ai < 2; ++ai)
#pragma unroll
                for (int m = 0; m < 4; ++m) { bf16* rowp = base + (size_t)(row0 + ai * 128 + m * 16) * ldc + col0;
#pragma unroll
                    for (int bj = 0; bj < 2; ++bj) { f32x4 v0 = acc[ai][bj][m][0], v1 = acc[ai][bj][m][1];
                        if (act != 0) {
#pragma unroll
                            for (int e = 0; e < 4; ++e) { const float s0 = sigmoidf_(v0[e]), s1 = sigmoidf_(v1[e]); v0[e] = act == 1 ? v0[e] * s0 : s0; v1[e] = act == 1 ? v1[e] * s1 : s1; }
                        }
                        v4u w; w.x = cvt_pk_bf16(v0[0], v0[1]); w.y = cvt_pk_bf16(v0[2], v0[3]); w.z = cvt_pk_bf16(v1[0], v1[1]); w.w = cvt_pk_bf16(v1[2], v1[3]);
                        if (seg == 4) {
                            const int col = col0 + bj * 128, g = col >> 4, half = (col >> 3) & 1;
                            *(v4u*)(base + ((size_t)g * MPAD + (row0 + ai * 128 + m * 16)) * 16 + 8 * half) = w;
                        } else *(v4u*)(rowp + bj * 128) = w; } }
        }
    }
};
struct EpiGlu {
    static constexpr bool MIDHOOK = false, AFTER_DRAIN = false, PERM = true;
    const bf16* Y; const bf16* ZB; bf16* AB; const float* bias;
    __device__ __forceinline__ void operator()(const f32x4 (&acc)[2][2][4][2], const Unit& u, int wr, int wc, int fr, int fq) const {
        const int row0 = u.pm * 256 + wr * 64 + fr, col0 = u.pn * 256 + wc * 32 + 8 * fq;
        f32x4 bq[2][2];
#pragma unroll
        for (int bj = 0; bj < 2; ++bj) { bq[bj][0] = *(const f32x4*)(bias + col0 + bj * 128); bq[bj][1] = *(const f32x4*)(bias + col0 + bj * 128 + 4); }
#pragma unroll
        for (int ai = 0; ai < 2; ++ai) {
            v4u yq[4][2], zq[4][2];
#pragma unroll
            for (int m = 0; m < 4; ++m)
#pragma unroll
                for (int bj = 0; bj < 2; ++bj) { const size_t off = (size_t)(row0 + ai * 128 + m * 16) * SW + col0 + bj * 128; yq[m][bj] = *(const v4u*)(Y + off); zq[m][bj] = *(const v4u*)(ZB + off); }
#pragma unroll
            for (int m = 0; m < 4; ++m)
#pragma unroll
                for (int bj = 0; bj < 2; ++bj) { const size_t off = (size_t)(row0 + ai * 128 + m * 16) * SW + col0 + bj * 128;
                    const v4u yv = yq[m][bj], zv = zq[m][bj];
                    const f32x4 g0 = acc[ai][bj][m][0] + bq[bj][0], g1 = acc[ai][bj][m][1] + bq[bj][1];
                    float o[8];
                    o[0] = bf_lo(yv.x) * sigmoidf_(g0[0]) * bf_lo(zv.x); o[1] = bf_hi(yv.x) * sigmoidf_(g0[1]) * bf_hi(zv.x);
                    o[2] = bf_lo(yv.y) * sigmoidf_(g0[2]) * bf_lo(zv.y); o[3] = bf_hi(yv.y) * sigmoidf_(g0[3]) * bf_hi(zv.y);
                    o[4] = bf_lo(yv.z) * sigmoidf_(g1[0]) * bf_lo(zv.z); o[5] = bf_hi(yv.z) * sigmoidf_(g1[1]) * bf_hi(zv.z);
                    o[6] = bf_lo(yv.w) * sigmoidf_(g1[2]) * bf_lo(zv.w); o[7] = bf_hi(yv.w) * sigmoidf_(g1[3]) * bf_hi(zv.w);
                    v4u w; w.x = cvt_pk_bf16(o[0], o[1]); w.y = cvt_pk_bf16(o[2], o[3]); w.z = cvt_pk_bf16(o[4], o[5]); w.w = cvt_pk_bf16(o[6], o[7]);
                    *(v4u*)(AB + (size_t)(row0 + ai * 128 + m * 16) * (2 * SW) + SW + col0 + bj * 128) = w; }
        }
    }
};
struct EpiMerge {
    static constexpr bool MIDHOOK = true, AFTER_DRAIN = false, PERM = true;
    const unsigned char* G8A; const unsigned char* G8B; bf16* MRG;
    __device__ __forceinline__ void mid(f32x4 (&acc)[2][2][4][2], const Unit& u, int wr, int wc, int fr, int fq) const {
        asm volatile("" : "+v"(fr), "+v"(fq));
        const size_t toff = (size_t)(u.pm * 8 + u.pn) * 65536 + (size_t)(((wr * 4 + wc) * 64) + fq * 16 + fr) * 8;
#pragma unroll
        for (int ai = 0; ai < 2; ++ai) {
            v2u ga[4][2], gb[4][2];
#pragma unroll
            for (int m = 0; m < 4; ++m)
#pragma unroll
                for (int bj = 0; bj < 2; ++bj) { ga[m][bj] = *(const v2u*)(G8A + toff + (size_t)((ai * 4 + m) * 2 + bj) * 4096); gb[m][bj] = *(const v2u*)(G8B + toff + (size_t)((ai * 4 + m) * 2 + bj) * 4096); }
#pragma unroll
            for (int m = 0; m < 4; ++m)
#pragma unroll
                for (int bj = 0; bj < 2; ++bj)
#pragma unroll
                    for (int e = 0; e < 4; ++e) {
                        const unsigned a0 = (ga[m][bj].x >> (8 * e)) & 255u, a1 = (ga[m][bj].y >> (8 * e)) & 255u, b0 = (gb[m][bj].x >> (8 * e)) & 255u, b1 = (gb[m][bj].y >> (8 * e)) & 255u;
                        acc[ai][bj][m][0][e] *= (float)a0 * __builtin_amdgcn_rcpf((float)(b0 ? b0 : 1u));
                        acc[ai][bj][m][1][e] *= (float)a1 * __builtin_amdgcn_rcpf((float)(b1 ? b1 : 1u)); }
        }
    }
    __device__ __forceinline__ void operator()(const f32x4 (&acc)[2][2][4][2], const Unit& u, int wr, int wc, int fr, int fq) const {
        asm volatile("" : "+v"(fr), "+v"(fq));
        const int row0 = u.pm * 256 + wr * 64 + fr, col0 = u.pn * 256 + wc * 32 + 8 * fq;
        const size_t toff = (size_t)(u.pm * 8 + u.pn) * 65536 + (size_t)(((wr * 4 + wc) * 64) + fq * 16 + fr) * 8;
        v2u gb[2][4][2];
#pragma unroll
        for (int ai = 0; ai < 2; ++ai)
#pragma unroll
            for (int m = 0; m < 4; ++m)
#pragma unroll
                for (int bj = 0; bj < 2; ++bj) gb[ai][m][bj] = *(const v2u*)(G8B + toff + (size_t)((ai * 4 + m) * 2 + bj) * 4096);
        const float k255 = 1.0f / 255.0f;
#pragma unroll
        for (int ai = 0; ai < 2; ++ai)
#pragma unroll
            for (int m = 0; m < 4; ++m)
#pragma unroll
                for (int bj = 0; bj < 2; ++bj) { float o[8];
#pragma unroll
                    for (int e = 0; e < 4; ++e) { const unsigned b0 = (gb[ai][m][bj].x >> (8 * e)) & 255u, b1 = (gb[ai][m][bj].y >> (8 * e)) & 255u;
                        o[e] = acc[ai][bj][m][0][e] * ((float)(b0 ? b0 : 1u) * k255); o[4 + e] = acc[ai][bj][m][1][e] * ((float)(b1 ? b1 : 1u) * k255); }
                    v4u w; w.x = cvt_pk_bf16(o[0], o[1]); w.y = cvt_pk_bf16(o[2], o[3]); w.z = cvt_pk_bf16(o[4], o[5]); w.w = cvt_pk_bf16(o[6], o[7]);
                    *(v4u*)(MRG + (size_t)(row0 + ai * 128 + m * 16) * DM + col0 + bj * 128) = w; }
    }
};
struct EpiOutBf16 {
    static constexpr bool MIDHOOK = false, AFTER_DRAIN = false, PERM = true;
    bf16* C; int ldc;
    __device__ __forceinline__ void operator()(const f32x4 (&acc)[2][2][4][2], const Unit& u, int wr, int wc, int fr, int fq) const {
        const int row0 = u.pm * 256 + wr * 64 + fr, col0 = u.pn * 256 + wc * 32 + 8 * fq;
#pragma unroll
        for (int ai = 0; ai < 2; ++ai)
#pragma unroll
            for (int m = 0; m < 4; ++m) { bf16* rowp = C + (size_t)(row0 + ai * 128 + m * 16) * ldc + col0;
#pragma unroll
                for (int bj = 0; bj < 2; ++bj) { const f32x4 v0 = acc[ai][bj][m][0], v1 = acc[ai][bj][m][1];
                    v4u w; w.x = cvt_pk_bf16(v0[0], v0[1]); w.y = cvt_pk_bf16(v0[2], v0[3]); w.z = cvt_pk_bf16(v1[0], v1[1]); w.w = cvt_pk_bf16(v1[2], v1[3]);
                    *(v4u*)(rowp + bj * 128) = w; } }
    }
};

typedef float f32x16 __attribute__((ext_vector_type(16)));
typedef float f32x2v __attribute__((ext_vector_type(2)));
typedef short bf16x8 __attribute__((ext_vector_type(8)));
typedef short s16x4 __attribute__((ext_vector_type(4)));
typedef __bf16 bf16x2_t __attribute__((ext_vector_type(2)));
#define MFMA32(a, b, c) __builtin_amdgcn_mfma_f32_32x32x16_bf16((a), (b), (c), 0, 0, 0)
#define MFMA16(a, b, c) __builtin_amdgcn_mfma_f32_16x16x32_bf16((a), (b), (c), 0, 0, 0)
__device__ __forceinline__ unsigned cvtpk(float lo, float hi) { f32x2v v = {lo, hi}; bf16x2_t b = __builtin_convertvector(v, bf16x2_t); return __builtin_bit_cast(unsigned, b); }
__device__ __forceinline__ v2u pk4(const f32x4 v) { v2u w; w.x = cvtpk(v[0], v[1]); w.y = cvtpk(v[2], v[3]); return w; }
__device__ __forceinline__ s16x4 lds_tr(LAS unsigned char* p) { return __builtin_bit_cast(s16x4, __builtin_amdgcn_ds_read_tr16_b64_v4i16((LAS s16x4*)p)); }
__device__ __forceinline__ bf16x8 cat8(s16x4 lo, s16x4 hi) { return (bf16x8){lo[0], lo[1], lo[2], lo[3], hi[0], hi[1], hi[2], hi[3]}; }
__device__ __forceinline__ bf16x8 pack8(const f32x16& x, int s) {
    v4u p; p.x = cvtpk(x[8 * s], x[8 * s + 1]); p.y = cvtpk(x[8 * s + 2], x[8 * s + 3]); p.z = cvtpk(x[8 * s + 4], x[8 * s + 5]); p.w = cvtpk(x[8 * s + 6], x[8 * s + 7]);
    return __builtin_bit_cast(bf16x8, p);
}
__device__ __forceinline__ void glds16(const void* g, LAS unsigned char* l) { __builtin_amdgcn_global_load_lds((const unsigned*)g, (LAS unsigned*)l, 16, 0, 0); }
__device__ __forceinline__ void glds16_asm(const void* gsrc, unsigned lds_dst) { unsigned keep;
    asm volatile("s_mov_b32 %0, m0\n\ts_mov_b32 m0, %2\n\ts_nop 0\n\tglobal_load_lds_dwordx4 %1, off\n\ts_mov_b32 m0, %0" : "=&s"(keep) : "v"(gsrc), "s"(lds_dst) : "memory"); }
__device__ __forceinline__ unsigned swz16(unsigned row) { return ((row & 3u) << 2) | ((row >> 2) & 3u); }
__device__ __forceinline__ unsigned off_b(unsigned row, unsigned ch) { return 256u * row + 16u * (ch ^ swz16(row)); }

__device__ __forceinline__ int launder(int x) { asm volatile("" : "+v"(x)); return x; }
constexpr int RT_STAT = RING_BYTES + 1024;
__device__ __forceinline__ void ret_stage(LAS unsigned char* buf, const bf16* KSg, const bf16* Vg, size_t tok0, int hcol, int wave, int lane) {
#pragma unroll
    for (int i = 0; i < 2; ++i) {
        const unsigned slot = (unsigned)(wave * 64 + lane + 512 * i), row = slot >> 4, cp = slot & 15u, ch = cp ^ swz16(row);
        const size_t go = (tok0 + row) * RW + hcol + ch * 8;
        const unsigned dst = (unsigned)(size_t)buf + (unsigned)((wave * 64 + 512 * i) * 16);
        glds16_asm(KSg + go, (unsigned)__builtin_amdgcn_readfirstlane((int)dst));
        glds16_asm(Vg + go, (unsigned)__builtin_amdgcn_readfirstlane((int)(dst + 16384u)));
    }
}
template <bool KROW> __device__ __forceinline__ unsigned tr_base(int lane, unsigned c, unsigned t) {
    const unsigned h = lane >> 5, blk = (lane >> 4) & 1, q = (lane & 15) >> 2, p = lane & 3;
    const unsigned rowl = KROW ? (8 * t + 4 * h + q) : (8 * h + 4 * t + q), sw = (q << 2) | (KROW ? (2 * t + h) : (2 * h + t));
    return 256u * rowl + 16u * ((4 * c + 2 * blk + (p >> 1)) ^ sw) + 8u * (p & 1);
}
__device__ __forceinline__ void ret_state_update(f32x16 (&accS)[2], LAS unsigned char* buf, const unsigned (&ba)[2], const unsigned (&bb)[2][2]) {
#pragma unroll
    for (int ks = 0; ks < 4; ++ks) {
        const bf16x8 A = cat8(lds_tr(buf + ba[0] + 4096 * ks), lds_tr(buf + ba[1] + 4096 * ks));
#pragma unroll
        for (int e2 = 0; e2 < 2; ++e2) {
            const bf16x8 B = cat8(lds_tr(buf + 16384 + bb[e2][0] + 4096 * ks), lds_tr(buf + 16384 + bb[e2][1] + 4096 * ks));
            accS[e2] = MFMA32(A, B, accS[e2]); }
    }
}
__device__ __forceinline__ void ret_unit(Frame& F, int b, int hd, int j, bool primed, int nj) {
    LAS unsigned char* lds = F.lds;
    const bf16* Qg = (const bf16*)(F.ws + WS_Q); const bf16* KSg = (const bf16*)(F.ws + WS_K); const bf16* Vg = (const bf16*)(F.ws + WS_V);
    const int w = F.wave; int lane = launder(F.lane); int h = lane >> 5, r = lane & 31;
    const int hi2 = w >> 1, eh = w & 1;
    const float lg2 = log2f(1.0f - exp2f(-5.0f - (float)hd)), g128 = exp2f(128.0f * lg2);
    const size_t tokb = (size_t)b * SEQ; const int hcol = hd * DK;
    f32x16 accS[2], accO[2];
#pragma unroll
    for (int i = 0; i < 16; ++i) { accS[0][i] = 0.f; accS[1][i] = 0.f; accO[0][i] = 0.f; accO[1][i] = 0.f; }
    bf16x8 qf[8]; v2u zq[2][4];
    { const bf16* qrow = Qg + (tokb + 128 * (size_t)j + 32 * hi2 + r) * RW + hcol + 4 * h;
#pragma unroll
      for (int ks = 0; ks < 8; ++ks) { const v2u lo = *(const v2u*)(qrow + 16 * ks), hi = *(const v2u*)(qrow + 16 * ks + 8); v4u t; t.x = lo.x; t.y = lo.y; t.z = hi.x; t.w = hi.y; qf[ks] = __builtin_bit_cast(bf16x8, t); }
      const bf16* zrow = (const bf16*)(F.ws + WS_ZA) + (tokb + 128 * (size_t)j + 32 * hi2 + r) * RW + hcol + 4 * h;
#pragma unroll
      for (int e2 = 0; e2 < 2; ++e2)
#pragma unroll
        for (int g4 = 0; g4 < 4; ++g4) zq[e2][g4] = *(const v2u*)(zrow + 32 * (2 * eh + e2) + 8 * g4); }
    unsigned ba[2], bb[2][2];
#pragma unroll
    for (int t = 0; t < 2; ++t) { ba[t] = tr_base<false>(lane, hi2, t); bb[0][t] = tr_base<false>(lane, 2 * eh, t); bb[1][t] = tr_base<false>(lane, 2 * eh + 1, t); }
    const int nprev = 2 * j, NS = nprev + 2;
#define RT_SLOT(n) (lds + (((n) & 3) << 15))
    if (!primed) {
        ret_stage(RT_SLOT(0), KSg, Vg, tokb, hcol, w, lane);
        ret_stage(RT_SLOT(1), KSg, Vg, tokb + 64, hcol, w, lane);
        if (NS > 2) ret_stage(RT_SLOT(2), KSg, Vg, tokb + 128, hcol, w, lane);
    }
    if (NS > 2) asm volatile("s_waitcnt vmcnt(8)" ::: "memory"); else asm volatile("s_waitcnt vmcnt(0)" ::: "memory");
    __builtin_amdgcn_s_barrier(); asm volatile("" ::: "memory");
    for (int n = 0; n < nprev; ++n) {
        const bool more = n + 3 < NS;
        if (more) ret_stage(RT_SLOT(n + 3), KSg, Vg, tokb + 64 * (size_t)(n + 3), hcol, w, lane);
        ret_state_update(accS, RT_SLOT(n), ba, bb);
        if (n & 1) { accS[0] = accS[0] * g128; accS[1] = accS[1] * g128; }
        if (more) asm volatile("s_waitcnt vmcnt(8) lgkmcnt(0)" ::: "memory"); else asm volatile("s_waitcnt vmcnt(0) lgkmcnt(0)" ::: "memory");
        __builtin_amdgcn_s_barrier(); asm volatile("" ::: "memory");
    }
    LAS unsigned char* sx = RT_SLOT(nprev + 2);
    lane = launder(F.lane); h = lane >> 5; r = lane & 31;
#pragma unroll
    for (int e2 = 0; e2 < 2; ++e2)
#pragma unroll
        for (int s = 0; s < 2; ++s) *(LAS bf16x8*)(sx + ((hi2 * 4 + 2 * eh + e2) * 2 + s) * 1024 + lane * 16) = pack8(accS[e2], s);
    LDS_WAIT(); __syncthreads();
    const int tt = hi2;
    unsigned rrow, rx, rc[2];
    { const unsigned sw = swz16((unsigned)r); rrow = 256u * r + 8u * h; rx = 32u * (sw >> 1); rc[0] = 16u * (sw & 1); rc[1] = 16u * ((sw & 1) ^ 1); }
    unsigned bv[2][2];
#pragma unroll
    for (int t = 0; t < 2; ++t) { bv[0][t] = tr_base<true>(lane, 2 * eh, t); bv[1][t] = tr_base<true>(lane, 2 * eh + 1, t); }
#pragma unroll
    for (int sg = 0; sg < 2; ++sg) {
        const int n = nprev + sg;
        LAS unsigned char* buf = RT_SLOT(n);
#pragma unroll
        for (int st2 = 0; st2 < 2; ++st2) {
            const int st = 2 * sg + st2;
            if (st <= tt) {
                const unsigned rb = 32 * st2;
                f32x16 X;
#pragma unroll
                for (int i = 0; i < 16; ++i) X[i] = 0.f;
#pragma unroll
                for (int ks = 0; ks < 8; ++ks) {
                    const unsigned ax = rrow + ((32u * ks) ^ rx) + 256u * rb;
                    const v2u lo = *(const LAS v2u*)(buf + ax + rc[0]), hi = *(const LAS v2u*)(buf + ax + rc[1]);
                    v4u t; t.x = lo.x; t.y = lo.y; t.z = hi.x; t.w = hi.y;
                    X = MFMA32(__builtin_bit_cast(bf16x8, t), qf[ks], X);
                }
                if (st == tt) {
#pragma unroll
                    for (int i = 0; i < 16; ++i) { const int srow = (i & 3) + 8 * (i >> 2) + 4 * h; X[i] = srow > r ? 0.f : X[i]; }
                }
#pragma unroll
                for (int s = 0; s < 2; ++s) {
                    const bf16x8 xb = pack8(X, s);
#pragma unroll
                    for (int e2 = 0; e2 < 2; ++e2) {
                        const bf16x8 A = cat8(lds_tr(buf + 16384 + bv[e2][0] + 256 * (rb + 16 * s)), lds_tr(buf + 16384 + bv[e2][1] + 256 * (rb + 16 * s)));
                        accO[e2] = MFMA32(A, xb, accO[e2]); }
                }
            }
        }
        if (sg == 0) {
#pragma unroll
            for (int e2 = 0; e2 < 2; ++e2)
#pragma unroll
                for (int dt = 0; dt < 4; ++dt)
#pragma unroll
                    for (int s = 0; s < 2; ++s) {
                        const bf16x8 A = *(const LAS bf16x8*)(sx + ((dt * 4 + 2 * eh + e2) * 2 + s) * 1024 + lane * 16);
                        accO[e2] = MFMA32(A, qf[2 * dt + s], accO[e2]); }
        }
        if (j == 15) ret_state_update(accS, buf, ba, bb);
    }
#undef RT_SLOT
    if (j == 15) {
        float* So = F.out + O_RP + (size_t)(b * NH + hd) * DK * DK;
#pragma unroll
        for (int e2 = 0; e2 < 2; ++e2)
#pragma unroll
            for (int i = 0; i < 16; ++i) So[(size_t)(32 * hi2 + (i & 3) + 8 * (i >> 2) + 4 * h) * DK + 32 * (2 * eh + e2) + r] = accS[e2][i] * g128;
    }
    lane = launder(F.lane); h = lane >> 5; r = lane & 31;
    if (nj >= 0) {
        __syncthreads();
        ret_stage(lds, KSg, Vg, tokb, hcol, w, lane);
        ret_stage(lds + 32768, KSg, Vg, tokb + 64, hcol, w, lane);
        if (2 * nj + 2 > 2) ret_stage(lds + 65536, KSg, Vg, tokb + 128, hcol, w, lane);
    }
    bf16* AA = (bf16*)(F.ws + WS_AAB);
    const float sc = exp2f((float)(32 * tt + r + 1) * lg2);
    float s1 = 0.f, s2 = 0.f;
#pragma unroll
    for (int e2 = 0; e2 < 2; ++e2)
#pragma unroll
        for (int i = 0; i < 16; ++i) { const float o = accO[e2][i] * sc; accO[e2][i] = o; s1 += o; s2 += o * o; }
    s1 += __shfl_xor(s1, 32); s2 += __shfl_xor(s2, 32);
    LAS f32x2v* stat = (LAS f32x2v*)(lds + RT_STAT);
    if (h == 0) stat[(32 * tt + r) * 2 + eh] = (f32x2v){s1, s2};
    LDS_WAIT(); __syncthreads();
    { const f32x2v a = stat[(32 * tt + r) * 2], c = stat[(32 * tt + r) * 2 + 1];
      const float mean = (a.x + c.x) * (1.0f / 128.0f), var = fmaxf((a.y + c.y) * (1.0f / 128.0f) - mean * mean, 0.f), rstd = 1.0f / sqrtf(var + EPSF);
      const size_t ro = (tokb + 128 * (size_t)j + 32 * tt + r) * (2 * RW) + hcol;
#pragma unroll
      for (int e2 = 0; e2 < 2; ++e2)
#pragma unroll
        for (int g4 = 0; g4 < 4; ++g4) { const int e0 = 32 * (2 * eh + e2) + 8 * g4 + 4 * h;
            const v2u zv = zq[e2][g4];
            const float o0 = (accO[e2][4 * g4] - mean) * rstd * bf_lo(zv.x), o1 = (accO[e2][4 * g4 + 1] - mean) * rstd * bf_hi(zv.x);
            const float o2 = (accO[e2][4 * g4 + 2] - mean) * rstd * bf_lo(zv.y), o3 = (accO[e2][4 * g4 + 3] - mean) * rstd * bf_hi(zv.y);
            v2u wv; wv.x = cvtpk(o0, o1); wv.y = cvtpk(o2, o3); *(v2u*)(AA + ro + e0) = wv; } }
    __syncthreads();
}
__device__ __forceinline__ float ps_sum(const float* PS, int b, int n) {
    const float* p = PS + (size_t)b * INC + n; return (p[0] + p[PS_SLAB]) + (p[2 * PS_SLAB] + p[3 * PS_SLAB]);
}
__device__ __forceinline__ void ret_sample_load(f32x4 (&S)[8], float (&px)[2], const float* S0, const float* PS, int v, int tid) {
    const int cg = tid & 31, rg = tid >> 5, b = v / NH, h = v % NH, d = tid & 127, part = tid >> 7;
#pragma unroll
    for (int i = 0; i < 8; ++i) S[i] = __builtin_nontemporal_load((const f32x4*)(S0 + (size_t)(rg + 16 * i) * DK + 4 * cg));
    if (part < 2) { const int dl = d & 63, c1 = 32 * (dl >> 4) + 8 * ((dl >> 2) & 3) + (dl & 3), nb = part * 1024 + h * 128; px[0] = ps_sum(PS, b, nb + c1); px[1] = ps_sum(PS, b, nb + c1 + 4); }
    else { px[0] = ps_sum(PS, b, part * 1024 + h * 128 + d); px[1] = 0.f; }
}
__device__ __forceinline__ void ret_sample_unit(Frame& F, int b, int h, f32x4 (&S)[8], const float (&px)[2], float* Sout) {
    bf16* AA = (bf16*)(F.ws + WS_AAB);
    float* sq = (float*)(F.lds); float* sk = sq + 128; float* sv = sk + 128; float* sz = sv + 128; float* red = sz + 128; float* stat = red + 16 * 128;
    const int tid = launder(F.tid) & 511, cg = tid & 31, rg = tid >> 5;
    const float gam = 1.0f - exp2f(-5.0f - (float)h);
    const size_t ro = (size_t)(MP + b) * (2 * RW) + h * DK;
    { const int d = tid & 127, part = tid >> 7;
      if (part < 2) { const int dl = d & 63;
          const float x1 = px[0], x2 = px[1];
          const float cs = ((const float*)(F.ws + WS_TAB + TB_COS))[2048 * 64 + dl], sn = ((const float*)(F.ws + WS_TAB + TB_SIN))[2048 * 64 + dl];
          const float o = d < 64 ? x1 * cs - x2 * sn : x1 * sn + x2 * cs;
          if (part == 0) sq[d] = o; else sk[d] = o * (0.08838834764831845f / gam);
      } else { const float x = px[0]; if (part == 2) sv[d] = x; else sz[d] = x * sigmoidf_(x); } }
    __syncthreads();
    const f32x4 vv = *(const f32x4*)(sv + 4 * cg); f32x4 o = (f32x4){0.f, 0.f, 0.f, 0.f};
#pragma unroll
    for (int i = 0; i < 8; ++i) { const float kk = sk[rg + 16 * i], qq = sq[rg + 16 * i]; S[i] = (S[i] + vv * kk) * gam; o += S[i] * qq;
        __builtin_nontemporal_store(S[i], (f32x4*)(Sout + (size_t)(rg + 16 * i) * DK + 4 * cg)); }
    *(f32x4*)(red + rg * 128 + 4 * cg) = o;
    __syncthreads();
    float ov = 0.f;
    if (tid < 128) {
#pragma unroll
        for (int rr = 0; rr < 16; ++rr) ov += red[rr * 128 + tid];
        const float t1 = wave_sum(ov); if (F.lane == 0) stat[F.wave] = t1;
    }
    __syncthreads();
    float dv_ = 0.f;
    if (tid < 128) { const float mu = (stat[0] + stat[1]) * (1.0f / 128.0f); dv_ = ov - mu; const float t2 = wave_sum(dv_ * dv_); if (F.lane == 0) stat[2 + F.wave] = t2; }
    __syncthreads();
    if (tid < 128) { const float var = (stat[2] + stat[3]) * (1.0f / 128.0f); const float on = dv_ * (1.0f / sqrtf(var + EPSF));
        AA[ro + tid] = (bf16)f2bf(on * sz[tid]); }
    __syncthreads();
}
__device__ __forceinline__ void s5_sample_wave(Frame& F, const Args& args, int g, int b0, int bstep) {
    bf16* Y = (bf16*)(F.ws + WS_Y);
    const int p = launder(F.lane) & 63, gp = g * SP + p;
    const float* PSl = (const float*)(F.ws + WS_PS) + (size_t)(p >> 4) * PS_SLAB + 4096 + g * SN + (p & 15);
    float uq[4], xq[4], yq[4];
#pragma unroll
    for (int k = 0; k < 4; ++k) { const int b = b0 + k * bstep; uq[k] = 0.f; xq[k] = 0.f; yq[k] = 0.f;
        if (b < MS) { uq[k] = PSl[(size_t)b * INC]; xq[k] = args.in[3][(size_t)(b * SG + g) * SP + p]; yq[k] = args.in[4][(size_t)(b * SG + g) * SP + p]; } }
    float br[SN], bi[SN], crv[SN], civ[SN];
    { const f32x4* tb = (const f32x4*)((const float*)(F.ws + WS_TAB + TB_BR) + (size_t)gp * SN); const f32x4* ti = (const f32x4*)((const float*)(F.ws + WS_TAB + TB_BI) + (size_t)gp * SN);
#pragma unroll
      for (int q4 = 0; q4 < 4; ++q4) { const f32x4 a = tb[q4], c = ti[q4]; br[4 * q4] = a[0]; br[4 * q4 + 1] = a[1]; br[4 * q4 + 2] = a[2]; br[4 * q4 + 3] = a[3]; bi[4 * q4] = c[0]; bi[4 * q4 + 1] = c[1]; bi[4 * q4 + 2] = c[2]; bi[4 * q4 + 3] = c[3]; } }
#pragma unroll
    for (int n = 0; n < SN; ++n) { crv[n] = args.in[16][(g * SN + n) * SP + p]; civ[n] = args.in[17][(g * SN + n) * SP + p]; }
    const float ar = ((const float*)(F.ws + WS_TAB + TB_AR))[gp], ai = ((const float*)(F.ws + WS_TAB + TB_AI))[gp];
    const float dnv = args.in[18][g * SN + (p & 15)];
    for (int bb = b0; bb < MS; bb += 4 * bstep) {
        if (bb != b0) {
#pragma unroll
            for (int k = 0; k < 4; ++k) { const int b = bb + k * bstep;
                if (b < MS) { uq[k] = PSl[(size_t)b * INC]; xq[k] = args.in[3][(size_t)(b * SG + g) * SP + p]; yq[k] = args.in[4][(size_t)(b * SG + g) * SP + p]; } }
        }
#pragma unroll
        for (int k = 0; k < 4; ++k) { const int b = bb + k * bstep;
            if (b < MS) {
                float un = uq[k]; un += __shfl_xor(un, 16); un += __shfl_xor(un, 32);
                const float x0r = xq[k], x0i = yq[k];
                float bur = 0.f, bui = 0.f;
#pragma unroll
                for (int n = 0; n < SN; ++n) { const float u = __builtin_bit_cast(float, __builtin_amdgcn_readlane(__builtin_bit_cast(int, un), n)); bur += br[n] * u; bui += bi[n] * u; }
                const float xr = ar * x0r - ai * x0i + bur, xi = ar * x0i + ai * x0r + bui;
                float yv = 0.f;
#pragma unroll
                for (int n = 0; n < SN; ++n) { const float sm = wave_sum(crv[n] * xr - civ[n] * xi); if ((p & 15) == n) yv = sm; }
                F.out[O_RES + (size_t)(b * SG + g) * SP + p] = xr; F.out[O_IMS + (size_t)(b * SG + g) * SP + p] = xi;
                if (p < 16) { const float y = yv + dnv * un; Y[(size_t)(MP + b) * SW + g * SN + p] = (bf16)f2bf(gelu_tanh(y)); }
            }
        }
    }
}
constexpr int S5_XLOC = 0, S5_XIN = 8192, S5_XIM = 32768;
__device__ __forceinline__ void s5_unit(Frame& F, const Args& args, int b, int g) {
    LAS unsigned char* lds = F.lds;
    const bf16* UBg = (const bf16*)(F.ws + WS_UB) + (size_t)g * MPAD * 16; bf16* Y = (bf16*)(F.ws + WS_Y);
    const float* tar = (const float*)(F.ws + WS_TAB + TB_AR); const float* tai = (const float*)(F.ws + WS_TAB + TB_AI);
    const float* tbr = (const float*)(F.ws + WS_TAB + TB_BR); const float* tbi = (const float*)(F.ws + WS_TAB + TB_BI);
    const int w = F.wave, lane = launder(F.lane), c = lane & 31, h = lane >> 5;
    const size_t rb = (size_t)b * SEQ;
    bf16x8 bfr[4];
#pragma unroll
    for (int f = 0; f < 4; ++f) { const float* src = ((f >> 1) ? tbi : tbr) + (size_t)(g * SP + c + 32 * (f & 1)) * SN + 8 * h;
        const f32x4 v0 = *(const f32x4*)src, v1 = *(const f32x4*)(src + 4);
        v4u t; t.x = cvtpk(v0[0], v0[1]); t.y = cvtpk(v0[2], v0[3]); t.z = cvtpk(v1[0], v1[1]); t.w = cvtpk(v1[2], v1[3]); bfr[f] = __builtin_bit_cast(bf16x8, t); }
    float ar[2], ai[2];
#pragma unroll
    for (int ps = 0; ps < 2; ++ps) { ar[ps] = tar[g * SP + c + 32 * ps]; ai[ps] = tai[g * SP + c + 32 * ps]; }
    const int rho = lane & 31, hr = (rho >> 2) & 1, ir = (rho & 3) + 4 * (rho >> 3);
    const bf16* arow = UBg + (rb + 128 * (size_t)(2 * w + hr) + ir) * 16 + 8 * h;
    f32x16 zero16;
#pragma unroll
    for (int i = 0; i < 16; ++i) zero16[i] = 0.f;
    float xr[2] = {0.f, 0.f}, xi[2] = {0.f, 0.f};
    bf16x8 afr[8];
#pragma unroll
    for (int blk = 0; blk < 8; ++blk) afr[blk] = *(const bf16x8*)(arow + (size_t)blk * 256);
#pragma unroll
    for (int blk = 0; blk < 8; ++blk) {
        const bf16x8 A = afr[blk];
        f32x16 bu[4];
#pragma unroll
        for (int f = 0; f < 4; ++f) bu[f] = MFMA32(A, bfr[f], zero16);
#pragma unroll
        for (int i = 0; i < 16; ++i)
#pragma unroll
            for (int ps = 0; ps < 2; ++ps) { const float nr = fmaf(ar[ps], xr[ps], fmaf(-ai[ps], xi[ps], bu[ps][i])), ni = fmaf(ar[ps], xi[ps], fmaf(ai[ps], xr[ps], bu[2 + ps][i])); xr[ps] = nr; xi[ps] = ni; }
    }
    LAS f32x2v* xloc = (LAS f32x2v*)(lds + S5_XLOC); LAS f32x2v* xin = (LAS f32x2v*)(lds + S5_XIN);
#pragma unroll
    for (int ps = 0; ps < 2; ++ps) xloc[(2 * w + h) * 64 + c + 32 * ps] = (f32x2v){xr[ps], xi[ps]};
    LDS_WAIT(); __syncthreads();
    if (w == 0) {
        float a_r = tar[g * SP + lane], a_i = tai[g * SP + lane];
#pragma unroll
        for (int k = 0; k < 7; ++k) { const float nr = a_r * a_r - a_i * a_i, ni = 2.0f * a_r * a_i; a_r = nr; a_i = ni; }
        float sr = 0.f, si = 0.f;
        for (int sgm = 0; sgm < 16; ++sgm) { xin[sgm * 64 + lane] = (f32x2v){sr, si}; const f32x2v l = xloc[sgm * 64 + lane];
            const float nr = a_r * sr - a_i * si + l.x, ni = a_r * si + a_i * sr + l.y; sr = nr; si = ni; }
        F.out[O_REP + (size_t)(b * SG + g) * SP + lane] = sr; F.out[O_IMP + (size_t)(b * SG + g) * SP + lane] = si;
    }
    LDS_WAIT(); __syncthreads();
#pragma unroll
    for (int ps = 0; ps < 2; ++ps) { const f32x2v v = xin[(2 * w + h) * 64 + c + 32 * ps]; xr[ps] = v.x; xi[ps] = v.y; }
    bf16x8 cfr[4];
    { const int n = lane & 15, kq = lane >> 4;
#pragma unroll
      for (int ks = 0; ks < 4; ++ks) { const float* src = ((ks >> 1) ? args.in[17] : args.in[16]) + (size_t)(g * SN + n) * SP + 32 * (ks & 1) + 8 * kq; const float sgn = (ks >> 1) ? -1.0f : 1.0f;
          const f32x4 v0 = *(const f32x4*)src * sgn, v1 = *(const f32x4*)(src + 4) * sgn;
          v4u t; t.x = cvtpk(v0[0], v0[1]); t.y = cvtpk(v0[2], v0[3]); t.z = cvtpk(v1[0], v1[1]); t.w = cvtpk(v1[2], v1[3]); cfr[ks] = __builtin_bit_cast(bf16x8, t); } }
    const int tq = lane & 15, nq = lane >> 4;
    const f32x4 dn = *(const f32x4*)(args.in[18] + g * SN + 4 * nq);
    LAS unsigned char* xim = lds + S5_XIM + w * 8192;
    v2u uvs[8][2];
#pragma unroll
    for (int blk = 0; blk < 8; ++blk)
#pragma unroll
        for (int sq = 0; sq < 2; ++sq) uvs[blk][sq] = *(const v2u*)(UBg + (rb + 128 * (size_t)(2 * w + sq) + 16 * blk + tq) * 16 + 4 * nq);
#pragma unroll
    for (int blk = 0; blk < 8; ++blk) {
        const bf16x8 A = afr[blk];
        f32x16 bu[4];
#pragma unroll
        for (int f = 0; f < 4; ++f) bu[f] = MFMA32(A, bfr[f], zero16);
#pragma unroll
        for (int i = 0; i < 16; ++i)
#pragma unroll
            for (int ps = 0; ps < 2; ++ps) { const float nr = fmaf(ar[ps], xr[ps], fmaf(-ai[ps], xi[ps], bu[ps][i])), ni = fmaf(ar[ps], xi[ps], fmaf(ai[ps], xr[ps], bu[2 + ps][i])); xr[ps] = nr; xi[ps] = ni; bu[ps][i] = nr; bu[2 + ps][i] = ni; }
#pragma unroll
        for (int f = 0; f < 4; ++f) { LAS unsigned char* dst = xim + h * 4096 + ((f >> 1) * 64 + (f & 1) * 32 + c) * 32;
            *(LAS bf16x8*)dst = pack8(bu[f], 0); *(LAS bf16x8*)(dst + 16) = pack8(bu[f], 1); }
        LDS_WAIT(); asm volatile("" ::: "memory");
#pragma unroll
        for (int sq = 0; sq < 2; ++sq) {
            f32x4 yT = (f32x4){0.f, 0.f, 0.f, 0.f};
#pragma unroll
            for (int ks = 0; ks < 4; ++ks) {
                LAS unsigned char* base = xim + sq * 4096 + (32 * ks + 8 * nq + (tq >> 2)) * 32 + 8 * (tq & 3);
                const bf16x8 B = cat8(lds_tr(base), lds_tr(base + 4 * 32));
                yT = MFMA16(cfr[ks], B, yT);
            }
            const size_t row = rb + 128 * (size_t)(2 * w + sq) + 16 * blk + tq;
            const v2u uv = uvs[blk][sq];
            const float y0 = gelu_tanh(yT[0] + dn[0] * bf_lo(uv.x)), y1 = gelu_tanh(yT[1] + dn[1] * bf_hi(uv.x)), y2 = gelu_tanh(yT[2] + dn[2] * bf_lo(uv.y)), y3 = gelu_tanh(yT[3] + dn[3] * bf_hi(uv.y));
            v2u wv; wv.x = cvtpk(y0, y1); wv.y = cvtpk(y2, y3); *(v2u*)(Y + row * SW + g * SN + 4 * nq) = wv;
        }
        LDS_WAIT(); asm volatile("" ::: "memory");
    }
    __syncthreads();
}
__device__ __forceinline__ void p2_phase(Frame& F, const Args& args, int mask) {
    if (mask & 1) for (int pu = F.vcu; pu < 256; pu += F.G) { const int bh = pu >> 3, jj = pu & 7; for (int k2 = 0; k2 < 2; ++k2) ret_unit(F, bh >> 3, bh & 7, k2 ? 15 - jj : jj, k2 != 0, k2 ? -1 : 15 - jj); }
    if (mask & 2) for (int u5 = F.vcu; u5 < NBATCH * SG; u5 += F.G) s5_unit(F, args, u5 >> 6, u5 & 63);
    (void)0;
    const float* PSr = (const float*)(F.ws + WS_PS);
    const int it0 = F.vcu * NTHR + F.tid, its = F.G * NTHR;
    f32x4 xs[2][4];
    if (mask & 8) {
#pragma unroll
      for (int k = 0; k < 2; ++k) { const int it = it0 + k * its;
        if (it < MS * (5120 / 4)) { const float* p = PSr + (size_t)(it / 1280) * INC + 5120 + 4 * (it % 1280);
#pragma unroll
          for (int sl = 0; sl < 4; ++sl) xs[k][sl] = *(const f32x4*)(p + (size_t)sl * PS_SLAB); } }
    }
    const int gw = F.vcu * NWAVES + F.wave, NGW = F.G * NWAVES;
    if (mask & 8) { if (NGW % SG == 0) s5_sample_wave(F, args, gw % SG, gw / SG, NGW / SG); else for (int v = gw; v < MS * SG; v += NGW) s5_sample_wave(F, args, v % SG, v / SG, MS); }
    if (mask & 8) {
      for (int it = it0, k = 0; it < MS * (5120 / 4); it += its, ++k) { const int b = it / 1280, n = 5120 + 4 * (it % 1280);
        f32x4 x;
        if (k == 0) x = (xs[0][0] + xs[0][1]) + (xs[0][2] + xs[0][3]);
        else if (k == 1) x = (xs[1][0] + xs[1][1]) + (xs[1][2] + xs[1][3]);
        else { const float* p = PSr + (size_t)b * INC + n; x = (*(const f32x4*)p + *(const f32x4*)(p + PS_SLAB)) + (*(const f32x4*)(p + 2 * PS_SLAB) + *(const f32x4*)(p + 3 * PS_SLAB)); }
        f32x4 o; for (int e = 0; e < 4; ++e) { const float sg = sigmoidf_(x[e]); o[e] = n < 6144 ? x[e] * sg : sg; }
        bf16* dst = n < 6144 ? (bf16*)(F.ws + WS_ZB) + (size_t)(MP + b) * SW + (n - 5120) : (n < 8192 ? (bf16*)(F.ws + WS_GAS) + (size_t)b * DM + (n - 6144) : (bf16*)(F.ws + WS_GBS) + (size_t)b * DM + (n - 8192));
        *(v2u*)dst = pk4(o); } }
}

template <int NT>
__device__ __forceinline__ void sk_acc(f32x4 (&acc)[NT], const bf16* X, const bf16* Wt, int K, int n0, int wave, int lane) {
    const int kq = lane >> 4;
    const bf16* xp = X + (size_t)(16 * wave + (lane & 15)) * K + 8 * kq;
    const bf16* wp = Wt + (size_t)(n0 + (lane & 15)) * K + 8 * kq;
#pragma unroll
    for (int nt = 0; nt < NT; ++nt) acc[nt] = (f32x4){0.f, 0.f, 0.f, 0.f};
#pragma unroll 8
    for (int ks = 0; ks < K / 32; ++ks) {
        const bf16x8 a = *(const bf16x8*)(xp + 32 * ks);
#pragma unroll
        for (int nt = 0; nt < NT; ++nt) { const bf16x8 bw = *(const bf16x8*)(wp + (size_t)nt * 16 * K + 32 * ks); acc[nt] = MFMA16(bw, a, acc[nt]); }
    }
}
__device__ __forceinline__ f32x4 ld4bf(const bf16* p) { const v2u w = *(const v2u*)p; return (f32x4){bf_lo(w.x), bf_hi(w.x), bf_lo(w.y), bf_hi(w.y)}; }
__device__ __forceinline__ void p3_sample_ret(Frame& F, const Args& args, int idx, int nidle, int v0, int v1) {
    f32x4 Scur[8], Snxt[8]; float pc[2], pn[2];
    const float* PS = (const float*)(F.ws + WS_PS);
    int v = v0 + idx;
    if (v < v1) ret_sample_load(Scur, pc, args.in[2] + (size_t)v * DK * DK, PS, v, F.tid);
    for (; v < v1; v += nidle) {
        const bool hasn = v + nidle < v1;
        if (hasn) ret_sample_load(Snxt, pn, args.in[2] + (size_t)(v + nidle) * DK * DK, PS, v + nidle, F.tid);
        ret_sample_unit(F, v / NH, v % NH, Scur, pc, F.out + O_RS + (size_t)v * DK * DK);
        if (hasn) { pc[0] = pn[0]; pc[1] = pn[1];
#pragma unroll
            for (int i = 0; i < 8; ++i) Scur[i] = Snxt[i]; }
    }
}
__device__ __forceinline__ void sk_p3(Frame& F, const Args& args, int idx, int nidle);
template <int KS4>
__device__ __forceinline__ void skw_acc(f32x4 (&acc)[4], const bf16* X, const bf16* Wt, int K, int k0, int n0, int lane) {
    const int kq = lane >> 4;
    const bf16* xp = X + (size_t)(lane & 15) * K + k0 + 8 * kq;
    const bf16* wp = Wt + (size_t)(n0 + (lane & 15)) * K + k0 + 8 * kq;
    bf16x8 af[KS4][4], wf[KS4];
#pragma unroll
    for (int ks = 0; ks < KS4; ++ks) { wf[ks] = *(const bf16x8*)(wp + 32 * ks);
#pragma unroll
        for (int mt = 0; mt < 4; ++mt) af[ks][mt] = *(const bf16x8*)(xp + (size_t)mt * 16 * K + 32 * ks); }
#pragma unroll
    for (int ks = 0; ks < KS4; ++ks)
#pragma unroll
        for (int mt = 0; mt < 4; ++mt) acc[mt] = MFMA16(wf[ks], af[ks][mt], acc[mt]);
}
__device__ __forceinline__ f32x4 skw_reduce(Frame& F, const f32x4 (&acc)[4], int lane) {
    LAS f32x4* red = (LAS f32x4*)F.lds;
#pragma unroll
    for (int mt = 0; mt < 4; ++mt) red[(F.wave * 64 + 16 * mt + (lane & 15)) * 4 + (lane >> 4)] = acc[mt];
    LDS_WAIT(); __syncthreads();
    f32x4 sum = (f32x4){0.f, 0.f, 0.f, 0.f};
    if (F.tid < 256) {
#pragma unroll
        for (int wv = 0; wv < 8; ++wv) sum += red[wv * 256 + F.tid]; }
    LDS_WAIT(); __syncthreads();
    return sum;
}
__device__ __forceinline__ void sk_p3(Frame& F, const Args& args, int idx, int nidle) {
    for (int task = idx; task < 2 * (SW / 16); task += nidle) {
        const int ct = task >> 1, r0 = 64 * (task & 1);
        const int lane = launder(F.lane) & 63; f32x4 acc[4];
#pragma unroll
        for (int mt = 0; mt < 4; ++mt) acc[mt] = (f32x4){0.f, 0.f, 0.f, 0.f};
        skw_acc<4>(acc, (const bf16*)(F.ws + WS_Y) + (size_t)(MP + r0) * SW, (const bf16*)(F.ws + WS_WGLU), SW, 128 * F.wave, 16 * ct, lane);
        const f32x4 gsum = skw_reduce(F, acc, lane);
        const int tid = launder(F.tid) & 511;
        if (tid < 256) { const int m = r0 + (tid >> 2), n = 16 * ct + 4 * (tid & 3); const size_t off = (size_t)(MP + m) * SW + n;
            const f32x4 gg = gsum + *(const f32x4*)(args.in[20] + n), yv = ld4bf((const bf16*)(F.ws + WS_Y) + off), zv = ld4bf((const bf16*)(F.ws + WS_ZB) + off);
            f32x4 o; for (int e = 0; e < 4; ++e) o[e] = yv[e] * sigmoidf_(gg[e]) * zv[e];
            *(v2u*)((bf16*)(F.ws + WS_AAB) + (size_t)(MP + m) * (2 * SW) + SW + n) = pk4(o); }
    }
}
__device__ __forceinline__ void skx_partial(Frame& F, const bf16* X, const bf16* Wt, float* PART) {
    for (int task = F.vcu; task < 256; task += F.G) {
        const int sl = task >> 5, cb = task & 31;
        const int lane = launder(F.lane) & 63, m15 = lane & 15, kq = lane >> 4, rq = F.wave & 3, chh = F.wave >> 2;
        const bf16* xp = X + (size_t)(32 * rq + m15) * DM + 256 * sl + 8 * kq;
        const bf16* wp = Wt + (size_t)(64 * cb + 32 * chh + m15) * DM + 256 * sl + 8 * kq;
        bf16x8 af[2][8], wf[2][8];
#pragma unroll
        for (int t = 0; t < 2; ++t)
#pragma unroll
            for (int ks = 0; ks < 8; ++ks) { af[t][ks] = *(const bf16x8*)(xp + (size_t)t * 16 * DM + 32 * ks); wf[t][ks] = *(const bf16x8*)(wp + (size_t)t * 16 * DM + 32 * ks); }
        f32x4 acc[2][2];
#pragma unroll
        for (int mt = 0; mt < 2; ++mt)
#pragma unroll
            for (int nt = 0; nt < 2; ++nt) acc[mt][nt] = (f32x4){0.f, 0.f, 0.f, 0.f};
#pragma unroll
        for (int ks = 0; ks < 8; ++ks)
#pragma unroll
            for (int mt = 0; mt < 2; ++mt)
#pragma unroll
                for (int nt = 0; nt < 2; ++nt) acc[mt][nt] = MFMA16(wf[nt][ks], af[mt][ks], acc[mt][nt]);
        float* po = PART + ((size_t)sl * MS + 32 * rq + m15) * DM + 64 * cb + 32 * chh + 4 * kq;
#pragma unroll
        for (int mt = 0; mt < 2; ++mt)
#pragma unroll
            for (int nt = 0; nt < 2; ++nt) *(f32x4*)(po + (size_t)mt * 16 * DM + 16 * nt) = acc[mt][nt];
    }
}
__device__ __forceinline__ void skx_merge(Frame& F) {
    const float* P = (const float*)(F.ws + WS_PART4); constexpr size_t SL = (size_t)MS * DM;
    const int tid = launder(F.tid) & 511;
    if (tid < 256) for (int it = F.vcu * 256 + tid; it < MS * (DM / 4); it += F.G * 256) {
        const size_t goff = (size_t)(it >> 9) * DM + 4 * (it & 511);
        const float* p = P + goff;
        const f32x4 ya = (*(const f32x4*)p + *(const f32x4*)(p + SL)) + (*(const f32x4*)(p + 2 * SL) + *(const f32x4*)(p + 3 * SL));
        const f32x4 yb = (*(const f32x4*)(p + 4 * SL) + *(const f32x4*)(p + 5 * SL)) + (*(const f32x4*)(p + 6 * SL) + *(const f32x4*)(p + 7 * SL));
        const f32x4 o = ld4bf((const bf16*)(F.ws + WS_GAS) + goff) * ya + ld4bf((const bf16*)(F.ws + WS_GBS) + goff) * yb;
        *(v2u*)((bf16*)(F.ws + WS_MRG) + (size_t)MP * DM + goff) = pk4(o); }
}

__device__ __forceinline__ void p6_load(v2u (&ov)[8], f32x4 (&xv)[8], const bf16* OUT, const Args& args, int m, int lane) {
    const float* xrow = m < MP ? args.in[0] + (size_t)m * DM : args.in[1] + (size_t)(m - MP) * DM;
    const GAS v2u* orow = (const GAS v2u*)(OUT + (size_t)m * DM) + lane; const GAS f32x4* xr = (const GAS f32x4*)xrow + lane;
#pragma unroll
    for (int j = 0; j < 8; ++j) { ov[j] = orow[64 * j]; xv[j] = __builtin_nontemporal_load(xr + 64 * j); }
}
__device__ __forceinline__ void p6_final(Frame& F, const Args& args) {
    const bf16* OUT = (const bf16*)(F.ws + WS_OUT);
    const int gw = F.vcu * NWAVES + F.wave, NGW = F.G * NWAVES;
    f32x4 gq[8];
    { const GAS f32x4* gr = (const GAS f32x4*)args.in[10] + F.lane;
#pragma unroll
      for (int j = 0; j < 8; ++j) gq[j] = gr[64 * j]; }
    for (int r = F.vcu; r < MS; r += F.G) {
        const int c = 256 * F.wave + 4 * F.lane; constexpr size_t SL = (size_t)MS * DM;
        const float* p = (const float*)(F.ws + WS_PART5) + (size_t)r * DM + c;
        const f32x4 xv = *(const f32x4*)(args.in[1] + (size_t)r * DM + c), gv = *(const f32x4*)(args.in[10] + c);
        const f32x4 v = ((*(const f32x4*)p + *(const f32x4*)(p + SL)) + (*(const f32x4*)(p + 2 * SL) + *(const f32x4*)(p + 3 * SL))) + ((*(const f32x4*)(p + 4 * SL) + *(const f32x4*)(p + 5 * SL)) + (*(const f32x4*)(p + 6 * SL) + *(const f32x4*)(p + 7 * SL)));
        const float ws_ = wave_sum((v.x * v.x + v.y * v.y) + (v.z * v.z + v.w * v.w));
        LAS float* red = (LAS float*)F.lds;
        if (F.lane == 0) red[F.wave] = ws_;
        LDS_WAIT(); __syncthreads();
        float tot = 0.f;
#pragma unroll
        for (int w8 = 0; w8 < NWAVES; ++w8) tot += red[w8];
        const float rstd = 1.0f / sqrtf(tot * (1.f / DM) + EPSF);
        __builtin_nontemporal_store(xv + v * rstd * gv, (f32x4*)(F.out + O_YS + (size_t)r * DM + c));
        __syncthreads();
    }
    v2u oa[8], ob[8]; f32x4 xa[8], xb[8];
    int m = gw;
    if (m < MP) p6_load(oa, xa, OUT, args, m, F.lane);
    for (; m < MP; m += NGW) {
        const bool hasn = m + NGW < MP;
        if (hasn) p6_load(ob, xb, OUT, args, m + NGW, F.lane);
        float* yrow = m < MP ? F.out + O_YP + (size_t)m * DM : F.out + O_YS + (size_t)(m - MP) * DM;
        f32x4 v[8]; float s = 0.f;
#pragma unroll
        for (int j = 0; j < 8; ++j) { v[j] = (f32x4){bf_lo(oa[j].x), bf_hi(oa[j].x), bf_lo(oa[j].y), bf_hi(oa[j].y)}; s += (v[j].x * v[j].x + v[j].y * v[j].y) + (v[j].z * v[j].z + v[j].w * v[j].w); }
        const float rstd = 1.0f / sqrtf(wave_sum(s) * (1.f / DM) + EPSF);
        GAS f32x4* yo = (GAS f32x4*)yrow + F.lane;
#pragma unroll
        for (int j = 0; j < 8; ++j) __builtin_nontemporal_store(xa[j] + v[j] * rstd * gq[j], yo + 64 * j);
        if (hasn) {
#pragma unroll
            for (int j = 0; j < 8; ++j) { oa[j] = ob[j]; xa[j] = xb[j]; } }
    }
}

__global__ void __launch_bounds__(NTHR, 2) fwd_kernel(Args args) {
    extern __shared__ __attribute__((aligned(16))) unsigned char lds[];
    Frame F;
    F.lds = (LAS unsigned char*)lds;
    F.MISC = (volatile LAS unsigned*)(F.lds + MISC_OFF);
    F.tid = threadIdx.x; F.lane = F.tid & 63; F.wave = __builtin_amdgcn_readfirstlane(F.tid >> 6);
    F.G = gridDim.x; { const int bx = blockIdx.x; F.vcu = (F.G % 8 == 0) ? (bx % 8) * (F.G / 8) + bx / 8 : bx; }
    F.out = args.out; F.ws = args.ws;
    for (int u = F.tid; u < (LDS_BYTES - LDSCTL_OFF) / 4; u += NTHR) ((LAS unsigned*)(F.lds + LDSCTL_OFF))[u] = 0u;
    __syncthreads();
    unsigned* ctl = (unsigned*)(args.ws + WS_CTL);
    XcdBarrier bar; bar.bar = ctl + CW_BAR + args.li * XCD_BAR_WORDS; bar.x = 0; bar.st = nullptr;
    const int lo = args.ph_lo, hi = args.ph_hi;
    bar = xcd_barrier_post(ctl + CW_BAR + args.li * XCD_BAR_WORDS, F.MISC + 8);
#define IN(k) (lo <= (k) && (k) < hi)
#define BOTH(k) (IN(k) && IN((k) + 1))
#define GRID_BAR() xcd_barrier(bar)

    if (IN(0)) for (int rep = 0; rep < (REP_PHASE == 0 ? 2 : 1); ++rep) { p0_prologue(F, args); if (BOTH(0)) GRID_BAR(); }

    if (IN(1)) for (int rep = 0; rep < (REP_PHASE == 1 ? 2 : 1); ++rep) {
        pg8::Gemm g{(const bf16*)(F.ws + WS_H), (const bf16*)(F.ws + WS_WIN), nullptr, nullptr, DM};
        pg8::ProjOrder S; S.init(MP, INC, F.G, (int)blockIdx.x);
        EpiProj E{(bf16*)(F.ws + WS_Q), (bf16*)(F.ws + WS_K), (bf16*)(F.ws + WS_V), (bf16*)(F.ws + WS_ZA), (bf16*)(F.ws + WS_UB), (bf16*)(F.ws + WS_ZB), (bf16*)(F.ws + WS_GA), (bf16*)(F.ws + WS_GB),
                  (const float*)(F.ws + WS_TAB + TB_COS), (const float*)(F.ws + WS_TAB + TB_SIN), (float*)(F.ws + WS_PS)};
        { const int nun = MP / 256 * (INC / 256) + 4 * (INC / 256), rem = nun % F.G;
          if (rem == 0) p1_convert_rest(F, args, (int)blockIdx.x, F.G); else if ((int)blockIdx.x >= rem) p1_convert_rest(F, args, (int)blockIdx.x - rem, F.G - rem);
          __syncthreads(); }
        pg8::gemm_phase<EpiProj, pg8::ProjOrder, true, true>(F.lds, g, S, E);
        if (BOTH(1)) GRID_BAR();
    }

    if (IN(2)) for (int rep = 0; rep < (REP_PHASE == 2 ? 2 : 1); ++rep) { p2_phase(F, args, args.pad ? args.pad : 15); if (BOTH(2)) GRID_BAR(); }

    if (IN(3)) for (int rep = 0; rep < (REP_PHASE == 3 ? 2 : 1); ++rep) {
        pg8::Gemm g{(const bf16*)(F.ws + WS_Y), (const bf16*)(F.ws + WS_WGLU), nullptr, nullptr, SW};
        pg8::StaticOrder S; S.init(MP, SW, F.G, (int)blockIdx.x);
        EpiGlu E{(const bf16*)(F.ws + WS_Y), (const bf16*)(F.ws + WS_ZB), (bf16*)(F.ws + WS_AAB), args.in[20]};
        pg8::gemm_phase<EpiGlu, pg8::StaticOrder, true, true>(F.lds, g, S, E);
        if (F.G > 128) { if ((int)blockIdx.x >= 128) sk_p3(F, args, (int)blockIdx.x - 128, F.G - 128); } else sk_p3(F, args, (int)blockIdx.x, F.G);
        if (F.G == 256) { if ((int)blockIdx.x >= 128) p3_sample_ret(F, args, (int)blockIdx.x - 128, 128, 0, 768); else p3_sample_ret(F, args, (int)blockIdx.x, 128, 768, MS * NH); }
        else if (F.G > 128) { if ((int)blockIdx.x >= 128) p3_sample_ret(F, args, (int)blockIdx.x - 128, F.G - 128, 0, MS * NH); } else p3_sample_ret(F, args, (int)blockIdx.x, F.G, 0, MS * NH);
        if (BOTH(3)) GRID_BAR();
    }

    if (IN(4)) for (int rep = 0; rep < (REP_PHASE == 4 ? 2 : 1); ++rep) {
        pg8::Gemm g{(const bf16*)(F.ws + WS_AAB), (const bf16*)(F.ws + WS_WPA), nullptr, nullptr, 2 * RW};
        pg8::StaticOrder S; S.init(MP, DM, F.G, (int)blockIdx.x);
        EpiMerge E{(const unsigned char*)(F.ws + WS_G8A), (const unsigned char*)(F.ws + WS_G8B), (bf16*)(F.ws + WS_MRG)};
        skx_partial(F, (const bf16*)(F.ws + WS_AAB) + (size_t)MP * DM, (const bf16*)(F.ws + WS_WPA), (float*)(F.ws + WS_PART4));
        pg8::gemm_phase<EpiMerge, pg8::StaticOrder, true, true>(F.lds, g, S, E);
        if (BOTH(4)) GRID_BAR();
    }

    const bool fuse5 = false;
    if (IN(5)) for (int rep = 0; rep < (REP_PHASE == 5 ? 2 : 1); ++rep) {
        pg8::Gemm g{(const bf16*)(F.ws + WS_MRG), (const bf16*)(F.ws + WS_WOUT), nullptr, nullptr, DM};
        pg8::StaticOrder S; S.init(MP, DM, F.G, (int)blockIdx.x);
        {
            EpiOutBf16 E{(bf16*)(F.ws + WS_OUT), DM};
            unsigned* sbd = ctl + CW_SBD + args.li * SB_WORDS;
            skx_merge(F);
            split_arrive(bar, sbd);
            pg8::gemm_phase<EpiOutBf16, pg8::StaticOrder, true, true>(F.lds, g, S, E);
            split_wait(bar, sbd);
            skx_partial(F, (const bf16*)(F.ws + WS_MRG) + (size_t)MP * DM, (const bf16*)(F.ws + WS_WOUT), (float*)(F.ws + WS_PART5));
            if (BOTH(5)) GRID_BAR();
        }
    }

    if (IN(6) && !fuse5) for (int rep = 0; rep < (REP_PHASE == 6 ? 2 : 1); ++rep) { p6_final(F, args); if (REP_PHASE == 6 && rep == 0) GRID_BAR(); }
#undef IN
#undef BOTH
#undef GRID_BAR
}

extern "C" void kernel_launch(void* const* d_in, const int* in_sizes, int n_in, void* d_out, int out_size, void* d_ws, size_t ws_size, hipStream_t stream) {
    static int grid = 0;
    if (grid == 0) {
        if (n_in != 21 || out_size != (int)O_END || ws_size < WS_END2) { fprintf(stderr, "kernel_launch: unexpected shapes: n_in %d out %d ws %zu\n", n_in, out_size, ws_size); grid = -1; return; }
        int dev = 0, cus = 0, per_cu = 0;
        if (hipGetDevice(&dev) != hipSuccess || hipDeviceGetAttribute(&cus, hipDeviceAttributeMultiprocessorCount, dev) != hipSuccess) { grid = -1; return; }
        if (hipFuncSetAttribute((const void*)fwd_kernel, hipFuncAttributeMaxDynamicSharedMemorySize, LDS_BYTES) != hipSuccess) { fprintf(stderr, "kernel_launch: hipFuncSetAttribute failed\n"); grid = -1; return; }
        if (hipOccupancyMaxActiveBlocksPerMultiprocessor(&per_cu, (const void*)fwd_kernel, NTHR, LDS_BYTES) != hipSuccess || per_cu < 1) { fprintf(stderr, "kernel_launch: occupancy query says %d\n", per_cu); (void)hipGetLastError(); grid = -1; return; }
        grid = cus;
    }
    if (grid < 0) return;
    (void)hipMemsetAsync((char*)d_ws + WS_CTL, 0, MK_N_LAUNCHES == 1 ? CTL_ZERO_BYTES : 256 * 1024, stream);
    Args a{};
    for (int i = 0; i < 21; ++i) a.in[i] = (const float*)d_in[i];
    a.out = (float*)d_out; a.ws = (unsigned char*)d_ws;
#if MK_N_LAUNCHES == 1
    a.ph_lo = 0; a.ph_hi = N_PHASES; a.li = 0;
    hipLaunchKernelGGL(fwd_kernel, dim3(grid), dim3(NTHR), LDS_BYTES, stream, a);
#else
    { const int seq[] = {PROBE_SEQ};
      for (unsigned q = 0; q < sizeof(seq) / sizeof(seq[0]); ++q) { a.ph_lo = seq[q] & 15; a.ph_hi = (seq[q] & 15) + 1; a.li = (int)q; a.pad = seq[q] >> 4; hipLaunchKernelGGL(fwd_kernel, dim3(grid), dim3(NTHR), LDS_BYTES, stream, a); } }
#endif
}
```

```cpp
#include <hip/hip_runtime.h>
#include <cstdio>
#include <cstdint>

#ifndef MK_N_LAUNCHES
#define MK_N_LAUNCHES 1
#endif
#ifndef PROBE_SEQ
#define PROBE_SEQ 0, 1, 2, 3, 4, 5, 6
#endif
#ifndef REP_PHASE
#define REP_PHASE -1
#endif

namespace pg8 {
#define PG8_LAS __attribute__((address_space(3)))
typedef unsigned short bf16_t;
typedef short bf16x8 __attribute__((ext_vector_type(8)));
typedef float f32x4 __attribute__((ext_vector_type(4)));
typedef float f32x2 __attribute__((ext_vector_type(2)));
typedef unsigned u32x4 __attribute__((ext_vector_type(4)));
typedef unsigned u32x2 __attribute__((ext_vector_type(2)));
constexpr int BM = 256, BK = 64, HALF = 128, HTB = HALF * BK * 2, STAGE_BYTES = 8 * HTB, NXCD = 8, WGM = 8;

__host__ __device__ __forceinline__ int lds_byte(int r, int c) { const int st = (r >> 4) * 2 + (c >> 5), rr = r & 15, cc = c & 31, ob = rr * 64 + cc * 2; return st * 1024 + (ob ^ (((ob >> 9) & 1) << 5)); }
__host__ __device__ __forceinline__ void stage_rc(int b, int& R, int& C) { const int st = b / 1024, sb = b % 1024, swz = sb ^ (((sb >> 9) & 1) << 5); R = (st >> 1) * 16 + swz / 64; C = (st & 1) * 32 + (swz % 64) / 2; }
__host__ __device__ __forceinline__ int perm32(int rho) { const int n = rho >> 4, i = rho & 15; return 8 * (i >> 2) + 4 * n + (i & 3); }

struct Unit { int pm, pn, z; };
struct Gemm { const bf16_t* A0; const bf16_t* B0; const bf16_t* A1; const bf16_t* B1; int K; };

struct StaticOrder {
    int nM, nN, nwg, G, c;
    __host__ __device__ void init(int M, int N, int G_, int c_) { nM = M / BM; nN = N / BM; nwg = nM * nN; G = G_; c = c_; }
    __host__ __device__ bool next(int i, Unit& u) const {
        const long L = (long)i * G + c; if (L >= nwg) return false;
        int wgid = (int)L; { const int q = nwg / NXCD, r = nwg % NXCD, xcd = wgid % NXCD, off = wgid / NXCD; wgid = (xcd < r ? xcd * (q + 1) : r * (q + 1) + (xcd - r) * q) + off; }
        const int nig = WGM * nN, gid = wgid / nig, fm = gid * WGM, gsz = (nM - fm) < WGM ? (nM - fm) : WGM;
        u.pm = fm + ((wgid % nig) % gsz); u.pn = (wgid % nig) / gsz; u.z = 0; return true;
    }
    __host__ __device__ int kofs(const Unit&, int) const { return 0; }
    __host__ __device__ int ktiles(const Unit&, int K) const { return K / BK; }
};
struct ProjOrder {
    StaticOrder so; int G, c;
    __host__ __device__ void init(int M, int N, int G_, int c_) { so.init(M, N, G_, c_); G = G_; c = c_; }
    __host__ __device__ bool next(int i, Unit& u) const {
        const long L = (long)i * G + c;
        if (L < so.nwg) return so.next(i, u);
        const int si = (int)(L - so.nwg); if (si >= 4 * so.nN) return false;
        u.pm = so.nM; u.pn = si % so.nN; u.z = 1 + si / so.nN; return true;
    }
    __host__ __device__ int kofs(const Unit& u, int) const { return u.z ? (u.z - 1) * 512 : 0; }
    __host__ __device__ int ktiles(const Unit& u, int K) const { return u.z ? 512 / BK : K / BK; }
};
struct PairOrder {
    int nM, nN, ntile, G, c;
    __host__ __device__ void init(int M, int N, int G_, int c_) { nM = M / BM; nN = N / BM; ntile = nM * nN; G = G_; c = c_; }
    __host__ __device__ bool next(int i, Unit& u) const {
        const long T = (long)(i >> 1) * G + c; if (T >= ntile) return false;
        u.pm = (int)(T % nM); u.pn = (int)(T / nM); u.z = i & 1; return true;
    }
    __host__ __device__ int kofs(const Unit&, int) const { return 0; }
    __host__ __device__ int ktiles(const Unit&, int K) const { return K / BK; }
};

__device__ __forceinline__ unsigned cvt_pk_bf16(float lo, float hi) { unsigned r; asm volatile("v_cvt_pk_bf16_f32 %0, %1, %2" : "=v"(r) : "v"(lo), "v"(hi)); return r; }
__device__ __forceinline__ float bf_lo(unsigned w) { return __uint_as_float(w << 16); }
__device__ __forceinline__ float bf_hi(unsigned w) { return __uint_as_float(w & 0xffff0000u); }
__device__ __forceinline__ float sigmoidf_(float x) { return __builtin_amdgcn_rcpf(1.0f + __expf(-x)); }

template <class Epi, class Sched, bool ALIGN_EPI = false, bool SP2 = false>
__device__ __forceinline__ void gemm_phase(PG8_LAS unsigned char* lds, const Gemm g, const Sched& S, const Epi& E) {
    const int tid = threadIdx.x, wid = __builtin_amdgcn_readfirstlane(tid >> 6), lane = tid & 63, wr = wid >> 2, wc = wid & 3, fr = lane & 15, fq = lane >> 4;
    const int K = g.K;
    unsigned voffA[2], voffB[2];
#pragma unroll
    for (int i = 0; i < 2; ++i) { int R, C; stage_rc(tid * 16 + i * 8192, R, C); const int Rb = Epi::PERM ? ((R & ~31) + perm32(R & 31)) : R;
        voffA[i] = (unsigned)(R * K + C) * 2u; voffB[i] = (unsigned)(Rb * K + C) * 2u; }
    const size_t kstep = (size_t)(BK * 2);
    const size_t hstep = (size_t)HALF * K * 2;
    const size_t tstep = 2 * hstep;
    const unsigned ldsw = (unsigned)wid * 1024u;
    const int aoff = lds_byte(wr * 64 + fr, fq * 8), boff = lds_byte(wc * 32 + fr, fq * 8);
#define PG8_SA(b, h) (((b) * 2 + (h)) * HTB)
#define PG8_SB(b, h) ((4 + (b) * 2 + (h)) * HTB)
#define PG8_STAGE(bufoff, gbase, voff) do { _Pragma("unroll") for (int _i = 0; _i < 2; ++_i) \
        __builtin_amdgcn_global_load_lds((const unsigned*)((const char*)(gbase) + (voff)[_i]), (PG8_LAS unsigned*)(lds + (bufoff) + ldsw + _i * 8192), 16, 0, 0); } while (0)
#define PG8_LDA(dst, b, h) do { _Pragma("unroll") for (int m = 0; m < 4; ++m) _Pragma("unroll") for (int k = 0; k < 2; ++k) dst[m][k] = *(const PG8_LAS bf16x8*)(lds + PG8_SA(b, h) + aoff + m * 2048 + k * 1024); } while (0)
#define PG8_LDB(dst, b, h) do { _Pragma("unroll") for (int n = 0; n < 2; ++n) _Pragma("unroll") for (int k = 0; k < 2; ++k) dst[n][k] = *(const PG8_LAS bf16x8*)(lds + PG8_SB(b, h) + boff + n * 2048 + k * 1024); } while (0)
#define PG8_MMA(ai, bj, At, Bt) do { __builtin_amdgcn_s_setprio(1); _Pragma("unroll") for (int m = 0; m < 4; ++m) _Pragma("unroll") for (int n = 0; n < 2; ++n) _Pragma("unroll") for (int k = 0; k < 2; ++k) \
        acc[ai][bj][m][n] = __builtin_amdgcn_mfma_f32_16x16x32_bf16(Bt[n][k], At[m][k], acc[ai][bj][m][n], 0, 0, 0); __builtin_amdgcn_s_setprio(0); } while (0)
#define PG8_WAIT_V(n) asm volatile("s_waitcnt vmcnt(" #n ")" ::: "memory")
#define PG8_WAIT_L(n) asm volatile("s_waitcnt lgkmcnt(" #n ")" ::: "memory")
#define PG8_BAR __builtin_amdgcn_s_barrier()
#define PG8_SCHED __builtin_amdgcn_sched_barrier(0)
#define PG8_PA(u) ((const char*)(((u).z && g.A1) ? g.A1 : g.A0) + (size_t)(u).pm * tstep + (size_t)S.kofs(u, K) * 2)
#define PG8_PB(u) ((const char*)(((u).z && g.B1) ? g.B1 : g.B0) + (size_t)(u).pn * tstep + (size_t)S.kofs(u, K) * 2)
    Unit cur, nxt; int ui = 0;
    if (!S.next(0, cur)) return;
    f32x4 acc[2][2][4][2];
#pragma unroll
    for (int a = 0; a < 2; ++a)
#pragma unroll
        for (int b = 0; b < 2; ++b)
#pragma unroll
            for (int m = 0; m < 4; ++m)
#pragma unroll
                for (int n = 0; n < 2; ++n) acc[a][b][m][n] = (f32x4){0.f, 0.f, 0.f, 0.f};
    bf16x8 At[4][2], B0[2][2], B1[2][2];
    const char* cA = PG8_PA(cur); const char* cB = PG8_PB(cur);
    if constexpr (SP2) {
        PG8_STAGE(PG8_SB(0, 0), cB, voffB); PG8_STAGE(PG8_SB(0, 1), cB + hstep, voffB); PG8_STAGE(PG8_SA(0, 0), cA, voffA); PG8_STAGE(PG8_SA(0, 1), cA + hstep, voffA);
        if (wr == 1) PG8_BAR;
        PG8_WAIT_V(2); PG8_BAR;
        PG8_STAGE(PG8_SB(1, 0), cB + kstep, voffB); PG8_STAGE(PG8_SA(1, 0), cA + kstep, voffA); PG8_STAGE(PG8_SB(1, 1), cB + hstep + kstep, voffB);
        PG8_WAIT_V(6); PG8_BAR;
    } else {
        PG8_STAGE(PG8_SB(0, 0), cB, voffB); PG8_STAGE(PG8_SA(0, 0), cA, voffA); PG8_STAGE(PG8_SB(0, 1), cB + hstep, voffB); PG8_STAGE(PG8_SA(0, 1), cA + hstep, voffA);
        if (wr == 1) PG8_BAR;
        PG8_WAIT_V(4); PG8_BAR;
        PG8_STAGE(PG8_SB(1, 0), cB + kstep, voffB); PG8_STAGE(PG8_SA(1, 0), cA + kstep, voffA); PG8_STAGE(PG8_SB(1, 1), cB + hstep + kstep, voffB);
        PG8_WAIT_V(6); PG8_BAR;
    }
    for (;;) {
        const bool has_next = S.next(ui + 1, nxt);
        const char* nA = has_next ? PG8_PA(nxt) : cA; const char* nB = has_next ? PG8_PB(nxt) : cB;
        const int nt = S.ktiles(cur, K);
        for (int t = 0; t < nt; t += 2) {
            if constexpr (Epi::MIDHOOK) { if (t == nt / 2) E.mid(acc, cur, wr, wc, fr, fq); }
            const bool last = (t == nt - 2);
            const char* a1 = cA + (size_t)(t + 1) * kstep;
            const char* a2 = last ? nA : cA + (size_t)(t + 2) * kstep; const char* b2 = last ? nB : cB + (size_t)(t + 2) * kstep;
            const char* a3 = a2 + kstep; const char* b3 = b2 + kstep;
            if constexpr (SP2) {
            PG8_LDB(B0, 0, 0); PG8_LDB(B1, 0, 1); PG8_SCHED; PG8_LDA(At, 0, 0); PG8_STAGE(PG8_SA(1, 1), a1 + hstep, voffA);
            PG8_WAIT_V(8); PG8_WAIT_L(0); PG8_BAR; PG8_MMA(0, 0, At, B0); PG8_MMA(0, 1, At, B1); PG8_BAR; PG8_SCHED;
            PG8_LDA(At, 0, 1); PG8_STAGE(PG8_SB(0, 0), b2, voffB); PG8_STAGE(PG8_SB(0, 1), b2 + hstep, voffB); PG8_STAGE(PG8_SA(0, 0), a2, voffA);
            PG8_WAIT_V(8); PG8_WAIT_L(0); PG8_BAR; PG8_MMA(1, 0, At, B0); PG8_MMA(1, 1, At, B1); PG8_BAR; PG8_SCHED;
            PG8_LDB(B0, 1, 0); PG8_LDB(B1, 1, 1); PG8_SCHED; PG8_LDA(At, 1, 0); PG8_STAGE(PG8_SA(0, 1), a2 + hstep, voffA);
            PG8_WAIT_V(8); PG8_WAIT_L(0); PG8_BAR; PG8_MMA(0, 0, At, B0); PG8_MMA(0, 1, At, B1); PG8_BAR; PG8_SCHED;
            PG8_LDA(At, 1, 1); PG8_STAGE(PG8_SB(1, 0), b3, voffB); PG8_STAGE(PG8_SB(1, 1), b3 + hstep, voffB); PG8_STAGE(PG8_SA(1, 0), a3, voffA);
            PG8_WAIT_V(8); PG8_WAIT_L(0); PG8_BAR; PG8_MMA(1, 0, At, B0); PG8_MMA(1, 1, At, B1); PG8_BAR; PG8_SCHED;
            } else {
            PG8_LDB(B0, 0, 0); PG8_SCHED; PG8_LDA(At, 0, 0); PG8_STAGE(PG8_SA(1, 1), a1 + hstep, voffA);
            PG8_WAIT_L(8); PG8_BAR; PG8_WAIT_L(0); PG8_MMA(0, 0, At, B0); PG8_BAR; PG8_SCHED;
            PG8_LDB(B1, 0, 1); PG8_STAGE(PG8_SB(0, 0), b2, voffB);
            PG8_BAR; PG8_WAIT_L(0); PG8_MMA(0, 1, At, B1); PG8_BAR;
            PG8_LDA(At, 0, 1); PG8_STAGE(PG8_SA(0, 0), a2, voffA);
            PG8_BAR; PG8_WAIT_L(0); PG8_MMA(1, 0, At, B0); PG8_BAR; PG8_SCHED;
            PG8_STAGE(PG8_SB(0, 1), b2 + hstep, voffB);
            PG8_WAIT_V(6); PG8_BAR; PG8_MMA(1, 1, At, B1); PG8_BAR;
            PG8_LDB(B0, 1, 0); PG8_SCHED; PG8_LDA(At, 1, 0); PG8_STAGE(PG8_SA(0, 1), a2 + hstep, voffA);
            PG8_WAIT_L(8); PG8_BAR; PG8_WAIT_L(0); PG8_MMA(0, 0, At, B0); PG8_BAR; PG8_SCHED;
            PG8_LDB(B1, 1, 1); PG8_STAGE(PG8_SB(1, 0), b3, voffB);
            PG8_BAR; PG8_WAIT_L(0); PG8_MMA(0, 1, At, B1); PG8_BAR;
            PG8_LDA(At, 1, 1); PG8_STAGE(PG8_SA(1, 0), a3, voffA);
            PG8_BAR; PG8_WAIT_L(0); PG8_MMA(1, 0, At, B0); PG8_BAR; PG8_SCHED;
            PG8_STAGE(PG8_SB(1, 1), b3 + hstep, voffB);
            PG8_WAIT_V(6); PG8_BAR; PG8_MMA(1, 1, At, B1); PG8_BAR;
            }
        }
        if constexpr (ALIGN_EPI) { if (wr == 0) PG8_BAR; }
        if constexpr (!Epi::AFTER_DRAIN) E(acc, cur, wr, wc, fr, fq);
        if (!has_next) break;
#pragma unroll
        for (int a = 0; a < 2; ++a)
#pragma unroll
            for (int b = 0; b < 2; ++b)
#pragma unroll
                for (int m = 0; m < 4; ++m)
#pragma unroll
                    for (int n = 0; n < 2; ++n) acc[a][b][m][n] = (f32x4){0.f, 0.f, 0.f, 0.f};
        cur = nxt; cA = nA; cB = nB; ++ui;
        if constexpr (ALIGN_EPI) { if (wr == 1) PG8_BAR; }
    }
    PG8_WAIT_V(0);
    __builtin_amdgcn_s_waitcnt(0x0F70);
    if constexpr (!ALIGN_EPI) { if (wr == 0) PG8_BAR; }
    PG8_BAR;
    if constexpr (Epi::AFTER_DRAIN) E.fused(acc, cur, wr, wc, fr, fq, lds, wid, lane);
#undef PG8_SA
#undef PG8_SB
#undef PG8_STAGE
#undef PG8_LDA
#undef PG8_LDB
#undef PG8_MMA
#undef PG8_WAIT_V
#undef PG8_WAIT_L
#undef PG8_BAR
#undef PG8_SCHED
#undef PG8_PA
#undef PG8_PB
}
}

constexpr int NWAVES = 8, NTHR = NWAVES * 64;
constexpr int DM = 2048, SEQ = 2048, NBATCH = 4, MP = NBATCH * SEQ, MS = 128, MV = MP + MS, MPAD = 8448;
constexpr int RW = 1024, NH = 8, DK = 128, SW = 1024, SG = 64, SP = 64, SN = 16;
constexpr int INC = 10240;
constexpr int POS_S = 16384;
constexpr float EPSF = 1e-6f;
constexpr int N_PHASES = 7;

constexpr size_t O_YP = 0, O_YS = O_YP + (size_t)MP * DM, O_RP = O_YS + (size_t)MS * DM, O_REP = O_RP + (size_t)NBATCH * NH * DK * DK,
                 O_IMP = O_REP + (size_t)NBATCH * SG * SP, O_RS = O_IMP + (size_t)NBATCH * SG * SP, O_RES = O_RS + (size_t)MS * NH * DK * DK,
                 O_IMS = O_RES + (size_t)MS * SG * SP, O_END = O_IMS + (size_t)MS * SG * SP;
static_assert(O_END == 35422208, "output size");

constexpr size_t MiB = 1u << 20;
constexpr size_t WS_CTL = 0, CTL_ZERO_BYTES = 64 * 1024;
constexpr size_t WS_WIN = 1 * MiB;
constexpr size_t WS_WPA = WS_WIN + 40 * MiB;
constexpr size_t WS_WPB = WS_WPA + 4 * MiB;
constexpr size_t WS_WOUT = WS_WPB + 4 * MiB;
constexpr size_t WS_WGLU = WS_WOUT + 8 * MiB;
constexpr size_t WS_TAB = WS_WGLU + 2 * MiB;
constexpr size_t ACT1 = (size_t)MPAD * 1024 * 2;
constexpr size_t WS_H = WS_TAB + 2 * MiB;
constexpr size_t WS_Q = WS_H + 2 * ACT1, WS_K = WS_Q + ACT1, WS_V = WS_K + ACT1, WS_ZA = WS_V + ACT1, WS_UB = WS_ZA + ACT1, WS_ZB = WS_UB + ACT1;
constexpr size_t WS_GA = WS_ZB + ACT1, WS_GB = WS_GA + 2 * ACT1, WS_END = WS_GB + 2 * ACT1;
constexpr size_t WS_G8A = WS_GA, WS_G8B = WS_GA + 16 * MiB;
constexpr size_t WS_GAS = WS_GA + 40 * MiB, WS_GBS = WS_GAS + 1 * MiB;
constexpr size_t WS_AAB = WS_H;
constexpr size_t WS_Y = WS_GA + 44 * MiB;
constexpr size_t WS_MRG = WS_K;
constexpr size_t WS_OUT = WS_GA;
constexpr size_t WS_PS = WS_END;
constexpr size_t PS_SLAB = (size_t)MS * INC;
constexpr size_t WS_XS = WS_PS + 4 * PS_SLAB * 4;
constexpr size_t WS_XS2 = WS_XS + (size_t)MP * 8 * 4;
constexpr size_t WS_END2 = WS_XS2 + (size_t)MS * 128 * 4;
static_assert(WS_END2 <= 300 * MiB, "ws map");
constexpr size_t TB_COS = 0, TB_SIN = TB_COS + 2049 * 64 * 4, TB_AR = TB_SIN + 2049 * 64 * 4, TB_AI = TB_AR + 64 * 64 * 4,
                 TB_BR = TB_AI + 64 * 64 * 4, TB_BI = TB_BR + 64 * 64 * 16 * 4, TB_END = TB_BI + 64 * 64 * 16 * 4;
static_assert(TB_END <= 2 * MiB && (TB_SIN % 16) == 0 && (TB_AR % 16) == 0, "tables");

constexpr int CW_TMO = 0;
constexpr int CW_SEAM = 16384;
constexpr int CW_BAR = 4096;

constexpr int RING_BYTES = 131072, LDSCTL_OFF = RING_BYTES, MISC_OFF = LDSCTL_OFF + 320, LDS_BYTES = 147456;

#define GAS __attribute__((address_space(1)))
#define LAS __attribute__((address_space(3)))
typedef unsigned short bf16;
typedef unsigned v4u __attribute__((ext_vector_type(4)));
typedef unsigned v2u __attribute__((ext_vector_type(2)));
typedef float f32x4 __attribute__((ext_vector_type(4)));
typedef GAS unsigned gu32;
#define RLX_AGENT __ATOMIC_RELAXED, __HIP_MEMORY_SCOPE_AGENT
#define LDS_WAIT() asm volatile("s_waitcnt lgkmcnt(0)" ::: "memory")
#define VM_WAIT() asm volatile("s_waitcnt vmcnt(0)" ::: "memory")
__device__ __forceinline__ unsigned f2bf(float f) { unsigned u = __builtin_bit_cast(unsigned, f); return (u + 0x7fffu + ((u >> 16) & 1u)) >> 16; }
__device__ __forceinline__ unsigned pk2(float lo, float hi) { return f2bf(lo) | (f2bf(hi) << 16); }
__device__ __forceinline__ float bf2f(bf16 v) { return __uint_as_float((unsigned)v << 16); }

#define XB_TMO      128
#define XB_XCNT(j)  (256  + 64 * (j))
#define XB_XSUB(j)  (1280 + 64 * (j))
#define XB_XGEN(j)  (2304 + 64 * (j))
#define XB_TOP      3328
#define XB_TOPGEN   3392
#define XCD_BAR_WORDS 3456
#define XB_SPIN_CAP (1u << 20)
__device__ __forceinline__ unsigned xb_ld(unsigned* p)              { return __hip_atomic_load(p, __ATOMIC_RELAXED, __HIP_MEMORY_SCOPE_AGENT); }
__device__ __forceinline__ unsigned xb_add(unsigned* p, unsigned v) { return __hip_atomic_fetch_add(p, v, __ATOMIC_RELAXED, __HIP_MEMORY_SCOPE_AGENT); }
__device__ __forceinline__ unsigned xb_xcc_id() { return (unsigned)__builtin_amdgcn_s_getreg((3 << 11) | 20) & 0xFu; }
#define XB_SPIN(cond, bar) do { unsigned _sp = 0; while (cond) { __builtin_amdgcn_s_sleep(1); \
    if ((++_sp & 255u) == 0u) { if (xb_ld(&(bar)[XB_TMO])) break; if (_sp > XB_SPIN_CAP) { atomicAdd(&(bar)[XB_TMO], 1u); break; } } } } while (0)
struct XcdBarrier { unsigned* bar; unsigned x; volatile LAS unsigned* st; };
__device__ __forceinline__ XcdBarrier xcd_barrier_post(unsigned* bar, volatile LAS unsigned* st) {
    XcdBarrier b; b.bar = bar; b.x = xb_xcc_id(); b.st = st;
    if (threadIdx.x == 0) (void)xb_add(&bar[XB_XCNT(b.x)], 1u);
    return b;
}
__device__ __forceinline__ void xcd_barrier_complete(unsigned* bar, unsigned x, unsigned& nloc, unsigned& nx) {
    const unsigned G = gridDim.x * gridDim.y * gridDim.z;
    unsigned sum, cnt, mine, sp = 0u;
    for (;;) {
        sum = 0u; cnt = 0u; mine = 0u;
#pragma unroll
        for (unsigned j = 0; j < 16; ++j) { const unsigned c = xb_ld(&bar[XB_XCNT(j)]); sum += c; cnt += (c > 0u) ? 1u : 0u; mine = (j == x) ? c : mine; }
        if (sum == G) break;
        __builtin_amdgcn_s_sleep(1);
        if ((++sp & 255u) == 0u) { if (xb_ld(&bar[XB_TMO])) break; if (sp > XB_SPIN_CAP) { atomicAdd(&bar[XB_TMO], 1u); break; } }
    }
    nloc = mine > 0u ? mine : 1u; nx = cnt > 0u ? cnt : 1u;
}
__device__ __forceinline__ void xcd_barrier(const XcdBarrier& b) {
    asm volatile("s_waitcnt vmcnt(0)" ::: "memory");
    __syncthreads();
    if (threadIdx.x == 0) {
        unsigned* bar = b.bar;
        __builtin_amdgcn_s_waitcnt(0);
        unsigned nloc = b.st[0], nx = b.st[1];
        if (nloc == 0u) { xcd_barrier_complete(bar, b.x, nloc, nx); b.st[0] = nloc; b.st[1] = nx; }
        const unsigned old = xb_add(&bar[XB_XSUB(b.x)], 1u);
        const unsigned gen = old / nloc;
        if (old + 1u == (gen + 1u) * nloc) {
            __builtin_amdgcn_fence(__ATOMIC_RELEASE, "agent");
            asm volatile("s_waitcnt vmcnt(0)" ::: "memory");
            const unsigned og = xb_add(&bar[XB_TOP], 1u);
            const unsigned tg = og / nx;
            if (og + 1u == (tg + 1u) * nx) xb_add(&bar[XB_TOPGEN], 1u);
            else XB_SPIN(xb_ld(&bar[XB_TOPGEN]) == tg, bar);
            __builtin_amdgcn_fence(__ATOMIC_ACQUIRE, "agent");
            xb_add(&bar[XB_XGEN(b.x)], 1u);
            asm volatile("s_waitcnt vmcnt(0)" ::: "memory");
        } else {
            XB_SPIN(xb_ld(&bar[XB_XGEN(b.x)]) == gen, bar);
            __builtin_amdgcn_fence(__ATOMIC_ACQUIRE, "agent");
            asm volatile("s_waitcnt vmcnt(0)" ::: "memory");
        }
    }
    __syncthreads();
}

struct Args { const float* in[21]; float* out; unsigned char* ws; int ph_lo, ph_hi, li, pad; };
struct Frame {
    LAS unsigned char* lds;
    volatile LAS unsigned* MISC;
    int tid, lane, wave, vcu, G;
    float* out; unsigned char* ws;
};
#define FIN(i) (args.in[i])
template <int CTRL, int RMASK> __device__ __forceinline__ float dpp_f(float v) { return __builtin_bit_cast(float, __builtin_amdgcn_update_dpp(0, __builtin_bit_cast(int, v), CTRL, RMASK, 0xF, false)); }
__device__ __forceinline__ float wave_sum(float v) {
    v += dpp_f<0xB1, 0xF>(v);
    v += dpp_f<0x4E, 0xF>(v);
    v += dpp_f<0x141, 0xF>(v);
    v += dpp_f<0x140, 0xF>(v);
    v += dpp_f<0x142, 0xA>(v);
    v += dpp_f<0x143, 0xC>(v);
    return __builtin_bit_cast(float, __builtin_amdgcn_readlane(__builtin_bit_cast(int, v), 63));
}
__device__ __forceinline__ float gelu_tanh(float x) {
    const float u = 0.7978845608028654f * (x + 0.044715f * x * x * x);
    const float e = __expf(2.0f * u);
    const float th = 1.0f - 2.0f * __builtin_amdgcn_rcpf(e + 1.0f);
    return 0.5f * x * (1.0f + th);
}
__device__ __forceinline__ float sigmoidf_(float x) { return __builtin_amdgcn_rcpf(1.0f + __expf(-x)); }

__device__ __forceinline__ int win_rowmap(int n) {
    if (n >= 2048) return n;
    const int head = n >> 7, d = n & 127, nn = d >> 6, dd = d & 63, wc = dd >> 4, fq = (dd >> 2) & 3, j = dd & 3;
    return head * 128 + 32 * wc + 8 * fq + 4 * nn + j;
}
__device__ __forceinline__ void p0_tr_load(float (&wv)[32], const float* W, int N, int item, int lane) {
    const int nblk = N / 32, kb = item / nblk, nb = item % nblk, k0 = 64 * kb, n0 = 32 * nb;
#pragma unroll
    for (int i = 0; i < 32; ++i) wv[i] = __builtin_nontemporal_load(W + (size_t)(k0 + 2 * i + (lane >> 5)) * N + n0 + (lane & 31));
}
template <bool MAPQ>
__device__ __forceinline__ void p0_tr_finish(const float (&wv)[32], int K, int N, bf16* WT, LAS float* scr, int item, int lane, int kofs = 0) {
    const int nblk = N / 32, kb = item / nblk, nb = item % nblk, k0 = 64 * kb, n0 = 32 * nb;
#pragma unroll
    for (int i = 0; i < 32; ++i) scr[(2 * i + (lane >> 5)) * 33 + (lane & 31)] = wv[i];
    LDS_WAIT(); asm volatile("" ::: "memory");
    const int c = lane & 7;
#pragma unroll
    for (int j = 0; j < 4; ++j) { const int n = (lane >> 3) + 8 * j; const LAS float* s = scr + (8 * c) * 33 + n;
        v4u o; o.x = pk2(s[0 * 33], s[1 * 33]); o.y = pk2(s[2 * 33], s[3 * 33]); o.z = pk2(s[4 * 33], s[5 * 33]); o.w = pk2(s[6 * 33], s[7 * 33]);
        const int drow = MAPQ ? win_rowmap(n0 + n) : (n0 + n);
        *(GAS v4u*)(WT + (size_t)drow * K + kofs + k0 + 8 * c) = o; }
    LDS_WAIT(); asm volatile("" ::: "memory");
}
template <bool MAPQ>
__device__ __forceinline__ void p0_transpose_item(const float* W, int K, int N, bf16* WT, LAS float* scr, int item, int lane, int kofs = 0) {
    float wv[32]; p0_tr_load(wv, W, N, item, lane); p0_tr_finish<MAPQ>(wv, K, N, WT, scr, item, lane, kofs);
}
__device__ __forceinline__ void rms_row_load(f32x4 (&v)[8], const float* xrow, int lane) {
    const GAS f32x4* xr = (const GAS f32x4*)xrow + lane;
#pragma unroll
    for (int j = 0; j < 8; ++j) v[j] = __builtin_nontemporal_load(xr + 64 * j);
}
__device__ __forceinline__ void rms_row_finish(const f32x4 (&v)[8], const float* g, bf16* orow, int lane) {
    const GAS f32x4* gr = (const GAS f32x4*)g + lane; float s = 0.f;
#pragma unroll
    for (int j = 0; j < 8; ++j) s += (v[j].x * v[j].x + v[j].y * v[j].y) + (v[j].z * v[j].z + v[j].w * v[j].w);
    const float rstd = 1.0f / sqrtf(wave_sum(s) * (1.f / DM) + EPSF);
    GAS unsigned long long* o8 = (GAS unsigned long long*)orow + lane;
#pragma unroll
    for (int j = 0; j < 8; ++j) { const f32x4 gg = gr[64 * j];
        o8[64 * j] = (unsigned long long)pk2(v[j].x * rstd * gg.x, v[j].y * rstd * gg.y) | ((unsigned long long)pk2(v[j].z * rstd * gg.z, v[j].w * rstd * gg.w) << 32); }
}
__device__ __forceinline__ void p0_prologue(Frame& F, const Args& args) {
    LAS float* scr = (LAS float*)(F.lds + F.wave * 16384);
    const int gw = F.vcu * NWAVES + F.wave, NGW = F.G * NWAVES;
    constexpr int I_IN = (DM / 64) * (INC / 32), I_PA = (RW / 64) * (DM / 32), I_PB = I_PA, I_OUT = (DM / 64) * (DM / 32), I_GLU = (SW / 64) * (SW / 32);
    constexpr int NITEMS = I_IN + I_PA + I_PB + I_OUT + I_GLU;
    bf16* WinT = (bf16*)(F.ws + WS_WIN); bf16* WgluT = (bf16*)(F.ws + WS_WGLU);
    (void)NITEMS;
    { float wa[32], wb[32]; int it = gw;
      if (it < I_IN) p0_tr_load(wa, args.in[6], INC, it, F.lane);
      for (; it < I_IN; it += NGW) {
          const bool hasn = it + NGW < I_IN;
          if (hasn) p0_tr_load(wb, args.in[6], INC, it + NGW, F.lane);
          p0_tr_finish<true>(wa, DM, INC, WinT, scr, it, F.lane);
          if (hasn) {
#pragma unroll
              for (int i = 0; i < 32; ++i) wa[i] = wb[i]; }
      } }
    for (int it = gw; it < I_GLU; it += NGW) p0_transpose_item<false>(args.in[19], SW, SW, WgluT, scr, it, F.lane);
    bf16* H = (bf16*)(F.ws + WS_H);
    { f32x4 ra[8], rb[8]; int m = gw;
#define XROW(mm) ((mm) < MP ? args.in[0] + (size_t)(mm) * DM : args.in[1] + (size_t)((mm) - MP) * DM)
      if (m < MV) rms_row_load(ra, XROW(m), F.lane);
      for (; m < MV; m += NGW) {
          const bool hasn = m + NGW < MV;
          if (hasn) rms_row_load(rb, XROW(m + NGW), F.lane);
          rms_row_finish(ra, args.in[5], H + (size_t)m * DM, F.lane);
          if (hasn) {
#pragma unroll
              for (int j = 0; j < 8; ++j) ra[j] = rb[j]; }
      }
#undef XROW
    }
    for (int m = MV + gw; m < MPAD; m += NGW) { GAS unsigned long long* o8 = (GAS unsigned long long*)(H + (size_t)m * DM) + F.lane;
#pragma unroll
        for (int j = 0; j < 8; ++j) o8[64 * j] = 0ull; }
    const int gt = F.vcu * NTHR + F.tid, NGT = F.G * NTHR;
    float* tcos = (float*)(F.ws + WS_TAB + TB_COS); float* tsin = (float*)(F.ws + WS_TAB + TB_SIN);
    for (int i = gt; i < 2049 * 64; i += NGT) {
        const int pi = i >> 6, d = i & 63; const double pos = (pi == 2048) ? (double)POS_S : (double)pi;
        const double inv = exp((double)d * (-9.210340371976184 / 64.0)), ang = pos * inv;
        const double red = ang - 6.283185307179586476925 * rint(ang * 0.15915494309189533577);
        float sn, cs; sincosf((float)red, &sn, &cs);
        tcos[i] = cs; tsin[i] = sn;
    }
    float* tar = (float*)(F.ws + WS_TAB + TB_AR); float* tai = (float*)(F.ws + WS_TAB + TB_AI);
    float* tbr = (float*)(F.ws + WS_TAB + TB_BR); float* tbi = (float*)(F.ws + WS_TAB + TB_BI);
    for (int i = (F.tid < 16 ? F.vcu * 16 + F.tid : SG * SP); i < SG * SP; i += F.G * 16) {
        const int g = i >> 6;
        const double lr = (double)args.in[11][i], li = (double)args.in[12][i], dt = exp((double)args.in[13][g]);
        const double ang = li * dt, red = ang - 6.283185307179586476925 * rint(ang * 0.15915494309189533577);
        float sn, cs; sincosf((float)red, &sn, &cs);
        const double mag = exp(lr * dt), ar = mag * (double)cs, ai = mag * (double)sn;
        const double nr = ar - 1.0, ni = ai, den = lr * lr + li * li;
        const double cr = (nr * lr + ni * li) / den, ci = (ni * lr - nr * li) / den;
        tar[i] = (float)ar; tai[i] = (float)ai;
        for (int n = 0; n < SN; ++n) { const double br = (double)args.in[14][i * SN + n], bi = (double)args.in[15][i * SN + n];
            tbr[i * SN + n] = (float)(cr * br - ci * bi); tbi[i * SN + n] = (float)(cr * bi + ci * br); }
    }
}

__device__ __forceinline__ void p1_convert_rest(Frame& F, const Args& args, int idx, int nidle) {
    LAS float* scr = (LAS float*)(F.lds + F.wave * 16384);
    constexpr int I_PA = (RW / 64) * (DM / 32), I_PB = I_PA, I_OUT = (DM / 64) * (DM / 32);
    bf16* WpT = (bf16*)(F.ws + WS_WPA); bf16* WoutT = (bf16*)(F.ws + WS_WOUT);
    for (int it = idx * NWAVES + F.wave; it < I_PA + I_PB + I_OUT; it += nidle * NWAVES) {
        int r = it;
        if (r < I_PA) { p0_transpose_item<false>(args.in[7], 2 * RW, DM, WpT, scr, r, F.lane, 0); continue; } r -= I_PA;
        if (r < I_PB) { p0_transpose_item<false>(args.in[8], 2 * RW, DM, WpT, scr, r, F.lane, RW); continue; } r -= I_PB;
        p0_transpose_item<false>(args.in[9], DM, DM, WoutT, scr, r, F.lane);
    }
}
using pg8::Unit; using pg8::cvt_pk_bf16; using pg8::bf_lo; using pg8::bf_hi;
struct EpiProj {
    static constexpr bool MIDHOOK = false, AFTER_DRAIN = false, PERM = true;
    bf16 *Q, *K, *V, *ZA, *UB, *ZB, *GA, *GB; const float* tcos; const float* tsin; float* PS;
    __device__ __forceinline__ void operator()(const f32x4 (&acc)[2][2][4][2], const Unit& u, int wr, int wc, int fr, int fq) const {
        asm volatile("" : "+v"(fr), "+v"(fq));
        const int row0 = u.pm * 256 + wr * 64 + fr;
        const int seg = u.pn >> 2;
        if (u.z) {
            float* slab = PS + (size_t)(u.z - 1) * PS_SLAB + (size_t)(wr * 64 + fr) * INC + u.pn * 256 + wc * 32 + 8 * fq;
#pragma unroll
            for (int m = 0; m < 4; ++m)
#pragma unroll
                for (int bj = 0; bj < 2; ++bj) { *(f32x4*)(slab + (size_t)m * 16 * INC + bj * 128) = acc[0][bj][m][0]; *(f32x4*)(slab + (size_t)m * 16 * INC + bj * 128 + 4) = acc[0][bj][m][1]; }
            return;
        }
        if (seg < 2) {
            bf16* base = seg == 0 ? Q : K;
            const int head0 = (u.pn & 3) * 2, d0 = 16 * wc + 4 * fq;
            float lgh[2];
#pragma unroll
            for (int bj = 0; bj < 2; ++bj) lgh[bj] = seg == 0 ? 0.f : log2f(1.0f - exp2f(-5.0f - (float)(head0 + bj)));
            f32x4 csq[2][4], snq[2][4];
#pragma unroll
            for (int ai = 0; ai < 2; ++ai)
#pragma unroll
                for (int m = 0; m < 4; ++m) { const int row = row0 + ai * 128 + m * 16; const int pi = row < MP ? (row & (SEQ - 1)) : 2048;
                    csq[ai][m] = *(const f32x4*)(tcos + pi * 64 + d0); snq[ai][m] = *(const f32x4*)(tsin + pi * 64 + d0); }
#pragma unroll
            for (int ai = 0; ai < 2; ++ai)
#pragma unroll
                for (int m = 0; m < 4; ++m) {
                    const int row = row0 + ai * 128 + m * 16;
                    const float sl1 = row < MP ? (float)((row & 127) + 1) : 1.0f;
                    const f32x4 cs = csq[ai][m], sn = snq[ai][m];
#pragma unroll
                    for (int bj = 0; bj < 2; ++bj) {
                        const float sc = seg == 0 ? 1.0f : 0.08838834764831845f * exp2f(-sl1 * lgh[bj]);
                        const f32x4 x1 = acc[ai][bj][m][0], x2 = acc[ai][bj][m][1];
                        const f32x4 o1 = (x1 * cs - x2 * sn) * sc, o2 = (x1 * sn + x2 * cs) * sc;
                        bf16* p = base + (size_t)row * RW + (head0 + bj) * 128 + d0;
                        v2u w1, w2; w1.x = cvt_pk_bf16(o1[0], o1[1]); w1.y = cvt_pk_bf16(o1[2], o1[3]); w2.x = cvt_pk_bf16(o2[0], o2[1]); w2.y = cvt_pk_bf16(o2[2], o2[3]);
                        *(v2u*)p = w1; *(v2u*)(p + 64) = w2;
                    }
                }
        } else {
            const int sb = seg < 6 ? seg : (seg & ~1);
            bf16* base = (bf16*)((unsigned char*)Q + (size_t)sb * ACT1);
            const int ldc = seg < 6 ? 1024 : 2048, colt = (u.pn - 4 * sb) * 256;
            const int act = seg >= 6 ? 2 : ((seg == 3 || seg == 5) ? 1 : 0);
            const int col0 = colt + wc * 32 + 8 * fq;
            if (seg >= 6) {
                unsigned char* gt = (unsigned char*)Q + (WS_G8A - WS_Q) + (seg >= 8 ? (WS_G8B - WS_G8A) : 0) + (size_t)(u.pm * 8 + ((u.pn - 24) & 7)) * 65536 + (size_t)(((wr * 4 + wc) * 64) + fq * 16 + fr) * 8;
#pragma unroll
                for (int ai = 0; ai < 2; ++ai)
#pragma unroll
                    for (int m = 0; m < 4; ++m)
#pragma unroll
                        for (int bj = 0; bj < 2; ++bj) { const f32x4 v0 = acc[ai][bj][m][0], v1 = acc[ai][bj][m][1]; unsigned q[8];
#pragma unroll
                            for (int e = 0; e < 4; ++e) { q[e] = (unsigned)(sigmoidf_(v0[e]) * 255.0f + 0.5f); q[4 + e] = (unsigned)(sigmoidf_(v1[e]) * 255.0f + 0.5f); }
                            v2u w; w.x = q[0] | (q[1] << 8) | (q[2] << 16) | (q[3] << 24); w.y = q[4] | (q[5] << 8) | (q[6] << 16) | (q[7] << 24);
                            *(v2u*)(gt + (size_t)((ai * 4 + m) * 2 + bj) * 4096) = w; }
                return;
            }
#pragma unroll
            for (int ai = 0; ai < 2; ++ai)
#pragma unroll
                for (int m = 0; m < 4; ++m) { bf16* rowp = base + (size_t)(row0 + ai * 128 + m * 16) * ldc + col0;
#pragma unroll
                    for (int bj = 0; bj < 2; ++bj) { f32x4 v0 = acc[ai][bj][m][0], v1 = acc[ai][bj][m][1];
                        if (act != 0) {
#pragma unroll
                            for (int e = 0; e < 4; ++e) { const float s0 = sigmoidf_(v0[e]), s1 = sigmoidf_(v1[e]); v0[e] = act == 1 ? v0[e] * s0 : s0; v1[e] = act == 1 ? v1[e] * s1 : s1; }
                        }
                        v4u w; w.x = cvt_pk_bf16(v0[0], v0[1]); w.y = cvt_pk_bf16(v0[2], v0[3]); w.z = cvt_pk_bf16(v1[0], v1[1]); w.w = cvt_pk_bf16(v1[2], v1[3]);
                        if (seg == 4) {
                            const int col = col0 + bj * 128, g = col >> 4, half = (col >> 3) & 1;
                            *(v4u*)(base + ((size_t)g * MPAD + (row0 + ai * 128 + m * 16)) * 16 + 8 * half) = w;
                        } else *(v4u*)(rowp + bj * 128) = w; } }
        }
    }
};
struct EpiGlu {
    static constexpr bool MIDHOOK = false, AFTER_DRAIN = false, PERM = true;
    const bf16* Y; const bf16* ZB; bf16* AB; const float* bias;
    __device__ __forceinline__ void operator()(const f32x4 (&acc)[2][2][4][2], const Unit& u, int wr, int wc, int fr, int fq) const {
        const int row0 = u.pm * 256 + wr * 64 + fr, col0 = u.pn * 256 + wc * 32 + 8 * fq;
        f32x4 bq[2][2];
#pragma unroll
        for (int bj = 0; bj < 2; ++bj) { bq[bj][0] = *(const f32x4*)(bias + col0 + bj * 128); bq[bj][1] = *(const f32x4*)(bias + col0 + bj * 128 + 4); }
#pragma unroll
        for (int ai = 0; ai < 2; ++ai) {
            v4u yq[4][2], zq[4][2];
#pragma unroll
            for (int m = 0; m < 4; ++m)
#pragma unroll
                for (int bj = 0; bj < 2; ++bj) { const size_t off = (size_t)(row0 + ai * 128 + m * 16) * SW + col0 + bj * 128; yq[m][bj] = *(const v4u*)(Y + off); zq[m][bj] = *(const v4u*)(ZB + off); }
#pragma unroll
            for (int m = 0; m < 4; ++m)
#pragma unroll
                for (int bj = 0; bj < 2; ++bj) { const size_t off = (size_t)(row0 + ai * 128 + m * 16) * SW + col0 + bj * 128;
                    const v4u yv = yq[m][bj], zv = zq[m][bj];
                    const f32x4 g0 = acc[ai][bj][m][0] + bq[bj][0], g1 = acc[ai][bj][m][1] + bq[bj][1];
                    float o[8];
                    o[0] = bf_lo(yv.x) * sigmoidf_(g0[0]) * bf_lo(zv.x); o[1] = bf_hi(yv.x) * sigmoidf_(g0[1]) * bf_hi(zv.x);
                    o[2] = bf_lo(yv.y) * sigmoidf_(g0[2]) * bf_lo(zv.y); o[3] = bf_hi(yv.y) * sigmoidf_(g0[3]) * bf_hi(zv.y);
                    o[4] = bf_lo(yv.z) * sigmoidf_(g1[0]) * bf_lo(zv.z); o[5] = bf_hi(yv.z) * sigmoidf_(g1[1]) * bf_hi(zv.z);
                    o[6] = bf_lo(yv.w) * sigmoidf_(g1[2]) * bf_lo(zv.w); o[7] = bf_hi(yv.w) * sigmoidf_(g1[3]) * bf_hi(zv.w);
                    v4u w; w.x = cvt_pk_bf16(o[0], o[1]); w.y = cvt_pk_bf16(o[2], o[3]); w.z = cvt_pk_bf16(o[4], o[5]); w.w = cvt_pk_bf16(o[6], o[7]);
                    *(v4u*)(AB + (size_t)(row0 + ai * 128 + m * 16) * (2 * SW) + SW + col0 + bj * 128) = w; }
        }
    }
};
struct EpiMerge {
    static constexpr bool MIDHOOK = true, AFTER_DRAIN = false, PERM = true;
    const unsigned char* G8A; const unsigned char* G8B; bf16* MRG;
    __device__ __forceinline__ void mid(f32x4 (&acc)[2][2][4][2], const Unit& u, int wr, int wc, int fr, int fq) const {
        asm volatile("" : "+v"(fr), "+v"(fq));
        const size_t toff = (size_t)(u.pm * 8 + u.pn) * 65536 + (size_t)(((wr * 4 + wc) * 64) + fq * 16 + fr) * 8;
#pragma unroll
        for (int ai = 0; ai < 2; ++ai) {
            v2u ga[4][2], gb[4][2];
#pragma unroll
            for (int m = 0; m < 4; ++m)
#pragma unroll
                for (int bj = 0; bj < 2; ++bj) { ga[m][bj] = *(const v2u*)(G8A + toff + (size_t)((ai * 4 + m) * 2 + bj) * 4096); gb[m][bj] = *(const v2u*)(G8B + toff + (size_t)((ai * 4 + m) * 2 + bj) * 4096); }
#pragma unroll
            for (int m = 0; m < 4; ++m)
#pragma unroll
                for (int bj = 0; bj < 2; ++bj)
#pragma unroll
                    for (int e = 0; e < 4; ++e) {
                        const unsigned a0 = (ga[m][bj].x >> (8 * e)) & 255u, a1 = (ga[m][bj].y >> (8 * e)) & 255u, b0 = (gb[m][bj].x >> (8 * e)) & 255u, b1 = (gb[m][bj].y >> (8 * e)) & 255u;
                        acc[ai][bj][m][0][e] *= (float)a0 * __builtin_amdgcn_rcpf((float)(b0 ? b0 : 1u));
                        acc[ai][bj][m][1][e] *= (float)a1 * __builtin_amdgcn_rcpf((float)(b1 ? b1 : 1u)); }
        }
    }
    __device__ __forceinline__ void operator()(const f32x4 (&acc)[2][2][4][2], const Unit& u, int wr, int wc, int fr, int fq) const {
        asm volatile("" : "+v"(fr), "+v"(fq));
        const int row0 = u.pm * 256 + wr * 64 + fr, col0 = u.pn * 256 + wc * 32 + 8 * fq;
        const size_t toff = (size_t)(u.pm * 8 + u.pn) * 65536 + (size_t)(((wr * 4 + wc) * 64) + fq * 16 + fr) * 8;
        v2u gb[2][4][2];
#pragma unroll
        for (int ai = 0; ai < 2; ++ai)
#pragma unroll
            for (int m = 0; m < 4; ++m)
#pragma unroll
                for (int bj = 0; bj < 2; ++bj) gb[ai][m][bj] = *(const v2u*)(G8B + toff + (size_t)((ai * 4 + m) * 2 + bj) * 4096);
        const float k255 = 1.0f / 255.0f;
#pragma unroll
        for (int ai = 0; ai < 2; ++ai)
#pragma unroll
            for (int m = 0; m < 4; ++m)
#pragma unroll
                for (int bj = 0; bj < 2; ++bj) { float o[8];
#pragma unroll
                    for (int e = 0; e < 4; ++e) { const unsigned b0 = (gb[ai][m][bj].x >> (8 * e)) & 255u, b1 = (gb[ai][m][bj].y >> (8 * e)) & 255u;
                        o[e] = acc[ai][bj][m][0][e] * ((float)(b0 ? b0 : 1u) * k255); o[4 + e] = acc[ai][bj][m][1][e] * ((float)(b1 ? b1 : 1u) * k255); }
                    v4u w; w.x = cvt_pk_bf16(o[0], o[1]); w.y = cvt_pk_bf16(o[2], o[3]); w.z = cvt_pk_bf16(o[4], o[5]); w.w = cvt_pk_bf16(o[6], o[7]);
                    *(v4u*)(MRG + (size_t)(row0 + ai * 128 + m * 16) * DM + col0 + bj * 128) = w; }
    }
};
struct EpiOutBf16 {
    static constexpr bool MIDHOOK = false, AFTER_DRAIN = false, PERM = true;
    bf16* C; int ldc;
    __device__ __forceinline__ void operator()(const f32x4 (&acc)[2][2][4][2], const Unit& u, int wr, int wc, int fr, int fq) const {
        const int row0 = u.pm * 256 + wr * 64 + fr, col0 = u.pn * 256 + wc * 32 + 8 * fq;
#pragma unroll
        for (int ai = 0; ai < 2; ++ai)
#pragma unroll
            for (int m = 0; m < 4; ++m) { bf16* rowp = C + (size_t)(row0 + ai * 128 + m * 16) * ldc + col0;
#pragma unroll
                for (int bj = 0; bj < 2; ++bj) { const f32x4 v0 = acc[ai][bj][m][0], v1 = acc[ai][bj][m][1];
                    v4u w; w.x = cvt_pk_bf16(v0[0], v0[1]); w.y = cvt_pk_bf16(v0[2], v0[3]); w.z = cvt_pk_bf16(v1[0], v1[1]); w.w = cvt_pk_bf16(v1[2], v1[3]);
                    *(v4u*)(rowp + bj * 128) = w; } }
    }
};

typedef float f32x16 __attribute__((ext_vector_type(16)));
typedef float f32x2v __attribute__((ext_vector_type(2)));
typedef short bf16x8 __attribute__((ext_vector_type(8)));
typedef short s16x4 __attribute__((ext_vector_type(4)));
typedef __bf16 bf16x2_t __attribute__((ext_vector_type(2)));
#define MFMA32(a, b, c) __builtin_amdgcn_mfma_f32_32x32x16_bf16((a), (b), (c), 0, 0, 0)
#define MFMA16(a, b, c) __builtin_amdgcn_mfma_f32_16x16x32_bf16((a), (b), (c), 0, 0, 0)
__device__ __forceinline__ unsigned cvtpk(float lo, float hi) { f32x2v v = {lo, hi}; bf16x2_t b = __builtin_convertvector(v, bf16x2_t); return __builtin_bit_cast(unsigned, b); }
__device__ __forceinline__ v2u pk4(const f32x4 v) { v2u w; w.x = cvtpk(v[0], v[1]); w.y = cvtpk(v[2], v[3]); return w; }
__device__ __forceinline__ s16x4 lds_tr(LAS unsigned char* p) { return __builtin_bit_cast(s16x4, __builtin_amdgcn_ds_read_tr16_b64_v4i16((LAS s16x4*)p)); }
__device__ __forceinline__ bf16x8 cat8(s16x4 lo, s16x4 hi) { return (bf16x8){lo[0], lo[1], lo[2], lo[3], hi[0], hi[1], hi[2], hi[3]}; }
__device__ __forceinline__ bf16x8 pack8(const f32x16& x, int s) {
    v4u p; p.x = cvtpk(x[8 * s], x[8 * s + 1]); p.y = cvtpk(x[8 * s + 2], x[8 * s + 3]); p.z = cvtpk(x[8 * s + 4], x[8 * s + 5]); p.w = cvtpk(x[8 * s + 6], x[8 * s + 7]);
    return __builtin_bit_cast(bf16x8, p);
}
__device__ __forceinline__ void glds16(const void* g, LAS unsigned char* l) { __builtin_amdgcn_global_load_lds((const unsigned*)g, (LAS unsigned*)l, 16, 0, 0); }
__device__ __forceinline__ void glds16_asm(const void* gsrc, unsigned lds_dst) { unsigned keep;
    asm volatile("s_mov_b32 %0, m0\n\ts_mov_b32 m0, %2\n\ts_nop 0\n\tglobal_load_lds_dwordx4 %1, off\n\ts_mov_b32 m0, %0" : "=&s"(keep) : "v"(gsrc), "s"(lds_dst) : "memory"); }
__device__ __forceinline__ unsigned swz16(unsigned row) { return ((row & 3u) << 2) | ((row >> 2) & 3u); }
__device__ __forceinline__ unsigned off_b(unsigned row, unsigned ch) { return 256u * row + 16u * (ch ^ swz16(row)); }

__device__ __forceinline__ int launder(int x) { asm volatile("" : "+v"(x)); return x; }
constexpr int RT_STAT = RING_BYTES + 1024;
__device__ __forceinline__ void ret_stage(LAS unsigned char* buf, const bf16* KSg, const bf16* Vg, size_t tok0, int hcol, int wave, int lane) {
#pragma unroll
    for (int i = 0; i < 2; ++i) {
        const unsigned slot = (unsigned)(wave * 64 + lane + 512 * i), row = slot >> 4, cp = slot & 15u, ch = cp ^ swz16(row);
        const size_t go = (tok0 + row) * RW + hcol + ch * 8;
        const unsigned dst = (unsigned)(size_t)buf + (unsigned)((wave * 64 + 512 * i) * 16);
        glds16_asm(KSg + go, (unsigned)__builtin_amdgcn_readfirstlane((int)dst));
        glds16_asm(Vg + go, (unsigned)__builtin_amdgcn_readfirstlane((int)(dst + 16384u)));
    }
}
template <bool KROW> __device__ __forceinline__ unsigned tr_base(int lane, unsigned c, unsigned t) {
    const unsigned h = lane >> 5, blk = (lane >> 4) & 1, q = (lane & 15) >> 2, p = lane & 3;
    const unsigned rowl = KROW ? (8 * t + 4 * h + q) : (8 * h + 4 * t + q), sw = (q << 2) | (KROW ? (2 * t + h) : (2 * h + t));
    return 256u * rowl + 16u * ((4 * c + 2 * blk + (p >> 1)) ^ sw) + 8u * (p & 1);
}
__device__ __forceinline__ void ret_state_update(f32x16 (&accS)[2], LAS unsigned char* buf, const unsigned (&ba)[2], const unsigned (&bb)[2][2]) {
#pragma unroll
    for (int ks = 0; ks < 4; ++ks) {
        const bf16x8 A = cat8(lds_tr(buf + ba[0] + 4096 * ks), lds_tr(buf + ba[1] + 4096 * ks));
#pragma unroll
        for (int e2 = 0; e2 < 2; ++e2) {
            const bf16x8 B = cat8(lds_tr(buf + 16384 + bb[e2][0] + 4096 * ks), lds_tr(buf + 16384 + bb[e2][1] + 4096 * ks));
            accS[e2] = MFMA32(A, B, accS[e2]); }
    }
}
__device__ __forceinline__ void ret_unit(Frame& F, int b, int hd, int j, bool primed, int nj) {
    LAS unsigned char* lds = F.lds;
    const bf16* Qg = (const bf16*)(F.ws + WS_Q); const bf16* KSg = (const bf16*)(F.ws + WS_K); const bf16* Vg = (const bf16*)(F.ws + WS_V);
    const int w = F.wave; int lane = launder(F.lane); int h = lane >> 5, r = lane & 31;
    const int hi2 = w >> 1, eh = w & 1;
    const float lg2 = log2f(1.0f - exp2f(-5.0f - (float)hd)), g128 = exp2f(128.0f * lg2);
    const size_t tokb = (size_t)b * SEQ; const int hcol = hd * DK;
    f32x16 accS[2], accO[2];
#pragma unroll
    for (int i = 0; i < 16; ++i) { accS[0][i] = 0.f; accS[1][i] = 0.f; accO[0][i] = 0.f; accO[1][i] = 0.f; }
    bf16x8 qf[8]; v2u zq[2][4];
    { const bf16* qrow = Qg + (tokb + 128 * (size_t)j + 32 * hi2 + r) * RW + hcol + 4 * h;
#pragma unroll
      for (int ks = 0; ks < 8; ++ks) { const v2u lo = *(const v2u*)(qrow + 16 * ks), hi = *(const v2u*)(qrow + 16 * ks + 8); v4u t; t.x = lo.x; t.y = lo.y; t.z = hi.x; t.w = hi.y; qf[ks] = __builtin_bit_cast(bf16x8, t); }
      const bf16* zrow = (const bf16*)(F.ws + WS_ZA) + (tokb + 128 * (size_t)j + 32 * hi2 + r) * RW + hcol + 4 * h;
#pragma unroll
      for (int e2 = 0; e2 < 2; ++e2)
#pragma unroll
        for (int g4 = 0; g4 < 4; ++g4) zq[e2][g4] = *(const v2u*)(zrow + 32 * (2 * eh + e2) + 8 * g4); }
    unsigned ba[2], bb[2][2];
#pragma unroll
    for (int t = 0; t < 2; ++t) { ba[t] = tr_base<false>(lane, hi2, t); bb[0][t] = tr_base<false>(lane, 2 * eh, t); bb[1][t] = tr_base<false>(lane, 2 * eh + 1, t); }
    const int nprev = 2 * j, NS = nprev + 2;
#define RT_SLOT(n) (lds + (((n) & 3) << 15))
    if (!primed) {
        ret_stage(RT_SLOT(0), KSg, Vg, tokb, hcol, w, lane);
        ret_stage(RT_SLOT(1), KSg, Vg, tokb + 64, hcol, w, lane);
        if (NS > 2) ret_stage(RT_SLOT(2), KSg, Vg, tokb + 128, hcol, w, lane);
    }
    if (NS > 2) asm volatile("s_waitcnt vmcnt(8)" ::: "memory"); else asm volatile("s_waitcnt vmcnt(0)" ::: "memory");
    __builtin_amdgcn_s_barrier(); asm volatile("" ::: "memory");
    for (int n = 0; n < nprev; ++n) {
        const bool more = n + 3 < NS;
        if (more) ret_stage(RT_SLOT(n + 3), KSg, Vg, tokb + 64 * (size_t)(n + 3), hcol, w, lane);
        ret_state_update(accS, RT_SLOT(n), ba, bb);
        if (n & 1) { accS[0] = accS[0] * g128; accS[1] = accS[1] * g128; }
        if (more) asm volatile("s_waitcnt vmcnt(8) lgkmcnt(0)" ::: "memory"); else asm volatile("s_waitcnt vmcnt(0) lgkmcnt(0)" ::: "memory");
        __builtin_amdgcn_s_barrier(); asm volatile("" ::: "memory");
    }
    LAS unsigned char* sx = RT_SLOT(nprev + 2);
    lane = launder(F.lane); h = lane >> 5; r = lane & 31;
#pragma unroll
    for (int e2 = 0; e2 < 2; ++e2)
#pragma unroll
        for (int s = 0; s < 2; ++s) *(LAS bf16x8*)(sx + ((hi2 * 4 + 2 * eh + e2) * 2 + s) * 1024 + lane * 16) = pack8(accS[e2], s);
    LDS_WAIT(); __syncthreads();
    const int tt = hi2;
    unsigned rrow, rx, rc[2];
    { const unsigned sw = swz16((unsigned)r); rrow = 256u * r + 8u * h; rx = 32u * (sw >> 1); rc[0] = 16u * (sw & 1); rc[1] = 16u * ((sw & 1) ^ 1); }
    unsigned bv[2][2];
#pragma unroll
    for (int t = 0; t < 2; ++t) { bv[0][t] = tr_base<true>(lane, 2 * eh, t); bv[1][t] = tr_base<true>(lane, 2 * eh + 1, t); }
#pragma unroll
    for (int sg = 0; sg < 2; ++sg) {
        const int n = nprev + sg;
        LAS unsigned char* buf = RT_SLOT(n);
#pragma unroll
        for (int st2 = 0; st2 < 2; ++st2) {
            const int st = 2 * sg + st2;
            if (st <= tt) {
                const unsigned rb = 32 * st2;
                f32x16 X;
#pragma unroll
                for (int i = 0; i < 16; ++i) X[i] = 0.f;
#pragma unroll
                for (int ks = 0; ks < 8; ++ks) {
                    const unsigned ax = rrow + ((32u * ks) ^ rx) + 256u * rb;
                    const v2u lo = *(const LAS v2u*)(buf + ax + rc[0]), hi = *(const LAS v2u*)(buf + ax + rc[1]);
                    v4u t; t.x = lo.x; t.y = lo.y; t.z = hi.x; t.w = hi.y;
                    X = MFMA32(__builtin_bit_cast(bf16x8, t), qf[ks], X);
                }
                if (st == tt) {
#pragma unroll
                    for (int i = 0; i < 16; ++i) { const int srow = (i & 3) + 8 * (i >> 2) + 4 * h; X[i] = srow > r ? 0.f : X[i]; }
                }
#pragma unroll
                for (int s = 0; s < 2; ++s) {
                    const bf16x8 xb = pack8(X, s);
#pragma unroll
                    for (int e2 = 0; e2 < 2; ++e2) {
                        const bf16x8 A = cat8(lds_tr(buf + 16384 + bv[e2][0] + 256 * (rb + 16 * s)), lds_tr(buf + 16384 + bv[e2][1] + 256 * (rb + 16 * s)));
                        accO[e2] = MFMA32(A, xb, accO[e2]); }
                }
            }
        }
        if (sg == 0) {
#pragma unroll
            for (int e2 = 0; e2 < 2; ++e2)
#pragma unroll
                for (int dt = 0; dt < 4; ++dt)
#pragma unroll
                    for (int s = 0; s < 2; ++s) {
                        const bf16x8 A = *(const LAS bf16x8*)(sx + ((dt * 4 + 2 * eh + e2) * 2 + s) * 1024 + lane * 16);
                        accO[e2] = MFMA32(A, qf[2 * dt + s], accO[e2]); }
        }
        if (j == 15) ret_state_update(accS, buf, ba, bb);
    }
#undef RT_SLOT
    if (j == 15) {
        float* So = F.out + O_RP + (size_t)(b * NH + hd) * DK * DK;
#pragma unroll
        for (int e2 = 0; e2 < 2; ++e2)
#pragma unroll
            for (int i = 0; i < 16; ++i) So[(size_t)(32 * hi2 + (i & 3) + 8 * (i >> 2) + 4 * h) * DK + 32 * (2 * eh + e2) + r] = accS[e2][i] * g128;
    }
    lane = launder(F.lane); h = lane >> 5; r = lane & 31;
    if (nj >= 0) {
        __syncthreads();
        ret_stage(lds, KSg, Vg, tokb, hcol, w, lane);
        ret_stage(lds + 32768, KSg, Vg, tokb + 64, hcol, w, lane);
        if (2 * nj + 2 > 2) ret_stage(lds + 65536, KSg, Vg, tokb + 128, hcol, w, lane);
    }
    bf16* AA = (bf16*)(F.ws + WS_AAB);
    const float sc = exp2f((float)(32 * tt + r + 1) * lg2);
    float s1 = 0.f, s2 = 0.f;
#pragma unroll
    for (int e2 = 0; e2 < 2; ++e2)
#pragma unroll
        for (int i = 0; i < 16; ++i) { const float o = accO[e2][i] * sc; accO[e2][i] = o; s1 += o; s2 += o * o; }
    s1 += __shfl_xor(s1, 32); s2 += __shfl_xor(s2, 32);
    LAS f32x2v* stat = (LAS f32x2v*)(lds + RT_STAT);
    if (h == 0) stat[(32 * tt + r) * 2 + eh] = (f32x2v){s1, s2};
    LDS_WAIT(); __syncthreads();
    { const f32x2v a = stat[(32 * tt + r) * 2], c = stat[(32 * tt + r) * 2 + 1];
      const float mean = (a.x + c.x) * (1.0f / 128.0f), var = fmaxf((a.y + c.y) * (1.0f / 128.0f) - mean * mean, 0.f), rstd = 1.0f / sqrtf(var + EPSF);
      const size_t ro = (tokb + 128 * (size_t)j + 32 * tt + r) * (2 * RW) + hcol;
#pragma unroll
      for (int e2 = 0; e2 < 2; ++e2)
#pragma unroll
        for (int g4 = 0; g4 < 4; ++g4) { const int e0 = 32 * (2 * eh + e2) + 8 * g4 + 4 * h;
            const v2u zv = zq[e2][g4];
            const float o0 = (accO[e2][4 * g4] - mean) * rstd * bf_lo(zv.x), o1 = (accO[e2][4 * g4 + 1] - mean) * rstd * bf_hi(zv.x);
            const float o2 = (accO[e2][4 * g4 + 2] - mean) * rstd * bf_lo(zv.y), o3 = (accO[e2][4 * g4 + 3] - mean) * rstd * bf_hi(zv.y);
            v2u wv; wv.x = cvtpk(o0, o1); wv.y = cvtpk(o2, o3); *(v2u*)(AA + ro + e0) = wv; } }
    __syncthreads();
}
__device__ __forceinline__ float ps_sum(const float* PS, int b, int n) {
    const float* p = PS + (size_t)b * INC + n; return (p[0] + p[PS_SLAB]) + (p[2 * PS_SLAB] + p[3 * PS_SLAB]);
}
__device__ __forceinline__ void ret_sample_load(f32x4 (&S)[8], float (&px)[2], const float* S0, const float* PS, int v, int tid) {
    const int cg = tid & 31, rg = tid >> 5, b = v / NH, h = v % NH, d = tid & 127, part = tid >> 7;
#pragma unroll
    for (int i = 0; i < 8; ++i) S[i] = __builtin_nontemporal_load((const f32x4*)(S0 + (size_t)(rg + 16 * i) * DK + 4 * cg));
    if (part < 2) { const int dl = d & 63, c1 = 32 * (dl >> 4) + 8 * ((dl >> 2) & 3) + (dl & 3), nb = part * 1024 + h * 128; px[0] = ps_sum(PS, b, nb + c1); px[1] = ps_sum(PS, b, nb + c1 + 4); }
    else { px[0] = ps_sum(PS, b, part * 1024 + h * 128 + d); px[1] = 0.f; }
}
__device__ __forceinline__ void ret_sample_unit(Frame& F, int b, int h, f32x4 (&S)[8], const float (&px)[2], float* Sout) {
    bf16* AA = (bf16*)(F.ws + WS_AAB);
    float* sq = (float*)(F.lds); float* sk = sq + 128; float* sv = sk + 128; float* sz = sv + 128; float* red = sz + 128; float* stat = red + 16 * 128;
    const int tid = launder(F.tid) & 511, cg = tid & 31, rg = tid >> 5;
    const float gam = 1.0f - exp2f(-5.0f - (float)h);
    const size_t ro = (size_t)(MP + b) * (2 * RW) + h * DK;
    { const int d = tid & 127, part = tid >> 7;
      if (part < 2) { const int dl = d & 63;
          const float x1 = px[0], x2 = px[1];
          const float cs = ((const float*)(F.ws + WS_TAB + TB_COS))[2048 * 64 + dl], sn = ((const float*)(F.ws + WS_TAB + TB_SIN))[2048 * 64 + dl];
          const float o = d < 64 ? x1 * cs - x2 * sn : x1 * sn + x2 * cs;
          if (part == 0) sq[d] = o; else sk[d] = o * (0.08838834764831845f / gam);
      } else { const float x = px[0]; if (part == 2) sv[d] = x; else sz[d] = x * sigmoidf_(x); } }
    __syncthreads();
    const f32x4 vv = *(const f32x4*)(sv + 4 * cg); f32x4 o = (f32x4){0.f, 0.f, 0.f, 0.f};
#pragma unroll
    for (int i = 0; i < 8; ++i) { const float kk = sk[rg + 16 * i], qq = sq[rg + 16 * i]; S[i] = (S[i] + vv * kk) * gam; o += S[i] * qq;
        __builtin_nontemporal_store(S[i], (f32x4*)(Sout + (size_t)(rg + 16 * i) * DK + 4 * cg)); }
    *(f32x4*)(red + rg * 128 + 4 * cg) = o;
    __syncthreads();
    float ov = 0.f;
    if (tid < 128) {
#pragma unroll
        for (int rr = 0; rr < 16; ++rr) ov += red[rr * 128 + tid];
        const float t1 = wave_sum(ov); if (F.lane == 0) stat[F.wave] = t1;
    }
    __syncthreads();
    float dv_ = 0.f;
    if (tid < 128) { const float mu = (stat[0] + stat[1]) * (1.0f / 128.0f); dv_ = ov - mu; const float t2 = wave_sum(dv_ * dv_); if (F.lane == 0) stat[2 + F.wave] = t2; }
    __syncthreads();
    if (tid < 128) { const float var = (stat[2] + stat[3]) * (1.0f / 128.0f); const float on = dv_ * (1.0f / sqrtf(var + EPSF));
        AA[ro + tid] = (bf16)f2bf(on * sz[tid]); }
    __syncthreads();
}
__device__ __forceinline__ void s5_sample_wave(Frame& F, const Args& args, int g, int b0, int bstep) {
    bf16* Y = (bf16*)(F.ws + WS_Y);
    const int p = launder(F.lane) & 63, gp = g * SP + p;
    const float* PSl = (const float*)(F.ws + WS_PS) + (size_t)(p >> 4) * PS_SLAB + 4096 + g * SN + (p & 15);
    float uq[4], xq[4], yq[4];
#pragma unroll
    for (int k = 0; k < 4; ++k) { const int b = b0 + k * bstep; uq[k] = 0.f; xq[k] = 0.f; yq[k] = 0.f;
        if (b < MS) { uq[k] = PSl[(size_t)b * INC]; xq[k] = args.in[3][(size_t)(b * SG + g) * SP + p]; yq[k] = args.in[4][(size_t)(b * SG + g) * SP + p]; } }
    float br[SN], bi[SN], crv[SN], civ[SN];
    { const f32x4* tb = (const f32x4*)((const float*)(F.ws + WS_TAB + TB_BR) + (size_t)gp * SN); const f32x4* ti = (const f32x4*)((const float*)(F.ws + WS_TAB + TB_BI) + (size_t)gp * SN);
#pragma unroll
      for (int q4 = 0; q4 < 4; ++q4) { const f32x4 a = tb[q4], c = ti[q4]; br[4 * q4] = a[0]; br[4 * q4 + 1] = a[1]; br[4 * q4 + 2] = a[2]; br[4 * q4 + 3] = a[3]; bi[4 * q4] = c[0]; bi[4 * q4 + 1] = c[1]; bi[4 * q4 + 2] = c[2]; bi[4 * q4 + 3] = c[3]; } }
#pragma unroll
    for (int n = 0; n < SN; ++n) { crv[n] = args.in[16][(g * SN + n) * SP + p]; civ[n] = args.in[17][(g * SN + n) * SP + p]; }
    const float ar = ((const float*)(F.ws + WS_TAB + TB_AR))[gp], ai = ((const float*)(F.ws + WS_TAB + TB_AI))[gp];
    const float dnv = args.in[18][g * SN + (p & 15)];
    for (int bb = b0; bb < MS; bb += 4 * bstep) {
        if (bb != b0) {
#pragma unroll
            for (int k = 0; k < 4; ++k) { const int b = bb + k * bstep;
                if (b < MS) { uq[k] = PSl[(size_t)b * INC]; xq[k] = args.in[3][(size_t)(b * SG + g) * SP + p]; yq[k] = args.in[4][(size_t)(b * SG + g) * SP + p]; } }
        }
#pragma unroll
        for (int k = 0; k < 4; ++k) { const int b = bb + k * bstep;
            if (b < MS) {
                float un = uq[k]; un += __shfl_xor(un, 16); un += __shfl_xor(un, 32);
                const float x0r = xq[k], x0i = yq[k];
                float bur = 0.f, bui = 0.f;
#pragma unroll
                for (int n = 0; n < SN; ++n) { const float u = __builtin_bit_cast(float, __builtin_amdgcn_readlane(__builtin_bit_cast(int, un), n)); bur += br[n] * u; bui += bi[n] * u; }
                const float xr = ar * x0r - ai * x0i + bur, xi = ar * x0i + ai * x0r + bui;
                float yv = 0.f;
#pragma unroll
                for (int n = 0; n < SN; ++n) { const float sm = wave_sum(crv[n] * xr - civ[n] * xi); if ((p & 15) == n) yv = sm; }
                F.out[O_RES + (size_t)(b * SG + g) * SP + p] = xr; F.out[O_IMS + (size_t)(b * SG + g) * SP + p] = xi;
                if (p < 16) { const float y = yv + dnv * un; Y[(size_t)(MP + b) * SW + g * SN + p] = (bf16)f2bf(gelu_tanh(y)); }
            }
        }
    }
}
constexpr int S5_XLOC = 0, S5_XIN = 8192, S5_XIM = 32768;
__device__ __forceinline__ void s5_unit(Frame& F, const Args& args, int b, int g) {
    LAS unsigned char* lds = F.lds;
    const bf16* UBg = (const bf16*)(F.ws + WS_UB) + (size_t)g * MPAD * 16; bf16* Y = (bf16*)(F.ws + WS_Y);
    const float* tar = (const float*)(F.ws + WS_TAB + TB_AR); const float* tai = (const float*)(F.ws + WS_TAB + TB_AI);
    const float* tbr = (const float*)(F.ws + WS_TAB + TB_BR); const float* tbi = (const float*)(F.ws + WS_TAB + TB_BI);
    const int w = F.wave, lane = launder(F.lane), c = lane & 31, h = lane >> 5;
    const size_t rb = (size_t)b * SEQ;
    bf16x8 bfr[4];
#pragma unroll
    for (int f = 0; f < 4; ++f) { const float* src = ((f >> 1) ? tbi : tbr) + (size_t)(g * SP + c + 32 * (f & 1)) * SN + 8 * h;
        const f32x4 v0 = *(const f32x4*)src, v1 = *(const f32x4*)(src + 4);
        v4u t; t.x = cvtpk(v0[0], v0[1]); t.y = cvtpk(v0[2], v0[3]); t.z = cvtpk(v1[0], v1[1]); t.w = cvtpk(v1[2], v1[3]); bfr[f] = __builtin_bit_cast(bf16x8, t); }
    float ar[2], ai[2];
#pragma unroll
    for (int ps = 0; ps < 2; ++ps) { ar[ps] = tar[g * SP + c + 32 * ps]; ai[ps] = tai[g * SP + c + 32 * ps]; }
    const int rho = lane & 31, hr = (rho >> 2) & 1, ir = (rho & 3) + 4 * (rho >> 3);
    const bf16* arow = UBg + (rb + 128 * (size_t)(2 * w + hr) + ir) * 16 + 8 * h;
    f32x16 zero16;
#pragma unroll
    for (int i = 0; i < 16; ++i) zero16[i] = 0.f;
    float xr[2] = {0.f, 0.f}, xi[2] = {0.f, 0.f};
    bf16x8 afr[8];
#pragma unroll
    for (int blk = 0; blk < 8; ++blk) afr[blk] = *(const bf16x8*)(arow + (size_t)blk * 256);
#pragma unroll
    for (int blk = 0; blk < 8; ++blk) {
        const bf16x8 A = afr[blk];
        f32x16 bu[4];
#pragma unroll
        for (int f = 0; f < 4; ++f) bu[f] = MFMA32(A, bfr[f], zero16);
#pragma unroll
        for (int i = 0; i < 16; ++i)
#pragma unroll
            for (int ps = 0; ps < 2; ++ps) { const float nr = fmaf(ar[ps], xr[ps], fmaf(-ai[ps], xi[ps], bu[ps][i])), ni = fmaf(ar[ps], xi[ps], fmaf(ai[ps], xr[ps], bu[2 + ps][i])); xr[ps] = nr; xi[ps] = ni; }
    }
    LAS f32x2v* xloc = (LAS f32x2v*)(lds + S5_XLOC); LAS f32x2v* xin = (LAS f32x2v*)(lds + S5_XIN);
#pragma unroll
    for (int ps = 0; ps < 2; ++ps) xloc[(2 * w + h) * 64 + c + 32 * ps] = (f32x2v){xr[ps], xi[ps]};
    LDS_WAIT(); __syncthreads();
    if (w == 0) {
        float a_r = tar[g * SP + lane], a_i = tai[g * SP + lane];
#pragma unroll
        for (int k = 0; k < 7; ++k) { const float nr = a_r * a_r - a_i * a_i, ni = 2.0f * a_r * a_i; a_r = nr; a_i = ni; }
        float sr = 0.f, si = 0.f;
        for (int sgm = 0; sgm < 16; ++sgm) { xin[sgm * 64 + lane] = (f32x2v){sr, si}; const f32x2v l = xloc[sgm * 64 + lane];
            const float nr = a_r * sr - a_i * si + l.x, ni = a_r * si + a_i * sr + l.y; sr = nr; si = ni; }
        F.out[O_REP + (size_t)(b * SG + g) * SP + lane] = sr; F.out[O_IMP + (size_t)(b * SG + g) * SP + lane] = si;
    }
    LDS_WAIT(); __syncthreads();
#pragma unroll
    for (int ps = 0; ps < 2; ++ps) { const f32x2v v = xin[(2 * w + h) * 64 + c + 32 * ps]; xr[ps] = v.x; xi[ps] = v.y; }
    bf16x8 cfr[4];
    { const int n = lane & 15, kq = lane >> 4;
#pragma unroll
      for (int ks = 0; ks < 4; ++ks) { const float* src = ((ks >> 1) ? args.in[17] : args.in[16]) + (size_t)(g * SN + n) * SP + 32 * (ks & 1) + 8 * kq; const float sgn = (ks >> 1) ? -1.0f : 1.0f;
          const f32x4 v0 = *(const f32x4*)src * sgn, v1 = *(const f32x4*)(src + 4) * sgn;
          v4u t; t.x = cvtpk(v0[0], v0[1]); t.y = cvtpk(v0[2], v0[3]); t.z = cvtpk(v1[0], v1[1]); t.w = cvtpk(v1[2], v1[3]); cfr[ks] = __builtin_bit_cast(bf16x8, t); } }
    const int tq = lane & 15, nq = lane >> 4;
    const f32x4 dn = *(const f32x4*)(args.in[18] + g * SN + 4 * nq);
    LAS unsigned char* xim = lds + S5_XIM + w * 8192;
    v2u uvs[8][2];
#pragma unroll
    for (int blk = 0; blk < 8; ++blk)
#pragma unroll
        for (int sq = 0; sq < 2; ++sq) uvs[blk][sq] = *(const v2u*)(UBg + (rb + 128 * (size_t)(2 * w + sq) + 16 * blk + tq) * 16 + 4 * nq);
#pragma unroll
    for (int blk = 0; blk < 8; ++blk) {
        const bf16x8 A = afr[blk];
        f32x16 bu[4];
#pragma unroll
        for (int f = 0; f < 4; ++f) bu[f] = MFMA32(A, bfr[f], zero16);
#pragma unroll
        for (int i = 0; i < 16; ++i)
#pragma unroll
            for (int ps = 0; ps < 2; ++ps) { const float nr = fmaf(ar[ps], xr[ps], fmaf(-ai[ps], xi[ps], bu[ps][i])), ni = fmaf(ar[ps], xi[ps], fmaf(ai[ps], xr[ps], bu[2 + ps][i])); xr[ps] = nr; xi[ps] = ni; bu[ps][i] = nr; bu[2 + ps][i] = ni; }
#pragma unroll
        for (int f = 0; f < 4; ++f) { LAS unsigned char* dst = xim + h * 4096 + ((f >> 1) * 64 + (f & 1) * 32 + c) * 32;
            *(LAS bf16x8*)dst = pack8(bu[f], 0); *(LAS bf16x8*)(dst + 16) = pack8(bu[f], 1); }
        LDS_WAIT(); asm volatile("" ::: "memory");
#pragma unroll
        for (int sq = 0; sq < 2; ++sq) {
            f32x4 yT = (f32x4){0.f, 0.f, 0.f, 0.f};
#pragma unroll
            for (int ks = 0; ks < 4; ++ks) {
                LAS unsigned char* base = xim + sq * 4096 + (32 * ks + 8 * nq + (tq >> 2)) * 32 + 8 * (tq & 3);
                const bf16x8 B = cat8(lds_tr(base), lds_tr(base + 4 * 32));
                yT = MFMA16(cfr[ks], B, yT);
            }
            const size_t row = rb + 128 * (size_t)(2 * w + sq) + 16 * blk + tq;
            const v2u uv = uvs[blk][sq];
            const float y0 = gelu_tanh(yT[0] + dn[0] * bf_lo(uv.x)), y1 = gelu_tanh(yT[1] + dn[1] * bf_hi(uv.x)), y2 = gelu_tanh(yT[2] + dn[2] * bf_lo(uv.y)), y3 = gelu_tanh(yT[3] + dn[3] * bf_hi(uv.y));
            v2u wv; wv.x = cvtpk(y0, y1); wv.y = cvtpk(y2, y3); *(v2u*)(Y + row * SW + g * SN + 4 * nq) = wv;
        }
        LDS_WAIT(); asm volatile("" ::: "memory");
    }
    __syncthreads();
}
__device__ __forceinline__ void p2_phase(Frame& F, const Args& args, int mask) {
    if (mask & 1) for (int pu = F.vcu; pu < 256; pu += F.G) { const int bh = pu >> 3, jj = pu & 7; for (int k2 = 0; k2 < 2; ++k2) ret_unit(F, bh >> 3, bh & 7, k2 ? 15 - jj : jj, k2 != 0, k2 ? -1 : 15 - jj); }
    if (mask & 2) for (int u5 = F.vcu; u5 < NBATCH * SG; u5 += F.G) s5_unit(F, args, u5 >> 6, u5 & 63);
    (void)0;
    const float* PSr = (const float*)(F.ws + WS_PS);
    const int it0 = F.vcu * NTHR + F.tid, its = F.G * NTHR;
    f32x4 xs[2][4];
    if (mask & 8) {
#pragma unroll
      for (int k = 0; k < 2; ++k) { const int it = it0 + k * its;
        if (it < MS * (5120 / 4)) { const float* p = PSr + (size_t)(it / 1280) * INC + 5120 + 4 * (it % 1280);
#pragma unroll
          for (int sl = 0; sl < 4; ++sl) xs[k][sl] = *(const f32x4*)(p + (size_t)sl * PS_SLAB); } }
    }
    const int gw = F.vcu * NWAVES + F.wave, NGW = F.G * NWAVES;
    if (mask & 8) { if (NGW % SG == 0) s5_sample_wave(F, args, gw % SG, gw / SG, NGW / SG); else for (int v = gw; v < MS * SG; v += NGW) s5_sample_wave(F, args, v % SG, v / SG, MS); }
    if (mask & 8) {
      for (int it = it0, k = 0; it < MS * (5120 / 4); it += its, ++k) { const int b = it / 1280, n = 5120 + 4 * (it % 1280);
        f32x4 x;
        if (k == 0) x = (xs[0][0] + xs[0][1]) + (xs[0][2] + xs[0][3]);
        else if (k == 1) x = (xs[1][0] + xs[1][1]) + (xs[1][2] + xs[1][3]);
        else { const float* p = PSr + (size_t)b * INC + n; x = (*(const f32x4*)p + *(const f32x4*)(p + PS_SLAB)) + (*(const f32x4*)(p + 2 * PS_SLAB) + *(const f32x4*)(p + 3 * PS_SLAB)); }
        f32x4 o; for (int e = 0; e < 4; ++e) { const float sg = sigmoidf_(x[e]); o[e] = n < 6144 ? x[e] * sg : sg; }
        bf16* dst = n < 6144 ? (bf16*)(F.ws + WS_ZB) + (size_t)(MP + b) * SW + (n - 5120) : (n < 8192 ? (bf16*)(F.ws + WS_GAS) + (size_t)b * DM + (n - 6144) : (bf16*)(F.ws + WS_GBS) + (size_t)b * DM + (n - 8192));
        *(v2u*)dst = pk4(o); } }
}

template <int NT>
__device__ __forceinline__ void sk_acc(f32x4 (&acc)[NT], const bf16* X, const bf16* Wt, int K, int n0, int wave, int lane) {
    const int kq = lane >> 4;
    const bf16* xp = X + (size_t)(16 * wave + (lane & 15)) * K + 8 * kq;
    const bf16* wp = Wt + (size_t)(n0 + (lane & 15)) * K + 8 * kq;
#pragma unroll
    for (int nt = 0; nt < NT; ++nt) acc[nt] = (f32x4){0.f, 0.f, 0.f, 0.f};
#pragma unroll 8
    for (int ks = 0; ks < K / 32; ++ks) {
        const bf16x8 a = *(const bf16x8*)(xp + 32 * ks);
#pragma unroll
        for (int nt = 0; nt < NT; ++nt) { const bf16x8 bw = *(const bf16x8*)(wp + (size_t)nt * 16 * K + 32 * ks); acc[nt] = MFMA16(bw, a, acc[nt]); }
    }
}
__device__ __forceinline__ f32x4 ld4bf(const bf16* p) { const v2u w = *(const v2u*)p; return (f32x4){bf_lo(w.x), bf_hi(w.x), bf_lo(w.y), bf_hi(w.y)}; }
__device__ __forceinline__ void p3_sample_ret(Frame& F, const Args& args, int idx, int nidle, int v0, int v1) {
    f32x4 Scur[8], Snxt[8]; float pc[2], pn[2];
    const float* PS = (const float*)(F.ws + WS_PS);
    int v = v0 + idx;
    if (v < v1) ret_sample_load(Scur, pc, args.in[2] + (size_t)v * DK * DK, PS, v, F.tid);
    for (; v < v1; v += nidle) {
        const bool hasn = v + nidle < v1;
        if (hasn) ret_sample_load(Snxt, pn, args.in[2] + (size_t)(v + nidle) * DK * DK, PS, v + nidle, F.tid);
        ret_sample_unit(F, v / NH, v % NH, Scur, pc, F.out + O_RS + (size_t)v * DK * DK);
        if (hasn) { pc[0] = pn[0]; pc[1] = pn[1];
#pragma unroll
            for (int i = 0; i < 8; ++i) Scur[i] = Snxt[i]; }
    }
}
__device__ __forceinline__ void sk_p3(Frame& F, const Args& args, int idx, int nidle);
template <int KS4>
__device__ __forceinline__ void skw_acc(f32x4 (&acc)[4], const bf16* X, const bf16* Wt, int K, int k0, int n0, int lane) {
    const int kq = lane >> 4;
    const bf16* xp = X + (size_t)(lane & 15) * K + k0 + 8 * kq;
    const bf16* wp = Wt + (size_t)(n0 + (lane & 15)) * K + k0 + 8 * kq;
    bf16x8 af[KS4][4], wf[KS4];
#pragma unroll
    for (int ks = 0; ks < KS4; ++ks) { wf[ks] = *(const bf16x8*)(wp + 32 * ks);
#pragma unroll
        for (int mt = 0; mt < 4; ++mt) af[ks][mt] = *(const bf16x8*)(xp + (size_t)mt * 16 * K + 32 * ks); }
#pragma unroll
    for (int ks = 0; ks < KS4; ++ks)
#pragma unroll
        for (int mt = 0; mt < 4; ++mt) acc[mt] = MFMA16(wf[ks], af[ks][mt], acc[mt]);
}
__device__ __forceinline__ f32x4 skw_reduce(Frame& F, const f32x4 (&acc)[4], int lane) {
    LAS f32x4* red = (LAS f32x4*)F.lds;
#pragma unroll
    for (int mt = 0; mt < 4; ++mt) red[(F.wave * 64 + 16 * mt + (lane & 15)) * 4 + (lane >> 4)] = acc[mt];
    LDS_WAIT(); __syncthreads();
    f32x4 sum = (f32x4){0.f, 0.f, 0.f, 0.f};
    if (F.tid < 256) {
#pragma unroll
        for (int wv = 0; wv < 8; ++wv) sum += red[wv * 256 + F.tid]; }
    LDS_WAIT(); __syncthreads();
    return sum;
}
constexpr int SKL_OFF = 32768, SKL_WAVE = 16 * (512 + 16);
template <int KW>
__device__ __forceinline__ void skl_acc(f32x4 (&acc)[4], const bf16* X, const bf16* Wt, int ld, int k0, int n0, LAS unsigned char* wl, int lane) {
    constexpr int RB = 2 * KW, LPR = RB / 16, RPI = 64 / LPR, NI = 16 / RPI, KS = KW / 32, PB = RB + 16;
    const int lr = lane / LPR, lc = lane % LPR, m15 = lane & 15, kq = lane >> 4;
    const bf16* wsrc = Wt + (size_t)(n0 + lr) * ld + k0 + 8 * lc;
    const bf16* xsrc = X + (size_t)lr * ld + k0 + 8 * lc;
    LAS unsigned char* wdst = wl + lr * PB + 16 * lc;
    LAS unsigned char* frd = wl + m15 * PB + 16 * kq;
    v4u wv[NI], xv[NI];
#pragma unroll
    for (int i = 0; i < NI; ++i) wv[i] = *(const v4u*)(wsrc + (size_t)i * RPI * ld);
#pragma unroll
    for (int i = 0; i < NI; ++i) xv[i] = *(const v4u*)(xsrc + (size_t)i * RPI * ld);
#pragma unroll
    for (int i = 0; i < NI; ++i) *(LAS v4u*)(wdst + i * RPI * PB) = wv[i];
    LDS_WAIT(); asm volatile("" ::: "memory");
    bf16x8 wf[KS];
#pragma unroll
    for (int ks = 0; ks < KS; ++ks) wf[ks] = *(const LAS bf16x8*)(frd + 64 * ks);
    LDS_WAIT(); asm volatile("" ::: "memory");
#pragma unroll
    for (int mt = 0; mt < 4; ++mt) {
#pragma unroll
        for (int i = 0; i < NI; ++i) *(LAS v4u*)(wdst + i * RPI * PB) = xv[i];
        if (mt < 3) {
#pragma unroll
            for (int i = 0; i < NI; ++i) xv[i] = *(const v4u*)(xsrc + (size_t)((mt + 1) * 16 + i * RPI) * ld); }
        LDS_WAIT(); asm volatile("" ::: "memory");
        bf16x8 xf[KS];
#pragma unroll
        for (int ks = 0; ks < KS; ++ks) xf[ks] = *(const LAS bf16x8*)(frd + 64 * ks);
        LDS_WAIT(); asm volatile("" ::: "memory");
#pragma unroll
        for (int ks = 0; ks < KS; ++ks) acc[mt] = MFMA16(wf[ks], xf[ks], acc[mt]);
    }
}
__device__ __forceinline__ void sk_p3(Frame& F, const Args& args, int idx, int nidle) {
    for (int task = idx; task < 2 * (SW / 16); task += nidle) {
        const int ct = task >> 1, r0 = 64 * (task & 1);
        const int lane = launder(F.lane) & 63; f32x4 acc[4];
#pragma unroll
        for (int mt = 0; mt < 4; ++mt) acc[mt] = (f32x4){0.f, 0.f, 0.f, 0.f};
        skl_acc<128>(acc, (const bf16*)(F.ws + WS_Y) + (size_t)(MP + r0) * SW, (const bf16*)(F.ws + WS_WGLU), SW, 128 * F.wave, 16 * ct, F.lds + SKL_OFF + F.wave * SKL_WAVE, lane);
        const f32x4 gsum = skw_reduce(F, acc, lane);
        const int tid = launder(F.tid) & 511;
        if (tid < 256) { const int m = r0 + (tid >> 2), n = 16 * ct + 4 * (tid & 3); const size_t off = (size_t)(MP + m) * SW + n;
            const f32x4 gg = gsum + *(const f32x4*)(args.in[20] + n), yv = ld4bf((const bf16*)(F.ws + WS_Y) + off), zv = ld4bf((const bf16*)(F.ws + WS_ZB) + off);
            f32x4 o; for (int e = 0; e < 4; ++e) o[e] = yv[e] * sigmoidf_(gg[e]) * zv[e];
            *(v2u*)((bf16*)(F.ws + WS_AAB) + (size_t)(MP + m) * (2 * SW) + SW + n) = pk4(o); }
    }
}
__device__ __forceinline__ void sk_p4(Frame& F) {
    for (int task = F.vcu; task < 2 * (DM / 16); task += F.G) {
        const int ct = task >> 1, r0 = 64 * (task & 1);
        const int lane = launder(F.lane) & 63; f32x4 acc[4];
        const bf16* X = (const bf16*)(F.ws + WS_AAB) + (size_t)(MP + r0) * 2 * RW;
#pragma unroll
        for (int mt = 0; mt < 4; ++mt) acc[mt] = (f32x4){0.f, 0.f, 0.f, 0.f};
        skl_acc<128>(acc, X, (const bf16*)(F.ws + WS_WPA), 2 * RW, 128 * F.wave, 16 * ct, F.lds + SKL_OFF + F.wave * SKL_WAVE, lane);
        const f32x4 ya = skw_reduce(F, acc, lane);
#pragma unroll
        for (int mt = 0; mt < 4; ++mt) acc[mt] = (f32x4){0.f, 0.f, 0.f, 0.f};
        skl_acc<128>(acc, X, (const bf16*)(F.ws + WS_WPA), 2 * RW, RW + 128 * F.wave, 16 * ct, F.lds + SKL_OFF + F.wave * SKL_WAVE, lane);
        const f32x4 yb = skw_reduce(F, acc, lane);
        const int tid = launder(F.tid) & 511;
        if (tid < 256) { const size_t goff = (size_t)(r0 + (tid >> 2)) * DM + 16 * ct + 4 * (tid & 3), off = goff + (size_t)MP * DM;
            const f32x4 o = ld4bf((const bf16*)(F.ws + WS_GAS) + goff) * ya + ld4bf((const bf16*)(F.ws + WS_GBS) + goff) * yb;
            *(v2u*)((bf16*)(F.ws + WS_MRG) + off) = pk4(o); }
    }
}
__device__ __forceinline__ void sk_p5(Frame& F) {
    for (int task = F.vcu; task < 2 * (DM / 16); task += F.G) {
        const int ct = task >> 1, r0 = 64 * (task & 1);
        const int lane = launder(F.lane) & 63; f32x4 acc[4];
        const bf16* X = (const bf16*)(F.ws + WS_MRG) + (size_t)(MP + r0) * DM;
#pragma unroll
        for (int mt = 0; mt < 4; ++mt) acc[mt] = (f32x4){0.f, 0.f, 0.f, 0.f};
        skl_acc<256>(acc, X, (const bf16*)(F.ws + WS_WOUT), DM, 256 * F.wave, 16 * ct, F.lds + SKL_OFF + F.wave * SKL_WAVE, lane);
        const f32x4 o = skw_reduce(F, acc, lane);
        const int tid = launder(F.tid) & 511;
        if (tid < 256) *(v2u*)((bf16*)(F.ws + WS_OUT) + (size_t)(MP + r0 + (tid >> 2)) * DM + 16 * ct + 4 * (tid & 3)) = pk4(o);
    }
}

__device__ __forceinline__ void p6_load(v2u (&ov)[8], f32x4 (&xv)[8], const bf16* OUT, const Args& args, int m, int lane) {
    const float* xrow = m < MP ? args.in[0] + (size_t)m * DM : args.in[1] + (size_t)(m - MP) * DM;
    const GAS v2u* orow = (const GAS v2u*)(OUT + (size_t)m * DM) + lane; const GAS f32x4* xr = (const GAS f32x4*)xrow + lane;
#pragma unroll
    for (int j = 0; j < 8; ++j) { ov[j] = orow[64 * j]; xv[j] = __builtin_nontemporal_load(xr + 64 * j); }
}
__device__ __forceinline__ void p6_final(Frame& F, const Args& args) {
    const bf16* OUT = (const bf16*)(F.ws + WS_OUT);
    const int gw = F.vcu * NWAVES + F.wave, NGW = F.G * NWAVES;
    f32x4 gq[8];
    { const GAS f32x4* gr = (const GAS f32x4*)args.in[10] + F.lane;
#pragma unroll
      for (int j = 0; j < 8; ++j) gq[j] = gr[64 * j]; }
    v2u oa[8], ob[8]; f32x4 xa[8], xb[8];
    int m = gw;
    if (m < MV) p6_load(oa, xa, OUT, args, m, F.lane);
    for (; m < MV; m += NGW) {
        const bool hasn = m + NGW < MV;
        if (hasn) p6_load(ob, xb, OUT, args, m + NGW, F.lane);
        float* yrow = m < MP ? F.out + O_YP + (size_t)m * DM : F.out + O_YS + (size_t)(m - MP) * DM;
        f32x4 v[8]; float s = 0.f;
#pragma unroll
        for (int j = 0; j < 8; ++j) { v[j] = (f32x4){bf_lo(oa[j].x), bf_hi(oa[j].x), bf_lo(oa[j].y), bf_hi(oa[j].y)}; s += (v[j].x * v[j].x + v[j].y * v[j].y) + (v[j].z * v[j].z + v[j].w * v[j].w); }
        const float rstd = 1.0f / sqrtf(wave_sum(s) * (1.f / DM) + EPSF);
        GAS f32x4* yo = (GAS f32x4*)yrow + F.lane;
#pragma unroll
        for (int j = 0; j < 8; ++j) __builtin_nontemporal_store(xa[j] + v[j] * rstd * gq[j], yo + 64 * j);
        if (hasn) {
#pragma unroll
            for (int j = 0; j < 8; ++j) { oa[j] = ob[j]; xa[j] = xb[j]; } }
    }
}

__global__ void __launch_bounds__(NTHR, 2) fwd_kernel(Args args) {
    extern __shared__ __attribute__((aligned(16))) unsigned char lds[];
    Frame F;
    F.lds = (LAS unsigned char*)lds;
    F.MISC = (volatile LAS unsigned*)(F.lds + MISC_OFF);
    F.tid = threadIdx.x; F.lane = F.tid & 63; F.wave = __builtin_amdgcn_readfirstlane(F.tid >> 6);
    F.G = gridDim.x; { const int bx = blockIdx.x; F.vcu = (F.G % 8 == 0) ? (bx % 8) * (F.G / 8) + bx / 8 : bx; }
    F.out = args.out; F.ws = args.ws;
    for (int u = F.tid; u < (LDS_BYTES - LDSCTL_OFF) / 4; u += NTHR) ((LAS unsigned*)(F.lds + LDSCTL_OFF))[u] = 0u;
    __syncthreads();
    unsigned* ctl = (unsigned*)(args.ws + WS_CTL);
    XcdBarrier bar; bar.bar = ctl + CW_BAR + args.li * XCD_BAR_WORDS; bar.x = 0; bar.st = nullptr;
    const int lo = args.ph_lo, hi = args.ph_hi;
    if (hi - lo > 1) bar = xcd_barrier_post(ctl + CW_BAR + args.li * XCD_BAR_WORDS, F.MISC + 8);
#define IN(k) (lo <= (k) && (k) < hi)
#define BOTH(k) (IN(k) && IN((k) + 1))
#define GRID_BAR() xcd_barrier(bar)

    if (IN(0)) for (int rep = 0; rep < (REP_PHASE == 0 ? 2 : 1); ++rep) { p0_prologue(F, args); if (BOTH(0)) GRID_BAR(); }

    if (IN(1)) for (int rep = 0; rep < (REP_PHASE == 1 ? 2 : 1); ++rep) {
        pg8::Gemm g{(const bf16*)(F.ws + WS_H), (const bf16*)(F.ws + WS_WIN), nullptr, nullptr, DM};
        pg8::ProjOrder S; S.init(MP, INC, F.G, (int)blockIdx.x);
        EpiProj E{(bf16*)(F.ws + WS_Q), (bf16*)(F.ws + WS_K), (bf16*)(F.ws + WS_V), (bf16*)(F.ws + WS_ZA), (bf16*)(F.ws + WS_UB), (bf16*)(F.ws + WS_ZB), (bf16*)(F.ws + WS_GA), (bf16*)(F.ws + WS_GB),
                  (const float*)(F.ws + WS_TAB + TB_COS), (const float*)(F.ws + WS_TAB + TB_SIN), (float*)(F.ws + WS_PS)};
        { const int nun = MP / 256 * (INC / 256) + 4 * (INC / 256), rem = nun % F.G;
          if (rem == 0) p1_convert_rest(F, args, (int)blockIdx.x, F.G); else if ((int)blockIdx.x >= rem) p1_convert_rest(F, args, (int)blockIdx.x - rem, F.G - rem);
          __syncthreads(); }
        pg8::gemm_phase<EpiProj, pg8::ProjOrder, true, true>(F.lds, g, S, E);
        if (BOTH(1)) GRID_BAR();
    }

    if (IN(2)) for (int rep = 0; rep < (REP_PHASE == 2 ? 2 : 1); ++rep) { p2_phase(F, args, args.pad ? args.pad : 15); if (BOTH(2)) GRID_BAR(); }

    if (IN(3)) for (int rep = 0; rep < (REP_PHASE == 3 ? 2 : 1); ++rep) {
        pg8::Gemm g{(const bf16*)(F.ws + WS_Y), (const bf16*)(F.ws + WS_WGLU), nullptr, nullptr, SW};
        pg8::StaticOrder S; S.init(MP, SW, F.G, (int)blockIdx.x);
        EpiGlu E{(const bf16*)(F.ws + WS_Y), (const bf16*)(F.ws + WS_ZB), (bf16*)(F.ws + WS_AAB), args.in[20]};
        pg8::gemm_phase<EpiGlu, pg8::StaticOrder, true, true>(F.lds, g, S, E);
        if (F.G > 128) { if ((int)blockIdx.x >= 128) sk_p3(F, args, (int)blockIdx.x - 128, F.G - 128); } else sk_p3(F, args, (int)blockIdx.x, F.G);
        if (F.G == 256) { if ((int)blockIdx.x >= 128) p3_sample_ret(F, args, (int)blockIdx.x - 128, 128, 0, 768); else p3_sample_ret(F, args, (int)blockIdx.x, 128, 768, MS * NH); }
        else if (F.G > 128) { if ((int)blockIdx.x >= 128) p3_sample_ret(F, args, (int)blockIdx.x - 128, F.G - 128, 0, MS * NH); } else p3_sample_ret(F, args, (int)blockIdx.x, F.G, 0, MS * NH);
        if (BOTH(3)) GRID_BAR();
    }

    if (IN(4)) for (int rep = 0; rep < (REP_PHASE == 4 ? 2 : 1); ++rep) {
        pg8::Gemm g{(const bf16*)(F.ws + WS_AAB), (const bf16*)(F.ws + WS_WPA), nullptr, nullptr, 2 * RW};
        pg8::StaticOrder S; S.init(MP, DM, F.G, (int)blockIdx.x);
        EpiMerge E{(const unsigned char*)(F.ws + WS_G8A), (const unsigned char*)(F.ws + WS_G8B), (bf16*)(F.ws + WS_MRG)};
        sk_p4(F);
        pg8::gemm_phase<EpiMerge, pg8::StaticOrder, true, true>(F.lds, g, S, E);
        if (BOTH(4)) GRID_BAR();
    }

    const bool fuse5 = false;
    if (IN(5)) for (int rep = 0; rep < (REP_PHASE == 5 ? 2 : 1); ++rep) {
        pg8::Gemm g{(const bf16*)(F.ws + WS_MRG), (const bf16*)(F.ws + WS_WOUT), nullptr, nullptr, DM};
        pg8::StaticOrder S; S.init(MP, DM, F.G, (int)blockIdx.x);
        {
            EpiOutBf16 E{(bf16*)(F.ws + WS_OUT), DM};
            pg8::gemm_phase<EpiOutBf16, pg8::StaticOrder, true, true>(F.lds, g, S, E);
            sk_p5(F);
            if (BOTH(5)) GRID_BAR();
        }
    }

    if (IN(6) && !fuse5) for (int rep = 0; rep < (REP_PHASE == 6 ? 2 : 1); ++rep) { p6_final(F, args); if (REP_PHASE == 6 && rep == 0) GRID_BAR(); }
#undef IN
#undef BOTH
#undef GRID_BAR
}

extern "C" void kernel_launch(void* const* d_in, const int* in_sizes, int n_in, void* d_out, int out_size, void* d_ws, size_t ws_size, hipStream_t stream) {
    static int grid = 0;
    if (grid == 0) {
        if (n_in != 21 || out_size != (int)O_END || ws_size < WS_END2) { fprintf(stderr, "kernel_launch: unexpected shapes: n_in %d out %d ws %zu\n", n_in, out_size, ws_size); grid = -1; return; }
        int dev = 0, cus = 0, per_cu = 0;
        if (hipGetDevice(&dev) != hipSuccess || hipDeviceGetAttribute(&cus, hipDeviceAttributeMultiprocessorCount, dev) != hipSuccess) { grid = -1; return; }
        if (hipFuncSetAttribute((const void*)fwd_kernel, hipFuncAttributeMaxDynamicSharedMemorySize, LDS_BYTES) != hipSuccess) { fprintf(stderr, "kernel_launch: hipFuncSetAttribute failed\n"); grid = -1; return; }
        if (hipOccupancyMaxActiveBlocksPerMultiprocessor(&per_cu, (const void*)fwd_kernel, NTHR, LDS_BYTES) != hipSuccess || per_cu < 1) { fprintf(stderr, "kernel_launch: occupancy query says %d\n", per_cu); (void)hipGetLastError(); grid = -1; return; }
        grid = cus;
    }
    if (grid < 0) return;
    (void)hipMemsetAsync((char*)d_ws + WS_CTL, 0, CTL_ZERO_BYTES, stream);
    Args a{};
    for (int i = 0; i < 21; ++i) a.in[i] = (const float*)d_in[i];
    a.out = (float*)d_out; a.ws = (unsigned char*)d_ws;
#if MK_N_LAUNCHES == 1
    a.ph_lo = 0; a.ph_hi = N_PHASES; a.li = 0;
    hipLaunchKernelGGL(fwd_kernel, dim3(grid), dim3(NTHR), LDS_BYTES, stream, a);
#else
    { const int seq[] = {PROBE_SEQ};
      for (unsigned q = 0; q < sizeof(seq) / sizeof(seq[0]); ++q) { a.ph_lo = seq[q] & 15; a.ph_hi = (seq[q] & 15) + 1; a.li = 0; a.pad = seq[q] >> 4; hipLaunchKernelGGL(fwd_kernel, dim3(grid), dim3(NTHR), LDS_BYTES, stream, a); } }
#endif
}
```

```cpp
#include <hip/hip_runtime.h>
#include <cstdio>
#include <cstdint>

#ifndef MK_N_LAUNCHES
#define MK_N_LAUNCHES 1
#endif
#ifndef PROBE_SEQ
#define PROBE_SEQ 0, 1, 2, 3, 4, 5, 6
#endif
#ifndef REP_PHASE
#define REP_PHASE -1
#endif

namespace pg8 {
#define PG8_LAS __attribute__((address_space(3)))
typedef unsigned short bf16_t;
typedef short bf16x8 __attribute__((ext_vector_type(8)));
typedef float f32x4 __attribute__((ext_vector_type(4)));
typedef float f32x2 __attribute__((ext_vector_type(2)));
typedef unsigned u32x4 __attribute__((ext_vector_type(4)));
typedef unsigned u32x2 __attribute__((ext_vector_type(2)));
constexpr int BM = 256, BK = 64, HALF = 128, HTB = HALF * BK * 2, STAGE_BYTES = 8 * HTB, NXCD = 8, WGM = 8;

__host__ __device__ __forceinline__ int lds_byte(int r, int c) { const int st = (r >> 4) * 2 + (c >> 5), rr = r & 15, cc = c & 31, ob = rr * 64 + cc * 2; return st * 1024 + (ob ^ (((ob >> 9) & 1) << 5)); }
__host__ __device__ __forceinline__ void stage_rc(int b, int& R, int& C) { const int st = b / 1024, sb = b % 1024, swz = sb ^ (((sb >> 9) & 1) << 5); R = (st >> 1) * 16 + swz / 64; C = (st & 1) * 32 + (swz % 64) / 2; }
__host__ __device__ __forceinline__ int perm32(int rho) { const int n = rho >> 4, i = rho & 15; return 8 * (i >> 2) + 4 * n + (i & 3); }

struct Unit { int pm, pn, z; };
struct Gemm { const bf16_t* A0; const bf16_t* B0; const bf16_t* A1; const bf16_t* B1; int K; };

struct StaticOrder {
    int nM, nN, nwg, G, c;
    __host__ __device__ void init(int M, int N, int G_, int c_) { nM = M / BM; nN = N / BM; nwg = nM * nN; G = G_; c = c_; }
    __host__ __device__ bool next(int i, Unit& u) const {
        const long L = (long)i * G + c; if (L >= nwg) return false;
        int wgid = (int)L; { const int q = nwg / NXCD, r = nwg % NXCD, xcd = wgid % NXCD, off = wgid / NXCD; wgid = (xcd < r ? xcd * (q + 1) : r * (q + 1) + (xcd - r) * q) + off; }
        const int nig = WGM * nN, gid = wgid / nig, fm = gid * WGM, gsz = (nM - fm) < WGM ? (nM - fm) : WGM;
        u.pm = fm + ((wgid % nig) % gsz); u.pn = (wgid % nig) / gsz; u.z = 0; return true;
    }
    __host__ __device__ int kofs(const Unit&, int) const { return 0; }
    __host__ __device__ int ktiles(const Unit&, int K) const { return K / BK; }
    __host__ __device__ bool half_m(const Unit&) const { return false; }
};
struct ProjOrder {
    StaticOrder so; int G, c;
    __host__ __device__ void init(int M, int N, int G_, int c_) { so.init(M, N, G_, c_); G = G_; c = c_; }
    __host__ __device__ bool next(int i, Unit& u) const {
        const long L = (long)i * G + c;
        if (L < so.nwg) {
            if (!so.next(i, u)) return false;
            if (so.nN == 40) u.pn = (int)((0x5948237160ull >> (4 * (u.pn >> 2))) & 15ull) * 4 + (u.pn & 3);
            return true; }
        const int si = (int)(L - so.nwg); if (si >= 4 * so.nN) return false;
        u.pm = so.nM; u.pn = si % so.nN; u.z = 1 + si / so.nN; return true;
    }
    __host__ __device__ int kofs(const Unit& u, int) const { return u.z ? (u.z - 1) * 512 : 0; }
    __host__ __device__ int ktiles(const Unit& u, int K) const { return u.z ? 512 / BK : K / BK; }
    __host__ __device__ bool half_m(const Unit& u) const { return u.z != 0; }
};
struct PairOrder {
    int nM, nN, ntile, G, c;
    __host__ __device__ void init(int M, int N, int G_, int c_) { nM = M / BM; nN = N / BM; ntile = nM * nN; G = G_; c = c_; }
    __host__ __device__ bool next(int i, Unit& u) const {
        const long T = (long)(i >> 1) * G + c; if (T >= ntile) return false;
        u.pm = (int)(T % nM); u.pn = (int)(T / nM); u.z = i & 1; return true;
    }
    __host__ __device__ int kofs(const Unit&, int) const { return 0; }
    __host__ __device__ int ktiles(const Unit&, int K) const { return K / BK; }
    __host__ __device__ bool half_m(const Unit&) const { return false; }
};

__device__ __forceinline__ unsigned cvt_pk_bf16(float lo, float hi) { unsigned r; asm volatile("v_cvt_pk_bf16_f32 %0, %1, %2" : "=v"(r) : "v"(lo), "v"(hi)); return r; }
__device__ __forceinline__ float bf_lo(unsigned w) { return __uint_as_float(w << 16); }
__device__ __forceinline__ float bf_hi(unsigned w) { return __uint_as_float(w & 0xffff0000u); }
__device__ __forceinline__ float sigmoidf_(float x) { return __builtin_amdgcn_rcpf(1.0f + __expf(-x)); }

template <class Epi, class Sched, bool ALIGN_EPI = false, bool SP2 = false>
__device__ __forceinline__ void gemm_phase(PG8_LAS unsigned char* lds, const Gemm g, const Sched& S, const Epi& E) {
    const int tid = threadIdx.x, wid = __builtin_amdgcn_readfirstlane(tid >> 6), lane = tid & 63, wr = wid >> 2, wc = wid & 3, fr = lane & 15, fq = lane >> 4;
    const int K = g.K;
    unsigned voffA[2], voffB[2];
#pragma unroll
    for (int i = 0; i < 2; ++i) { int R, C; stage_rc(tid * 16 + i * 8192, R, C); const int Rb = Epi::PERM ? ((R & ~31) + perm32(R & 31)) : R;
        voffA[i] = (unsigned)(R * K + C) * 2u; voffB[i] = (unsigned)(Rb * K + C) * 2u; }
    const size_t kstep = (size_t)(BK * 2);
    const size_t hstep = (size_t)HALF * K * 2;
    const size_t tstep = 2 * hstep;
    const unsigned ldsw = (unsigned)wid * 1024u;
    const int aoff = lds_byte(wr * 64 + fr, fq * 8), boff = lds_byte(wc * 32 + fr, fq * 8);
#define PG8_SA(b, h) (((b) * 2 + (h)) * HTB)
#define PG8_SB(b, h) ((4 + (b) * 2 + (h)) * HTB)
#define PG8_STAGE(bufoff, gbase, voff) do { _Pragma("unroll") for (int _i = 0; _i < 2; ++_i) \
        __builtin_amdgcn_global_load_lds((const unsigned*)((const char*)(gbase) + (voff)[_i]), (PG8_LAS unsigned*)(lds + (bufoff) + ldsw + _i * 8192), 16, 0, 0); } while (0)
#define PG8_LDA(dst, b, h) do { _Pragma("unroll") for (int m = 0; m < 4; ++m) _Pragma("unroll") for (int k = 0; k < 2; ++k) dst[m][k] = *(const PG8_LAS bf16x8*)(lds + PG8_SA(b, h) + aoff + m * 2048 + k * 1024); } while (0)
#define PG8_LDB(dst, b, h) do { _Pragma("unroll") for (int n = 0; n < 2; ++n) _Pragma("unroll") for (int k = 0; k < 2; ++k) dst[n][k] = *(const PG8_LAS bf16x8*)(lds + PG8_SB(b, h) + boff + n * 2048 + k * 1024); } while (0)
#define PG8_MMA(ai, bj, At, Bt) do { __builtin_amdgcn_s_setprio(1); _Pragma("unroll") for (int m = 0; m < 4; ++m) _Pragma("unroll") for (int n = 0; n < 2; ++n) _Pragma("unroll") for (int k = 0; k < 2; ++k) \
        acc[ai][bj][m][n] = __builtin_amdgcn_mfma_f32_16x16x32_bf16(Bt[n][k], At[m][k], acc[ai][bj][m][n], 0, 0, 0); __builtin_amdgcn_s_setprio(0); } while (0)
#define PG8_WAIT_V(n) asm volatile("s_waitcnt vmcnt(" #n ")" ::: "memory")
#define PG8_WAIT_L(n) asm volatile("s_waitcnt lgkmcnt(" #n ")" ::: "memory")
#define PG8_BAR __builtin_amdgcn_s_barrier()
#define PG8_SCHED __builtin_amdgcn_sched_barrier(0)
#define PG8_PA(u) ((const char*)(((u).z && g.A1) ? g.A1 : g.A0) + (size_t)(u).pm * tstep + (size_t)S.kofs(u, K) * 2)
#define PG8_PB(u) ((const char*)(((u).z && g.B1) ? g.B1 : g.B0) + (size_t)(u).pn * tstep + (size_t)S.kofs(u, K) * 2)
    Unit cur, nxt; int ui = 0;
    if (!S.next(0, cur)) return;
    f32x4 acc[2][2][4][2];
#pragma unroll
    for (int a = 0; a < 2; ++a)
#pragma unroll
        for (int b = 0; b < 2; ++b)
#pragma unroll
            for (int m = 0; m < 4; ++m)
#pragma unroll
                for (int n = 0; n < 2; ++n) acc[a][b][m][n] = (f32x4){0.f, 0.f, 0.f, 0.f};
    bf16x8 At[4][2], B0[2][2], B1[2][2];
    const char* cA = PG8_PA(cur); const char* cB = PG8_PB(cur);
    if constexpr (SP2) {
        PG8_STAGE(PG8_SB(0, 0), cB, voffB); PG8_STAGE(PG8_SB(0, 1), cB + hstep, voffB); PG8_STAGE(PG8_SA(0, 0), cA, voffA); PG8_STAGE(PG8_SA(0, 1), cA + (S.half_m(cur) ? 0 : hstep), voffA);
        if (wr == 1) PG8_BAR;
        PG8_WAIT_V(2); PG8_BAR;
        PG8_STAGE(PG8_SB(1, 0), cB + kstep, voffB); PG8_STAGE(PG8_SA(1, 0), cA + kstep, voffA); PG8_STAGE(PG8_SB(1, 1), cB + hstep + kstep, voffB);
        PG8_WAIT_V(6); PG8_BAR;
    } else {
        PG8_STAGE(PG8_SB(0, 0), cB, voffB); PG8_STAGE(PG8_SA(0, 0), cA, voffA); PG8_STAGE(PG8_SB(0, 1), cB + hstep, voffB); PG8_STAGE(PG8_SA(0, 1), cA + hstep, voffA);
        if (wr == 1) PG8_BAR;
        PG8_WAIT_V(4); PG8_BAR;
        PG8_STAGE(PG8_SB(1, 0), cB + kstep, voffB); PG8_STAGE(PG8_SA(1, 0), cA + kstep, voffA); PG8_STAGE(PG8_SB(1, 1), cB + hstep + kstep, voffB);
        PG8_WAIT_V(6); PG8_BAR;
    }
    for (;;) {
        const bool has_next = S.next(ui + 1, nxt);
        const char* nA = has_next ? PG8_PA(nxt) : cA; const char* nB = has_next ? PG8_PB(nxt) : cB;
        const int nt = S.ktiles(cur, K);
        const size_t hsA = S.half_m(cur) ? 0 : hstep, hsN = has_next ? (S.half_m(nxt) ? 0 : hstep) : hsA;
        for (int t = 0; t < nt; t += 2) {
            if constexpr (Epi::MIDHOOK) { if (t == nt / 2) E.mid(acc, cur, wr, wc, fr, fq); }
            const bool last = (t == nt - 2);
            const char* a1 = cA + (size_t)(t + 1) * kstep;
            const char* a2 = last ? nA : cA + (size_t)(t + 2) * kstep; const char* b2 = last ? nB : cB + (size_t)(t + 2) * kstep;
            const char* a3 = a2 + kstep; const char* b3 = b2 + kstep;
            if constexpr (SP2) {
            PG8_LDB(B0, 0, 0); PG8_LDB(B1, 0, 1); PG8_SCHED; PG8_LDA(At, 0, 0); PG8_STAGE(PG8_SA(1, 1), a1 + hsA, voffA);
            PG8_WAIT_V(8); PG8_WAIT_L(0); PG8_BAR; PG8_MMA(0, 0, At, B0); PG8_MMA(0, 1, At, B1); PG8_BAR; PG8_SCHED;
            PG8_LDA(At, 0, 1); PG8_STAGE(PG8_SB(0, 0), b2, voffB); PG8_STAGE(PG8_SB(0, 1), b2 + hstep, voffB); PG8_STAGE(PG8_SA(0, 0), a2, voffA);
            PG8_WAIT_V(8); PG8_WAIT_L(0); PG8_BAR; PG8_MMA(1, 0, At, B0); PG8_MMA(1, 1, At, B1); PG8_BAR; PG8_SCHED;
            PG8_LDB(B0, 1, 0); PG8_LDB(B1, 1, 1); PG8_SCHED; PG8_LDA(At, 1, 0); PG8_STAGE(PG8_SA(0, 1), a2 + (last ? hsN : hsA), voffA);
            PG8_WAIT_V(8); PG8_WAIT_L(0); PG8_BAR; PG8_MMA(0, 0, At, B0); PG8_MMA(0, 1, At, B1); PG8_BAR; PG8_SCHED;
            PG8_LDA(At, 1, 1); PG8_STAGE(PG8_SB(1, 0), b3, voffB); PG8_STAGE(PG8_SB(1, 1), b3 + hstep, voffB); PG8_STAGE(PG8_SA(1, 0), a3, voffA);
            PG8_WAIT_V(8); PG8_WAIT_L(0); PG8_BAR; PG8_MMA(1, 0, At, B0); PG8_MMA(1, 1, At, B1); PG8_BAR; PG8_SCHED;
            } else {
            PG8_LDB(B0, 0, 0); PG8_SCHED; PG8_LDA(At, 0, 0); PG8_STAGE(PG8_SA(1, 1), a1 + hstep, voffA);
            PG8_WAIT_L(8); PG8_BAR; PG8_WAIT_L(0); PG8_MMA(0, 0, At, B0); PG8_BAR; PG8_SCHED;
            PG8_LDB(B1, 0, 1); PG8_STAGE(PG8_SB(0, 0), b2, voffB);
            PG8_BAR; PG8_WAIT_L(0); PG8_MMA(0, 1, At, B1); PG8_BAR;
            PG8_LDA(At, 0, 1); PG8_STAGE(PG8_SA(0, 0), a2, voffA);
            PG8_BAR; PG8_WAIT_L(0); PG8_MMA(1, 0, At, B0); PG8_BAR; PG8_SCHED;
            PG8_STAGE(PG8_SB(0, 1), b2 + hstep, voffB);
            PG8_WAIT_V(6); PG8_BAR; PG8_MMA(1, 1, At, B1); PG8_BAR;
            PG8_LDB(B0, 1, 0); PG8_SCHED; PG8_LDA(At, 1, 0); PG8_STAGE(PG8_SA(0, 1), a2 + hstep, voffA);
            PG8_WAIT_L(8); PG8_BAR; PG8_WAIT_L(0); PG8_MMA(0, 0, At, B0); PG8_BAR; PG8_SCHED;
            PG8_LDB(B1, 1, 1); PG8_STAGE(PG8_SB(1, 0), b3, voffB);
            PG8_BAR; PG8_WAIT_L(0); PG8_MMA(0, 1, At, B1); PG8_BAR;
            PG8_LDA(At, 1, 1); PG8_STAGE(PG8_SA(1, 0), a3, voffA);
            PG8_BAR; PG8_WAIT_L(0); PG8_MMA(1, 0, At, B0); PG8_BAR; PG8_SCHED;
            PG8_STAGE(PG8_SB(1, 1), b3 + hstep, voffB);
            PG8_WAIT_V(6); PG8_BAR; PG8_MMA(1, 1, At, B1); PG8_BAR;
            }
        }
        if constexpr (ALIGN_EPI) { if (wr == 0) PG8_BAR; }
        if constexpr (!Epi::AFTER_DRAIN) E(acc, cur, wr, wc, fr, fq); else { if (has_next) E(acc, cur, wr, wc, fr, fq); }
        if (!has_next) break;
#pragma unroll
        for (int a = 0; a < 2; ++a)
#pragma unroll
            for (int b = 0; b < 2; ++b)
#pragma unroll
                for (int m = 0; m < 4; ++m)
#pragma unroll
                    for (int n = 0; n < 2; ++n) acc[a][b][m][n] = (f32x4){0.f, 0.f, 0.f, 0.f};
        cur = nxt; cA = nA; cB = nB; ++ui;
        if constexpr (ALIGN_EPI) { if (wr == 1) PG8_BAR; }
    }
    PG8_WAIT_V(0);
    __builtin_amdgcn_s_waitcnt(0x0F70);
    if constexpr (!ALIGN_EPI) { if (wr == 0) PG8_BAR; }
    PG8_BAR;
    if constexpr (Epi::AFTER_DRAIN) E.fused(acc, cur, wr, wc, fr, fq, lds, wid, lane);
#undef PG8_SA
#undef PG8_SB
#undef PG8_STAGE
#undef PG8_LDA
#undef PG8_LDB
#undef PG8_MMA
#undef PG8_WAIT_V
#undef PG8_WAIT_L
#undef PG8_BAR
#undef PG8_SCHED
#undef PG8_PA
#undef PG8_PB
}
}

constexpr int NWAVES = 8, NTHR = NWAVES * 64;
constexpr int DM = 2048, SEQ = 2048, NBATCH = 4, MP = NBATCH * SEQ, MS = 128, MV = MP + MS, MPAD = 8448;
constexpr int RW = 1024, NH = 8, DK = 128, SW = 1024, SG = 64, SP = 64, SN = 16;
constexpr int INC = 10240;
constexpr int POS_S = 16384;
constexpr float EPSF = 1e-6f;
constexpr int N_PHASES = 7;

constexpr size_t O_YP = 0, O_YS = O_YP + (size_t)MP * DM, O_RP = O_YS + (size_t)MS * DM, O_REP = O_RP + (size_t)NBATCH * NH * DK * DK,
                 O_IMP = O_REP + (size_t)NBATCH * SG * SP, O_RS = O_IMP + (size_t)NBATCH * SG * SP, O_RES = O_RS + (size_t)MS * NH * DK * DK,
                 O_IMS = O_RES + (size_t)MS * SG * SP, O_END = O_IMS + (size_t)MS * SG * SP;
static_assert(O_END == 35422208, "output size");

constexpr size_t MiB = 1u << 20;
constexpr size_t WS_CTL = 0, CTL_ZERO_BYTES = 64 * 1024;
constexpr size_t WS_WIN = 1 * MiB;
constexpr size_t WS_WPA = WS_WIN + 40 * MiB;
constexpr size_t WS_WPB = WS_WPA + 4 * MiB;
constexpr size_t WS_WOUT = WS_WPB + 4 * MiB;
constexpr size_t WS_WGLU = WS_WOUT + 8 * MiB;
constexpr size_t WS_TAB = WS_WGLU + 2 * MiB;
constexpr size_t ACT1 = (size_t)MPAD * 1024 * 2;
constexpr size_t WS_H = WS_TAB + 2 * MiB;
constexpr size_t WS_Q = WS_H + 2 * ACT1, WS_K = WS_Q + ACT1, WS_V = WS_K + ACT1, WS_ZA = WS_V + ACT1, WS_UB = WS_ZA + ACT1, WS_ZB = WS_UB + ACT1;
constexpr size_t WS_GA = WS_ZB + ACT1, WS_GB = WS_GA + 2 * ACT1, WS_END = WS_GB + 2 * ACT1;
constexpr size_t WS_G8A = WS_GA, WS_G8B = WS_GA + 16 * MiB;
constexpr size_t WS_GAS = WS_GA + 40 * MiB, WS_GBS = WS_GAS + 1 * MiB;
constexpr size_t WS_AAB = WS_H;
constexpr size_t WS_Y = WS_GA + 44 * MiB;
constexpr size_t WS_MRG = WS_K;
constexpr size_t WS_OUT = WS_GA;
constexpr size_t WS_PS = WS_END;
constexpr size_t PS_SLAB = (size_t)MS * INC;
constexpr size_t WS_XS = WS_PS + 4 * PS_SLAB * 4;
constexpr size_t WS_XS2 = WS_XS + (size_t)MP * 8 * 4;
constexpr size_t WS_END2 = WS_XS2 + (size_t)MS * 128 * 4;
static_assert(WS_END2 <= 300 * MiB, "ws map");
constexpr size_t TB_COS = 0, TB_SIN = TB_COS + 2049 * 64 * 4, TB_AR = TB_SIN + 2049 * 64 * 4, TB_AI = TB_AR + 64 * 64 * 4,
                 TB_BR = TB_AI + 64 * 64 * 4, TB_BI = TB_BR + 64 * 64 * 16 * 4, TB_END = TB_BI + 64 * 64 * 16 * 4;
static_assert(TB_END <= 2 * MiB && (TB_SIN % 16) == 0 && (TB_AR % 16) == 0, "tables");

constexpr int CW_TMO = 0;
constexpr int CW_SEAM = 16384;
constexpr int CW_BAR = 4096;

constexpr int RING_BYTES = 131072, LDSCTL_OFF = RING_BYTES, MISC_OFF = LDSCTL_OFF + 320, LDS_BYTES = 147456;

#define GAS __attribute__((address_space(1)))
#define LAS __attribute__((address_space(3)))
typedef unsigned short bf16;
typedef unsigned v4u __attribute__((ext_vector_type(4)));
typedef unsigned v2u __attribute__((ext_vector_type(2)));
typedef float f32x4 __attribute__((ext_vector_type(4)));
typedef GAS unsigned gu32;
#define RLX_AGENT __ATOMIC_RELAXED, __HIP_MEMORY_SCOPE_AGENT
#define LDS_WAIT() asm volatile("s_waitcnt lgkmcnt(0)" ::: "memory")
#define VM_WAIT() asm volatile("s_waitcnt vmcnt(0)" ::: "memory")
__device__ __forceinline__ unsigned f2bf(float f) { unsigned u = __builtin_bit_cast(unsigned, f); return (u + 0x7fffu + ((u >> 16) & 1u)) >> 16; }
__device__ __forceinline__ unsigned pk2(float lo, float hi) { return f2bf(lo) | (f2bf(hi) << 16); }
__device__ __forceinline__ float bf2f(bf16 v) { return __uint_as_float((unsigned)v << 16); }

#define XB_TMO      128
#define XB_XCNT(j)  (256  + 64 * (j))
#define XB_XSUB(j)  (1280 + 64 * (j))
#define XB_XGEN(j)  (2304 + 64 * (j))
#define XB_TOP      3328
#define XB_TOPGEN   3392
#define XCD_BAR_WORDS 3456
#define XB_SPIN_CAP (1u << 20)
__device__ __forceinline__ unsigned xb_ld(unsigned* p)              { return __hip_atomic_load(p, __ATOMIC_RELAXED, __HIP_MEMORY_SCOPE_AGENT); }
__device__ __forceinline__ unsigned xb_add(unsigned* p, unsigned v) { return __hip_atomic_fetch_add(p, v, __ATOMIC_RELAXED, __HIP_MEMORY_SCOPE_AGENT); }
__device__ __forceinline__ unsigned xb_xcc_id() { return (unsigned)__builtin_amdgcn_s_getreg((3 << 11) | 20) & 0xFu; }
#define XB_SPIN(cond, bar) do { unsigned _sp = 0; while (cond) { __builtin_amdgcn_s_sleep(1); \
    if ((++_sp & 255u) == 0u) { if (xb_ld(&(bar)[XB_TMO])) break; if (_sp > XB_SPIN_CAP) { atomicAdd(&(bar)[XB_TMO], 1u); break; } } } } while (0)
struct XcdBarrier { unsigned* bar; unsigned x; volatile LAS unsigned* st; };
__device__ __forceinline__ XcdBarrier xcd_barrier_post(unsigned* bar, volatile LAS unsigned* st) {
    XcdBarrier b; b.bar = bar; b.x = xb_xcc_id(); b.st = st;
    if (threadIdx.x == 0) (void)xb_add(&bar[XB_XCNT(b.x)], 1u);
    return b;
}
__device__ __forceinline__ void xcd_barrier_complete(unsigned* bar, unsigned x, unsigned& nloc, unsigned& nx) {
    const unsigned G = gridDim.x * gridDim.y * gridDim.z;
    unsigned sum, cnt, mine, sp = 0u;
    for (;;) {
        sum = 0u; cnt = 0u; mine = 0u;
#pragma unroll
        for (unsigned j = 0; j < 16; ++j) { const unsigned c = xb_ld(&bar[XB_XCNT(j)]); sum += c; cnt += (c > 0u) ? 1u : 0u; mine = (j == x) ? c : mine; }
        if (sum == G) break;
        __builtin_amdgcn_s_sleep(1);
        if ((++sp & 255u) == 0u) { if (xb_ld(&bar[XB_TMO])) break; if (sp > XB_SPIN_CAP) { atomicAdd(&bar[XB_TMO], 1u); break; } }
    }
    nloc = mine > 0u ? mine : 1u; nx = cnt > 0u ? cnt : 1u;
}
__device__ __forceinline__ void xcd_barrier(const XcdBarrier& b) {
    asm volatile("s_waitcnt vmcnt(0)" ::: "memory");
    __syncthreads();
    if (threadIdx.x == 0) {
        unsigned* bar = b.bar;
        __builtin_amdgcn_s_waitcnt(0);
        unsigned nloc = b.st[0], nx = b.st[1];
        if (nloc == 0u) { xcd_barrier_complete(bar, b.x, nloc, nx); b.st[0] = nloc; b.st[1] = nx; }
        const unsigned old = xb_add(&bar[XB_XSUB(b.x)], 1u);
        const unsigned gen = old / nloc;
        if (old + 1u == (gen + 1u) * nloc) {
            __builtin_amdgcn_fence(__ATOMIC_RELEASE, "agent");
            asm volatile("s_waitcnt vmcnt(0)" ::: "memory");
            const unsigned og = xb_add(&bar[XB_TOP], 1u);
            const unsigned tg = og / nx;
            if (og + 1u == (tg + 1u) * nx) xb_add(&bar[XB_TOPGEN], 1u);
            else XB_SPIN(xb_ld(&bar[XB_TOPGEN]) == tg, bar);
            __builtin_amdgcn_fence(__ATOMIC_ACQUIRE, "agent");
            asm volatile("s_waitcnt vmcnt(0)" ::: "memory");
        } else {
            XB_SPIN(xb_ld(&bar[XB_TOPGEN]) == gen, bar);
            __builtin_amdgcn_fence(__ATOMIC_ACQUIRE, "agent");
            asm volatile("s_waitcnt vmcnt(0)" ::: "memory");
        }
    }
    __syncthreads();
}

struct Args { const float* in[21]; float* out; unsigned char* ws; int ph_lo, ph_hi, li, pad; };
struct Frame {
    LAS unsigned char* lds;
    volatile LAS unsigned* MISC;
    int tid, lane, wave, vcu, G;
    float* out; unsigned char* ws;
};
#define FIN(i) (args.in[i])
template <int CTRL, int RMASK> __device__ __forceinline__ float dpp_f(float v) { return __builtin_bit_cast(float, __builtin_amdgcn_update_dpp(0, __builtin_bit_cast(int, v), CTRL, RMASK, 0xF, false)); }
__device__ __forceinline__ float wave_sum(float v) {
    v += dpp_f<0xB1, 0xF>(v);
    v += dpp_f<0x4E, 0xF>(v);
    v += dpp_f<0x141, 0xF>(v);
    v += dpp_f<0x140, 0xF>(v);
    v += dpp_f<0x142, 0xA>(v);
    v += dpp_f<0x143, 0xC>(v);
    return __builtin_bit_cast(float, __builtin_amdgcn_readlane(__builtin_bit_cast(int, v), 63));
}
__device__ __forceinline__ float gelu_tanh(float x) {
    const float t = x * fmaf(x * x, -0.10294324f, -2.3022082f);
    return x * __builtin_amdgcn_rcpf(1.0f + __builtin_amdgcn_exp2f(t));
}
__device__ __forceinline__ float sigmoidf_(float x) { return __builtin_amdgcn_rcpf(1.0f + __expf(-x)); }

__device__ __forceinline__ int win_rowmap(int n) {
    if (n >= 2048) return n;
    const int head = n >> 7, d = n & 127, nn = d >> 6, dd = d & 63, wc = dd >> 4, fq = (dd >> 2) & 3, j = dd & 3;
    return head * 128 + 32 * wc + 8 * fq + 4 * nn + j;
}
__device__ __forceinline__ void p0_tr_load(float (&wv)[32], const float* W, int N, int item, int lane) {
    const int nblk = N / 32, kb = item / nblk, nb = item % nblk, k0 = 64 * kb, n0 = 32 * nb;
#pragma unroll
    for (int i = 0; i < 32; ++i) wv[i] = __builtin_nontemporal_load(W + (size_t)(k0 + 2 * i + (lane >> 5)) * N + n0 + (lane & 31));
}
template <bool MAPQ>
__device__ __forceinline__ void p0_tr_finish(const float (&wv)[32], int K, int N, bf16* WT, LAS float* scr, int item, int lane, int kofs = 0) {
    const int nblk = N / 32, kb = item / nblk, nb = item % nblk, k0 = 64 * kb, n0 = 32 * nb;
#pragma unroll
    for (int i = 0; i < 32; ++i) scr[(2 * i + (lane >> 5)) * 33 + (lane & 31)] = wv[i];
    LDS_WAIT(); asm volatile("" ::: "memory");
    const int c = lane & 7;
#pragma unroll
    for (int j = 0; j < 4; ++j) { const int n = (lane >> 3) + 8 * j; const LAS float* s = scr + (8 * c) * 33 + n;
        v4u o; o.x = pk2(s[0 * 33], s[1 * 33]); o.y = pk2(s[2 * 33], s[3 * 33]); o.z = pk2(s[4 * 33], s[5 * 33]); o.w = pk2(s[6 * 33], s[7 * 33]);
        const int drow = MAPQ ? win_rowmap(n0 + n) : (n0 + n);
        *(GAS v4u*)(WT + (size_t)drow * K + kofs + k0 + 8 * c) = o; }
    LDS_WAIT(); asm volatile("" ::: "memory");
}
template <bool MAPQ>
__device__ __forceinline__ void p0_transpose_item(const float* W, int K, int N, bf16* WT, LAS float* scr, int item, int lane, int kofs = 0) {
    float wv[32]; p0_tr_load(wv, W, N, item, lane); p0_tr_finish<MAPQ>(wv, K, N, WT, scr, item, lane, kofs);
}
__device__ __forceinline__ void rms_row_load(f32x4 (&v)[8], const float* xrow, int lane) {
    const GAS f32x4* xr = (const GAS f32x4*)xrow + lane;
#pragma unroll
    for (int j = 0; j < 8; ++j) v[j] = __builtin_nontemporal_load(xr + 64 * j);
}
__device__ __forceinline__ void rms_row_finish(const f32x4 (&v)[8], const float* g, bf16* orow, int lane) {
    const GAS f32x4* gr = (const GAS f32x4*)g + lane; float s = 0.f;
#pragma unroll
    for (int j = 0; j < 8; ++j) s += (v[j].x * v[j].x + v[j].y * v[j].y) + (v[j].z * v[j].z + v[j].w * v[j].w);
    const float rstd = 1.0f / sqrtf(wave_sum(s) * (1.f / DM) + EPSF);
    GAS unsigned long long* o8 = (GAS unsigned long long*)orow + lane;
#pragma unroll
    for (int j = 0; j < 8; ++j) { const f32x4 gg = gr[64 * j];
        o8[64 * j] = (unsigned long long)pk2(v[j].x * rstd * gg.x, v[j].y * rstd * gg.y) | ((unsigned long long)pk2(v[j].z * rstd * gg.z, v[j].w * rstd * gg.w) << 32); }
}
__device__ __forceinline__ void p0_prologue(Frame& F, const Args& args) {
    LAS float* scr = (LAS float*)(F.lds + F.wave * 16384);
    const int gw = F.vcu * NWAVES + F.wave, NGW = F.G * NWAVES;
    constexpr int I_IN = (DM / 64) * (INC / 32), I_PA = (RW / 64) * (DM / 32), I_PB = I_PA, I_OUT = (DM / 64) * (DM / 32), I_GLU = (SW / 64) * (SW / 32);
    constexpr int NITEMS = I_IN + I_PA + I_PB + I_OUT + I_GLU;
    bf16* WinT = (bf16*)(F.ws + WS_WIN); bf16* WgluT = (bf16*)(F.ws + WS_WGLU);
    (void)NITEMS;
    { float wa[32], wb[32]; int it = gw;
      if (it < I_IN) p0_tr_load(wa, args.in[6], INC, it, F.lane);
      for (; it < I_IN; it += NGW) {
          const bool hasn = it + NGW < I_IN;
          if (hasn) p0_tr_load(wb, args.in[6], INC, it + NGW, F.lane);
          p0_tr_finish<true>(wa, DM, INC, WinT, scr, it, F.lane);
          if (hasn) {
#pragma unroll
              for (int i = 0; i < 32; ++i) wa[i] = wb[i]; }
      } }
    for (int it = (NGW % 4 == 0) ? ((gw & 3) == 1 ? gw >> 2 : I_GLU) : gw; it < I_GLU; it += (NGW % 4 == 0) ? NGW / 4 : NGW) p0_transpose_item<false>(args.in[19], SW, SW, WgluT, scr, it, F.lane);
    bf16* H = (bf16*)(F.ws + WS_H);
    { f32x4 ra[8], rb[8]; int m = gw;
#define XROW(mm) ((mm) < MP ? args.in[0] + (size_t)(mm) * DM : args.in[1] + (size_t)((mm) - MP) * DM)
      const bool spread = (NGW == 2048) && (MP % NGW == 0), extra = spread && (gw % 16 == 0);
      int mnext = extra ? gw : gw + NGW; const int mend = spread ? MP : MV;
      if (extra) m = MP + gw / 16;
      if (m < MV) {
        rms_row_load(ra, XROW(m), F.lane);
        for (;; m = mnext, mnext += NGW) {
          const bool hasn = mnext < mend;
          if (hasn) rms_row_load(rb, XROW(mnext), F.lane);
          rms_row_finish(ra, args.in[5], H + (size_t)m * DM, F.lane);
          if (!hasn) break;
#pragma unroll
          for (int j = 0; j < 8; ++j) ra[j] = rb[j];
        } }
#undef XROW
    }
    for (int m = (NGW % 16 == 0) ? ((gw & 15) == 8 ? MV + (gw >> 4) : MPAD) : MV + gw; m < MPAD; m += (NGW % 16 == 0) ? NGW / 16 : NGW) { GAS unsigned long long* o8 = (GAS unsigned long long*)(H + (size_t)m * DM) + F.lane;
#pragma unroll
        for (int j = 0; j < 8; ++j) o8[64 * j] = 0ull; }
    const int gt = F.vcu * NTHR + F.tid, NGT = F.G * NTHR;
    float* tcos = (float*)(F.ws + WS_TAB + TB_COS); float* tsin = (float*)(F.ws + WS_TAB + TB_SIN);
    for (int i = gt; i < 2049 * 64; i += NGT) {
        const int pi = i >> 6, d = i & 63; const double pos = (pi == 2048) ? (double)POS_S : (double)pi;
        const double inv = exp((double)d * (-9.210340371976184 / 64.0)), ang = pos * inv;
        const double red = ang - 6.283185307179586476925 * rint(ang * 0.15915494309189533577);
        float sn, cs; sincosf((float)red, &sn, &cs);
        const int ti = ((d >> 2) * 2049 + pi) * 4 + (d & 3);
        tcos[ti] = cs; tsin[ti] = sn;
    }
    float* tar = (float*)(F.ws + WS_TAB + TB_AR); float* tai = (float*)(F.ws + WS_TAB + TB_AI);
    float* tbr = (float*)(F.ws + WS_TAB + TB_BR); float* tbi = (float*)(F.ws + WS_TAB + TB_BI);
    for (int i = (F.tid < 16 ? F.vcu * 16 + F.tid : SG * SP); i < SG * SP; i += F.G * 16) {
        const int g = i >> 6;
        const double lr = (double)args.in[11][i], li = (double)args.in[12][i], dt = exp((double)args.in[13][g]);
        const double ang = li * dt, red = ang - 6.283185307179586476925 * rint(ang * 0.15915494309189533577);
        float sn, cs; sincosf((float)red, &sn, &cs);
        const double mag = exp(lr * dt), ar = mag * (double)cs, ai = mag * (double)sn;
        const double nr = ar - 1.0, ni = ai, den = lr * lr + li * li;
        const double cr = (nr * lr + ni * li) / den, ci = (ni * lr - nr * li) / den;
        tar[i] = (float)ar; tai[i] = (float)ai;
        for (int n = 0; n < SN; ++n) { const double br = (double)args.in[14][i * SN + n], bi = (double)args.in[15][i * SN + n];
            tbr[i * SN + n] = (float)(cr * br - ci * bi); tbi[i * SN + n] = (float)(cr * bi + ci * br); }
    }
}

__device__ __forceinline__ void p1_convert_rest(Frame& F, const Args& args, int idx, int nidle) {
    LAS float* scr = (LAS float*)(F.lds + F.wave * 16384);
    constexpr int I_PA = (RW / 64) * (DM / 32), I_PB = I_PA, I_OUT = (DM / 64) * (DM / 32);
    bf16* WpT = (bf16*)(F.ws + WS_WPA); bf16* WoutT = (bf16*)(F.ws + WS_WOUT);
    for (int it = idx * NWAVES + F.wave; it < I_PA + I_PB + I_OUT; it += nidle * NWAVES) {
        int r = it;
        if (r < I_PA) { p0_transpose_item<false>(args.in[7], 2 * RW, DM, WpT, scr, r, F.lane, 0); continue; } r -= I_PA;
        if (r < I_PB) { p0_transpose_item<false>(args.in[8], 2 * RW, DM, WpT, scr, r, F.lane, RW); continue; } r -= I_PB;
        p0_transpose_item<false>(args.in[9], DM, DM, WoutT, scr, r, F.lane);
    }
}
using pg8::Unit; using pg8::cvt_pk_bf16; using pg8::bf_lo; using pg8::bf_hi;
struct EpiProj {
    static constexpr bool MIDHOOK = false, AFTER_DRAIN = false, PERM = true;
    bf16 *Q, *K, *V, *ZA, *UB, *ZB, *GA, *GB; const float* tcos; const float* tsin; float* PS;
    __device__ __forceinline__ void operator()(const f32x4 (&acc)[2][2][4][2], const Unit& u, int wr, int wc, int fr, int fq) const {
        asm volatile("" : "+v"(fr), "+v"(fq));
        const int row0 = u.pm * 256 + wr * 64 + fr;
        const int seg = u.pn >> 2;
        if (u.z) {
            float* slab = PS + (size_t)(u.z - 1) * PS_SLAB + (size_t)(wr * 64 + fr) * INC + u.pn * 256 + wc * 32 + 8 * fq;
#pragma unroll
            for (int m = 0; m < 4; ++m)
#pragma unroll
                for (int bj = 0; bj < 2; ++bj) { *(f32x4*)(slab + (size_t)m * 16 * INC + bj * 128) = acc[0][bj][m][0]; *(f32x4*)(slab + (size_t)m * 16 * INC + bj * 128 + 4) = acc[0][bj][m][1]; }
            return;
        }
        if (seg < 2) {
            bf16* base = seg == 0 ? Q : K;
            const int head0 = (u.pn & 3) * 2, d0 = 16 * wc + 4 * fq;
            float lgh[2];
#pragma unroll
            for (int bj = 0; bj < 2; ++bj) lgh[bj] = seg == 0 ? 0.f : log2f(1.0f - exp2f(-5.0f - (float)(head0 + bj)));
            f32x4 csq[2][4], snq[2][4];
#pragma unroll
            for (int ai = 0; ai < 2; ++ai)
#pragma unroll
                for (int m = 0; m < 4; ++m) { const int row = row0 + ai * 128 + m * 16; const int pi = row < MP ? (row & (SEQ - 1)) : 2048;
                    csq[ai][m] = *(const f32x4*)(tcos + ((d0 >> 2) * 2049 + pi) * 4); snq[ai][m] = *(const f32x4*)(tsin + ((d0 >> 2) * 2049 + pi) * 4); }
#pragma unroll
            for (int ai = 0; ai < 2; ++ai)
#pragma unroll
                for (int m = 0; m < 4; ++m) {
                    const int row = row0 + ai * 128 + m * 16;
                    const float sl1 = row < MP ? (float)((row & 127) + 1) : 1.0f;
                    const f32x4 cs = csq[ai][m], sn = snq[ai][m];
#pragma unroll
                    for (int bj = 0; bj < 2; ++bj) {
                        const float sc = seg == 0 ? 1.0f : 0.08838834764831845f * exp2f(-sl1 * lgh[bj]);
                        const f32x4 x1 = acc[ai][bj][m][0], x2 = acc[ai][bj][m][1];
                        const f32x4 o1 = (x1 * cs - x2 * sn) * sc, o2 = (x1 * sn + x2 * cs) * sc;
                        bf16* p = base + (size_t)row * RW + (head0 + bj) * 128 + d0;
                        v2u w1, w2; w1.x = cvt_pk_bf16(o1[0], o1[1]); w1.y = cvt_pk_bf16(o1[2], o1[3]); w2.x = cvt_pk_bf16(o2[0], o2[1]); w2.y = cvt_pk_bf16(o2[2], o2[3]);
                        *(v2u*)p = w1; *(v2u*)(p + 64) = w2;
                    }
                }
        } else {
            const int sb = seg < 6 ? seg : (seg & ~1);
            bf16* base = (bf16*)((unsigned char*)Q + (size_t)sb * ACT1);
            const int ldc = seg < 6 ? 1024 : 2048, colt = (u.pn - 4 * sb) * 256;
            const int act = seg >= 6 ? 2 : ((seg == 3 || seg == 5) ? 1 : 0);
            const int col0 = colt + wc * 32 + 8 * fq;
            if (seg >= 6) {
                unsigned char* gt = (unsigned char*)Q + (WS_G8A - WS_Q) + (seg >= 8 ? (WS_G8B - WS_G8A) : 0) + (size_t)(u.pm * 8 + ((u.pn - 24) & 7)) * 65536 + (size_t)(((wr * 4 + wc) * 64) + fq * 16 + fr) * 8;
#pragma unroll
                for (int ai = 0; ai < 2; ++ai)
#pragma unroll
                    for (int m = 0; m < 4; ++m)
#pragma unroll
                        for (int bj = 0; bj < 2; ++bj) { const f32x4 v0 = acc[ai][bj][m][0], v1 = acc[ai][bj][m][1]; unsigned q[8];
#pragma unroll
                            for (int e = 0; e < 4; ++e) { q[e] = (unsigned)(sigmoidf_(v0[e]) * 255.0f + 0.5f); q[4 + e] = (unsigned)(sigmoidf_(v1[e]) * 255.0f + 0.5f); }
                            v2u w; w.x = q[0] | (q[1] << 8) | (q[2] << 16) | (q[3] << 24); w.y = q[4] | (q[5] << 8) | (q[6] << 16) | (q[7] << 24);
                            *(v2u*)(gt + (size_t)((ai * 4 + m) * 2 + bj) * 4096) = w; }
                return;
            }
#pragma unroll
            for (int ai = 0; ai < 2; ++ai)
#pragma unroll
                for (int m = 0; m < 4; ++m) { bf16* rowp = base + (size_t)(row0 + ai * 128 + m * 16) * ldc + col0;
#pragma unroll
                    for (int bj = 0; bj < 2; ++bj) { f32x4 v0 = acc[ai][bj][m][0], v1 = acc[ai][bj][m][1];
                        if (act != 0) {
#pragma unroll
                            for (int e = 0; e < 4; ++e) { const float s0 = sigmoidf_(v0[e]), s1 = sigmoidf_(v1[e]); v0[e] = act == 1 ? v0[e] * s0 : s0; v1[e] = act == 1 ? v1[e] * s1 : s1; }
                        }
                        v4u w; w.x = cvt_pk_bf16(v0[0], v0[1]); w.y = cvt_pk_bf16(v0[2], v0[3]); w.z = cvt_pk_bf16(v1[0], v1[1]); w.w = cvt_pk_bf16(v1[2], v1[3]);
                        if (seg == 4) {
                            const int col = col0 + bj * 128, g = col >> 4, half = (col >> 3) & 1;
                            *(v4u*)(base + ((size_t)g * MPAD + (row0 + ai * 128 + m * 16)) * 16 + 8 * half) = w;
                        } else if (seg == 5) {
                            *(v4u*)((unsigned char*)base + (size_t)(u.pm * 4 + (u.pn - 20)) * 131072 + (size_t)((ai * 4 + m) * 2 + bj) * 8192 + (size_t)(((wr * 4 + wc) * 64) + fq * 16 + fr) * 16) = w;
                        } else *(v4u*)(rowp + bj * 128) = w; } }
        }
    }
};
struct EpiGlu {
    static constexpr bool MIDHOOK = false, AFTER_DRAIN = true, PERM = true;
    const bf16* Y; const bf16* ZB; bf16* AB; const float* bias;
    __device__ __forceinline__ void operator()(const f32x4 (&acc)[2][2][4][2], const Unit& u, int wr, int wc, int fr, int fq) const {
        const int row0 = u.pm * 256 + wr * 64 + fr, col0 = u.pn * 256 + wc * 32 + 8 * fq;
        f32x4 bq[2][2];
#pragma unroll
        for (int bj = 0; bj < 2; ++bj) { bq[bj][0] = *(const f32x4*)(bias + col0 + bj * 128); bq[bj][1] = *(const f32x4*)(bias + col0 + bj * 128 + 4); }
#pragma unroll
        for (int ai = 0; ai < 2; ++ai) {
            v4u yq[4][2], zq[4][2];
#pragma unroll
            for (int m = 0; m < 4; ++m)
#pragma unroll
                for (int bj = 0; bj < 2; ++bj) { const size_t off = (size_t)(row0 + ai * 128 + m * 16) * SW + col0 + bj * 128; yq[m][bj] = *(const v4u*)(Y + off);
                    zq[m][bj] = *(const v4u*)((const unsigned char*)ZB + (size_t)(u.pm * 4 + u.pn) * 131072 + (size_t)((ai * 4 + m) * 2 + bj) * 8192 + (size_t)(((wr * 4 + wc) * 64) + fq * 16 + fr) * 16); }
#pragma unroll
            for (int m = 0; m < 4; ++m)
#pragma unroll
                for (int bj = 0; bj < 2; ++bj) { const size_t off = (size_t)(row0 + ai * 128 + m * 16) * SW + col0 + bj * 128;
                    const v4u yv = yq[m][bj], zv = zq[m][bj];
                    const f32x4 g0 = acc[ai][bj][m][0] + bq[bj][0], g1 = acc[ai][bj][m][1] + bq[bj][1];
                    float o[8];
                    o[0] = bf_lo(yv.x) * sigmoidf_(g0[0]) * bf_lo(zv.x); o[1] = bf_hi(yv.x) * sigmoidf_(g0[1]) * bf_hi(zv.x);
                    o[2] = bf_lo(yv.y) * sigmoidf_(g0[2]) * bf_lo(zv.y); o[3] = bf_hi(yv.y) * sigmoidf_(g0[3]) * bf_hi(zv.y);
                    o[4] = bf_lo(yv.z) * sigmoidf_(g1[0]) * bf_lo(zv.z); o[5] = bf_hi(yv.z) * sigmoidf_(g1[1]) * bf_hi(zv.z);
                    o[6] = bf_lo(yv.w) * sigmoidf_(g1[2]) * bf_lo(zv.w); o[7] = bf_hi(yv.w) * sigmoidf_(g1[3]) * bf_hi(zv.w);
                    v4u w; w.x = cvt_pk_bf16(o[0], o[1]); w.y = cvt_pk_bf16(o[2], o[3]); w.z = cvt_pk_bf16(o[4], o[5]); w.w = cvt_pk_bf16(o[6], o[7]);
                    *(v4u*)(AB + (size_t)(row0 + ai * 128 + m * 16) * (2 * SW) + SW + col0 + bj * 128) = w; }
        }
    }
    __device__ __forceinline__ void fused(const f32x4 (&acc)[2][2][4][2], const Unit& u, int wr, int wc, int fr, int fq, PG8_LAS unsigned char* lds, int wid, int lane) const {
        asm volatile("" : "+v"(fr), "+v"(fq), "+v"(lane));
        { const bf16* ybase = Y + (size_t)(u.pm * 256) * SW + u.pn * 256;
#pragma unroll
          for (int i = 0; i < 16; ++i) { const int q = wid * 16 + i, R = 2 * q + (lane >> 5), p = lane & 31;
              __builtin_amdgcn_global_load_lds((const unsigned*)(ybase + (size_t)R * SW + 8 * (p ^ (R & 15))), (PG8_LAS unsigned*)(lds + 1024 * q), 16, 0, 0); } }
        const int row0 = u.pm * 256 + wr * 64 + fr, col0 = u.pn * 256 + wc * 32 + 8 * fq;
        f32x4 bq[2][2];
#pragma unroll
        for (int bj = 0; bj < 2; ++bj) { bq[bj][0] = *(const f32x4*)(bias + col0 + bj * 128); bq[bj][1] = *(const f32x4*)(bias + col0 + bj * 128 + 4); }
        v4u zq[2][4][2];
        { const unsigned char* zt = (const unsigned char*)ZB + (size_t)(u.pm * 4 + u.pn) * 131072 + (size_t)(((wr * 4 + wc) * 64) + fq * 16 + fr) * 16;
#pragma unroll
          for (int ai = 0; ai < 2; ++ai)
#pragma unroll
            for (int m = 0; m < 4; ++m)
#pragma unroll
                for (int bj = 0; bj < 2; ++bj) zq[ai][m][bj] = *(const v4u*)(zt + (size_t)((ai * 4 + m) * 2 + bj) * 8192); }
        asm volatile("s_waitcnt vmcnt(0)" ::: "memory"); __syncthreads();
#pragma unroll
        for (int ai = 0; ai < 2; ++ai)
#pragma unroll
            for (int m = 0; m < 4; ++m)
#pragma unroll
                for (int bj = 0; bj < 2; ++bj) { const int R = wr * 64 + ai * 128 + m * 16 + fr, c = wc * 4 + bj * 16 + fq;
                    const v4u yv = *(const PG8_LAS v4u*)(lds + 512 * R + 16 * (c ^ (R & 15))), zv = zq[ai][m][bj];
                    const f32x4 g0 = acc[ai][bj][m][0] + bq[bj][0], g1 = acc[ai][bj][m][1] + bq[bj][1];
                    float o[8];
                    o[0] = bf_lo(yv.x) * sigmoidf_(g0[0]) * bf_lo(zv.x); o[1] = bf_hi(yv.x) * sigmoidf_(g0[1]) * bf_hi(zv.x);
                    o[2] = bf_lo(yv.y) * sigmoidf_(g0[2]) * bf_lo(zv.y); o[3] = bf_hi(yv.y) * sigmoidf_(g0[3]) * bf_hi(zv.y);
                    o[4] = bf_lo(yv.z) * sigmoidf_(g1[0]) * bf_lo(zv.z); o[5] = bf_hi(yv.z) * sigmoidf_(g1[1]) * bf_hi(zv.z);
                    o[6] = bf_lo(yv.w) * sigmoidf_(g1[2]) * bf_lo(zv.w); o[7] = bf_hi(yv.w) * sigmoidf_(g1[3]) * bf_hi(zv.w);
                    v4u w; w.x = cvt_pk_bf16(o[0], o[1]); w.y = cvt_pk_bf16(o[2], o[3]); w.z = cvt_pk_bf16(o[4], o[5]); w.w = cvt_pk_bf16(o[6], o[7]);
                    *(v4u*)(AB + (size_t)(row0 + ai * 128 + m * 16) * (2 * SW) + SW + col0 + bj * 128) = w; }
        asm volatile("s_waitcnt lgkmcnt(0)" ::: "memory"); __syncthreads();
    }
};
struct EpiMerge {
    static constexpr bool MIDHOOK = true, AFTER_DRAIN = false, PERM = true;
    const unsigned char* G8A; const unsigned char* G8B; bf16* MRG;
    __device__ __forceinline__ void mid(f32x4 (&acc)[2][2][4][2], const Unit& u, int wr, int wc, int fr, int fq) const {
        asm volatile("" : "+v"(fr), "+v"(fq));
        const size_t toff = (size_t)(u.pm * 8 + u.pn) * 65536 + (size_t)(((wr * 4 + wc) * 64) + fq * 16 + fr) * 8;
#pragma unroll
        for (int ai = 0; ai < 2; ++ai) {
            v2u ga[4][2], gb[4][2];
#pragma unroll
            for (int m = 0; m < 4; ++m)
#pragma unroll
                for (int bj = 0; bj < 2; ++bj) { ga[m][bj] = *(const v2u*)(G8A + toff + (size_t)((ai * 4 + m) * 2 + bj) * 4096); gb[m][bj] = *(const v2u*)(G8B + toff + (size_t)((ai * 4 + m) * 2 + bj) * 4096); }
#pragma unroll
            for (int m = 0; m < 4; ++m)
#pragma unroll
                for (int bj = 0; bj < 2; ++bj)
#pragma unroll
                    for (int e = 0; e < 4; ++e) {
                        const unsigned a0 = (ga[m][bj].x >> (8 * e)) & 255u, a1 = (ga[m][bj].y >> (8 * e)) & 255u, b0 = (gb[m][bj].x >> (8 * e)) & 255u, b1 = (gb[m][bj].y >> (8 * e)) & 255u;
                        acc[ai][bj][m][0][e] *= (float)a0 * __builtin_amdgcn_rcpf((float)(b0 ? b0 : 1u));
                        acc[ai][bj][m][1][e] *= (float)a1 * __builtin_amdgcn_rcpf((float)(b1 ? b1 : 1u)); }
        }
    }
    __device__ __forceinline__ void operator()(const f32x4 (&acc)[2][2][4][2], const Unit& u, int wr, int wc, int fr, int fq) const {
        asm volatile("" : "+v"(fr), "+v"(fq));
        const int row0 = u.pm * 256 + wr * 64 + fr, col0 = u.pn * 256 + wc * 32 + 8 * fq;
        const size_t toff = (size_t)(u.pm * 8 + u.pn) * 65536 + (size_t)(((wr * 4 + wc) * 64) + fq * 16 + fr) * 8;
        v2u gb[2][4][2];
#pragma unroll
        for (int ai = 0; ai < 2; ++ai)
#pragma unroll
            for (int m = 0; m < 4; ++m)
#pragma unroll
                for (int bj = 0; bj < 2; ++bj) gb[ai][m][bj] = *(const v2u*)(G8B + toff + (size_t)((ai * 4 + m) * 2 + bj) * 4096);
        const float k255 = 1.0f / 255.0f;
#pragma unroll
        for (int ai = 0; ai < 2; ++ai)
#pragma unroll
            for (int m = 0; m < 4; ++m)
#pragma unroll
                for (int bj = 0; bj < 2; ++bj) { float o[8];
#pragma unroll
                    for (int e = 0; e < 4; ++e) { const unsigned b0 = (gb[ai][m][bj].x >> (8 * e)) & 255u, b1 = (gb[ai][m][bj].y >> (8 * e)) & 255u;
                        o[e] = acc[ai][bj][m][0][e] * ((float)(b0 ? b0 : 1u) * k255); o[4 + e] = acc[ai][bj][m][1][e] * ((float)(b1 ? b1 : 1u) * k255); }
                    v4u w; w.x = cvt_pk_bf16(o[0], o[1]); w.y = cvt_pk_bf16(o[2], o[3]); w.z = cvt_pk_bf16(o[4], o[5]); w.w = cvt_pk_bf16(o[6], o[7]);
                    *(v4u*)(MRG + (size_t)(row0 + ai * 128 + m * 16) * DM + col0 + bj * 128) = w; }
    }
};
struct EpiOutBf16 {
    static constexpr bool MIDHOOK = false, AFTER_DRAIN = false, PERM = true;
    bf16* C; int ldc;
    __device__ __forceinline__ void operator()(const f32x4 (&acc)[2][2][4][2], const Unit& u, int wr, int wc, int fr, int fq) const {
        const int row0 = u.pm * 256 + wr * 64 + fr, col0 = u.pn * 256 + wc * 32 + 8 * fq;
#pragma unroll
        for (int ai = 0; ai < 2; ++ai)
#pragma unroll
            for (int m = 0; m < 4; ++m) { bf16* rowp = C + (size_t)(row0 + ai * 128 + m * 16) * ldc + col0;
#pragma unroll
                for (int bj = 0; bj < 2; ++bj) { const f32x4 v0 = acc[ai][bj][m][0], v1 = acc[ai][bj][m][1];
                    v4u w; w.x = cvt_pk_bf16(v0[0], v0[1]); w.y = cvt_pk_bf16(v0[2], v0[3]); w.z = cvt_pk_bf16(v1[0], v1[1]); w.w = cvt_pk_bf16(v1[2], v1[3]);
                    *(v4u*)(rowp + bj * 128) = w; } }
    }
};

typedef float f32x16 __attribute__((ext_vector_type(16)));
typedef float f32x2v __attribute__((ext_vector_type(2)));
typedef short bf16x8 __attribute__((ext_vector_type(8)));
typedef short s16x4 __attribute__((ext_vector_type(4)));
typedef __bf16 bf16x2_t __attribute__((ext_vector_type(2)));
#define MFMA32(a, b, c) __builtin_amdgcn_mfma_f32_32x32x16_bf16((a), (b), (c), 0, 0, 0)
#define MFMA16(a, b, c) __builtin_amdgcn_mfma_f32_16x16x32_bf16((a), (b), (c), 0, 0, 0)
__device__ __forceinline__ unsigned cvtpk(float lo, float hi) { f32x2v v = {lo, hi}; bf16x2_t b = __builtin_convertvector(v, bf16x2_t); return __builtin_bit_cast(unsigned, b); }
__device__ __forceinline__ v2u pk4(const f32x4 v) { v2u w; w.x = cvtpk(v[0], v[1]); w.y = cvtpk(v[2], v[3]); return w; }
__device__ __forceinline__ s16x4 lds_tr(LAS unsigned char* p) { return __builtin_bit_cast(s16x4, __builtin_amdgcn_ds_read_tr16_b64_v4i16((LAS s16x4*)p)); }
__device__ __forceinline__ bf16x8 cat8(s16x4 lo, s16x4 hi) { return (bf16x8){lo[0], lo[1], lo[2], lo[3], hi[0], hi[1], hi[2], hi[3]}; }
__device__ __forceinline__ bf16x8 pack8(const f32x16& x, int s) {
    v4u p; p.x = cvtpk(x[8 * s], x[8 * s + 1]); p.y = cvtpk(x[8 * s + 2], x[8 * s + 3]); p.z = cvtpk(x[8 * s + 4], x[8 * s + 5]); p.w = cvtpk(x[8 * s + 6], x[8 * s + 7]);
    return __builtin_bit_cast(bf16x8, p);
}
__device__ __forceinline__ void glds16(const void* g, LAS unsigned char* l) { __builtin_amdgcn_global_load_lds((const unsigned*)g, (LAS unsigned*)l, 16, 0, 0); }
__device__ __forceinline__ void glds16_asm(const void* gsrc, unsigned lds_dst) { unsigned keep;
    asm volatile("s_mov_b32 %0, m0\n\ts_mov_b32 m0, %2\n\ts_nop 0\n\tglobal_load_lds_dwordx4 %1, off\n\ts_mov_b32 m0, %0" : "=&s"(keep) : "v"(gsrc), "s"(lds_dst) : "memory"); }
__device__ __forceinline__ unsigned swz16(unsigned row) { return ((row & 3u) << 2) | ((row >> 2) & 3u); }
__device__ __forceinline__ unsigned off_b(unsigned row, unsigned ch) { return 256u * row + 16u * (ch ^ swz16(row)); }

__device__ __forceinline__ int launder(int x) { asm volatile("" : "+v"(x)); return x; }
constexpr int RT_STAT = RING_BYTES + 1024;
__device__ __forceinline__ void ret_stage(LAS unsigned char* buf, const bf16* KSg, const bf16* Vg, size_t tok0, int hcol, int wave, int lane) {
#pragma unroll
    for (int i = 0; i < 2; ++i) {
        const unsigned slot = (unsigned)(wave * 64 + lane + 512 * i), row = slot >> 4, cp = slot & 15u, ch = cp ^ swz16(row);
        const size_t go = (tok0 + row) * RW + hcol + ch * 8;
        const unsigned dst = (unsigned)(size_t)buf + (unsigned)((wave * 64 + 512 * i) * 16);
        glds16_asm(KSg + go, (unsigned)__builtin_amdgcn_readfirstlane((int)dst));
        glds16_asm(Vg + go, (unsigned)__builtin_amdgcn_readfirstlane((int)(dst + 16384u)));
    }
}
template <bool KROW> __device__ __forceinline__ unsigned tr_base(int lane, unsigned c, unsigned t) {
    const unsigned h = lane >> 5, blk = (lane >> 4) & 1, q = (lane & 15) >> 2, p = lane & 3;
    const unsigned rowl = KROW ? (8 * t + 4 * h + q) : (8 * h + 4 * t + q), sw = (q << 2) | (KROW ? (2 * t + h) : (2 * h + t));
    return 256u * rowl + 16u * ((4 * c + 2 * blk + (p >> 1)) ^ sw) + 8u * (p & 1);
}
__device__ __forceinline__ void ret_state_update(f32x16 (&accS)[2], LAS unsigned char* buf, const unsigned (&ba)[2], const unsigned (&bb)[2][2]) {
#pragma unroll
    for (int ks = 0; ks < 4; ++ks) {
        const bf16x8 A = cat8(lds_tr(buf + ba[0] + 4096 * ks), lds_tr(buf + ba[1] + 4096 * ks));
#pragma unroll
        for (int e2 = 0; e2 < 2; ++e2) {
            const bf16x8 B = cat8(lds_tr(buf + 16384 + bb[e2][0] + 4096 * ks), lds_tr(buf + 16384 + bb[e2][1] + 4096 * ks));
            accS[e2] = MFMA32(A, B, accS[e2]); }
    }
}
__device__ __forceinline__ void ret_prime(LAS unsigned char* lds, const bf16* Qg, const bf16* ZAg, const bf16* KSg, const bf16* Vg, size_t tokb, int j, size_t toks, int hcol, int wave, int lane) {
    ret_stage(lds + 2 * 32768, Qg, Qg + 64 * (size_t)RW, tokb + 128 * (size_t)j, hcol, wave, lane);
    ret_stage(lds + 3 * 32768, ZAg, ZAg + 64 * (size_t)RW, tokb + 128 * (size_t)j, hcol, wave, lane);
    ret_stage(lds, KSg, Vg, toks, hcol, wave, lane);
    ret_stage(lds + 32768, KSg, Vg, toks + 64, hcol, wave, lane);
}
__device__ __forceinline__ void ret_prime3(LAS unsigned char* lds, const bf16* Qg, const bf16* ZAg, const bf16* KSg, const bf16* Vg, size_t tokb, int j, size_t toks, int hcol, int wave, int lane) {
    ret_stage(lds + 2 * 32768, Qg, Qg + 64 * (size_t)RW, tokb + 128 * (size_t)j, hcol, wave, lane);
    ret_stage(lds + 3 * 32768, ZAg, ZAg + 64 * (size_t)RW, tokb + 128 * (size_t)j, hcol, wave, lane);
    ret_stage(lds, KSg, Vg, toks, hcol, wave, lane);
}
__device__ __forceinline__ void ret_unit(Frame& F, int b, int hd, int j, bool primed, int nj, int n0, int nn0, bool fold, f32x16 (&accS)[2]) {
    LAS unsigned char* lds = F.lds;
    const bf16* Qg = (const bf16*)(F.ws + WS_Q); const bf16* KSg = (const bf16*)(F.ws + WS_K); const bf16* Vg = (const bf16*)(F.ws + WS_V);
    const int w = F.wave; int lane = launder(F.lane); int h = lane >> 5, r = lane & 31;
    const int hi2 = w >> 1, eh = w & 1;
    const float lg2 = log2f(1.0f - exp2f(-5.0f - (float)hd)), g128 = exp2f(128.0f * lg2);
    const size_t tokb = (size_t)b * SEQ; const int hcol = hd * DK;
    f32x16 accO[2];
    const size_t toks = tokb + 64 * (size_t)n0;
#pragma unroll
    for (int i = 0; i < 16; ++i) { accO[0][i] = 0.f; accO[1][i] = 0.f; }
    if (n0 == 0) {
#pragma unroll
        for (int i = 0; i < 16; ++i) { accS[0][i] = 0.f; accS[1][i] = 0.f; } }
    bf16x8 qf[8]; v2u zq[2][4];
    unsigned ba[2], bb[2][2];
#pragma unroll
    for (int t = 0; t < 2; ++t) { ba[t] = tr_base<false>(lane, hi2, t); bb[0][t] = tr_base<false>(lane, 2 * eh, t); bb[1][t] = tr_base<false>(lane, 2 * eh + 1, t); }
    const int nprev = 2 * j - n0, NS = nprev + 2;
#define RT_SLOT(n) (lds + (((n) & 3) << 15))
    if (!primed) ret_prime(lds, Qg, (const bf16*)(F.ws + WS_ZA), KSg, Vg, tokb, j, toks, hcol, w, lane);
    asm volatile("s_waitcnt vmcnt(8)" ::: "memory");
    __builtin_amdgcn_s_barrier(); asm volatile("" ::: "memory");
    { const unsigned sw = swz16((unsigned)r), rx = 32u * (sw >> 1), c0 = 16u * (sw & 1), c1 = 16u * ((sw & 1) ^ 1);
      LAS unsigned char* qrow = lds + 2 * 32768 + 256u * (32 * hi2 + r) + 8u * h;
#pragma unroll
      for (int ks = 0; ks < 8; ++ks) { const unsigned ax = (32u * ks) ^ rx; const v2u lo = *(const LAS v2u*)(qrow + ax + c0), hi = *(const LAS v2u*)(qrow + ax + c1);
          v4u t; t.x = lo.x; t.y = lo.y; t.z = hi.x; t.w = hi.y; qf[ks] = __builtin_bit_cast(bf16x8, t); }
      LAS unsigned char* zrow = lds + 3 * 32768 + 256u * (32 * hi2 + r) + 8u * h;
#pragma unroll
      for (int e2 = 0; e2 < 2; ++e2)
#pragma unroll
        for (int g4 = 0; g4 < 4; ++g4) zq[e2][g4] = *(const LAS v2u*)(zrow + 16u * ((unsigned)(4 * (2 * eh + e2) + g4) ^ sw)); }
    LDS_WAIT();
    __builtin_amdgcn_s_barrier(); asm volatile("" ::: "memory");
    if (NS > 2) ret_stage(RT_SLOT(2), KSg, Vg, toks + 128, hcol, w, lane);
    if (NS > 2) asm volatile("s_waitcnt vmcnt(8)" ::: "memory"); else asm volatile("s_waitcnt vmcnt(0)" ::: "memory");
    __builtin_amdgcn_s_barrier(); asm volatile("" ::: "memory");
    for (int n = 0; n < nprev; ++n) {
        const bool more = n + 3 < NS;
        if (more) ret_stage(RT_SLOT(n + 3), KSg, Vg, toks + 64 * (size_t)(n + 3), hcol, w, lane);
        ret_state_update(accS, RT_SLOT(n), ba, bb);
        if (n & 1) { accS[0] = accS[0] * g128; accS[1] = accS[1] * g128; }
        if (more) asm volatile("s_waitcnt vmcnt(8) lgkmcnt(0)" ::: "memory"); else asm volatile("s_waitcnt vmcnt(0) lgkmcnt(0)" ::: "memory");
        __builtin_amdgcn_s_barrier(); asm volatile("" ::: "memory");
    }
    LAS unsigned char* sx = RT_SLOT(nprev + 2);
    lane = launder(F.lane); h = lane >> 5; r = lane & 31;
#pragma unroll
    for (int e2 = 0; e2 < 2; ++e2)
#pragma unroll
        for (int s = 0; s < 2; ++s) *(LAS bf16x8*)(sx + ((hi2 * 4 + 2 * eh + e2) * 2 + s) * 1024 + lane * 16) = pack8(accS[e2], s);
    LDS_WAIT(); __syncthreads();
    const int tt = hi2;
    unsigned rrow, rx, rc[2];
    { const unsigned sw = swz16((unsigned)r); rrow = 256u * r + 8u * h; rx = 32u * (sw >> 1); rc[0] = 16u * (sw & 1); rc[1] = 16u * ((sw & 1) ^ 1); }
    unsigned bv[2][2];
#pragma unroll
    for (int t = 0; t < 2; ++t) { bv[0][t] = tr_base<true>(lane, 2 * eh, t); bv[1][t] = tr_base<true>(lane, 2 * eh + 1, t); }
#pragma unroll
    for (int sg = 0; sg < 2; ++sg) {
        const int n = nprev + sg;
        LAS unsigned char* buf = RT_SLOT(n);
#pragma unroll
        for (int st2 = 0; st2 < 2; ++st2) {
            const int st = 2 * sg + st2;
            if (st <= tt) {
                const unsigned rb = 32 * st2;
                f32x16 X;
#pragma unroll
                for (int i = 0; i < 16; ++i) X[i] = 0.f;
#pragma unroll
                for (int ks = 0; ks < 8; ++ks) {
                    const unsigned ax = rrow + ((32u * ks) ^ rx) + 256u * rb;
                    const v2u lo = *(const LAS v2u*)(buf + ax + rc[0]), hi = *(const LAS v2u*)(buf + ax + rc[1]);
                    v4u t; t.x = lo.x; t.y = lo.y; t.z = hi.x; t.w = hi.y;
                    X = MFMA32(__builtin_bit_cast(bf16x8, t), qf[ks], X);
                }
                if (st == tt) {
#pragma unroll
                    for (int i = 0; i < 16; ++i) { const int srow = (i & 3) + 8 * (i >> 2) + 4 * h; X[i] = srow > r ? 0.f : X[i]; }
                }
#pragma unroll
                for (int s = 0; s < 2; ++s) {
                    const bf16x8 xb = pack8(X, s);
#pragma unroll
                    for (int e2 = 0; e2 < 2; ++e2) {
                        const bf16x8 A = cat8(lds_tr(buf + 16384 + bv[e2][0] + 256 * (rb + 16 * s)), lds_tr(buf + 16384 + bv[e2][1] + 256 * (rb + 16 * s)));
                        accO[e2] = MFMA32(A, xb, accO[e2]); }
                }
            }
        }
        if (sg == 0) {
#pragma unroll
            for (int e2 = 0; e2 < 2; ++e2)
#pragma unroll
                for (int dt = 0; dt < 4; ++dt)
#pragma unroll
                    for (int s = 0; s < 2; ++s) {
                        const bf16x8 A = *(const LAS bf16x8*)(sx + ((dt * 4 + 2 * eh + e2) * 2 + s) * 1024 + lane * 16);
                        accO[e2] = MFMA32(A, qf[2 * dt + s], accO[e2]); }
        }
        if (j == 15 || fold) ret_state_update(accS, buf, ba, bb);
    }
    if (fold) { accS[0] = accS[0] * g128; accS[1] = accS[1] * g128; }
#undef RT_SLOT
    if (j == 15) {
        float* So = F.out + O_RP + (size_t)(b * NH + hd) * DK * DK;
#pragma unroll
        for (int e2 = 0; e2 < 2; ++e2)
#pragma unroll
            for (int i = 0; i < 16; ++i) So[(size_t)(32 * hi2 + (i & 3) + 8 * (i >> 2) + 4 * h) * DK + 32 * (2 * eh + e2) + r] = accS[e2][i] * g128;
    }
    lane = launder(F.lane); h = lane >> 5; r = lane & 31;
    if (nj >= 0) {
        __syncthreads();
        ret_prime3(lds, Qg, (const bf16*)(F.ws + WS_ZA), KSg, Vg, tokb, nj, tokb + 64 * (size_t)nn0, hcol, w, lane);
    }
    bf16* AA = (bf16*)(F.ws + WS_AAB);
    const float sc = exp2f((float)(32 * tt + r + 1) * lg2);
    float s1 = 0.f, s2 = 0.f;
#pragma unroll
    for (int e2 = 0; e2 < 2; ++e2)
#pragma unroll
        for (int i = 0; i < 16; ++i) { const float o = accO[e2][i] * sc; accO[e2][i] = o; s1 += o; s2 += o * o; }
    s1 += __shfl_xor(s1, 32); s2 += __shfl_xor(s2, 32);
    LAS f32x2v* stat = (LAS f32x2v*)(lds + RT_STAT);
    if (h == 0) stat[(32 * tt + r) * 2 + eh] = (f32x2v){s1, s2};
    LDS_WAIT(); __syncthreads();
    LAS unsigned char* oimg = lds + 32768;
    { const f32x2v a = stat[(32 * tt + r) * 2], c = stat[(32 * tt + r) * 2 + 1];
      const float mean = (a.x + c.x) * (1.0f / 128.0f), var = fmaxf((a.y + c.y) * (1.0f / 128.0f) - mean * mean, 0.f), rstd = 1.0f / sqrtf(var + EPSF);
      const unsigned sw = swz16((unsigned)r);
      LAS unsigned char* orow = oimg + 256u * (32 * tt + r) + 8u * h;
#pragma unroll
      for (int e2 = 0; e2 < 2; ++e2)
#pragma unroll
        for (int g4 = 0; g4 < 4; ++g4) {
            const v2u zv = zq[e2][g4];
            const float o0 = (accO[e2][4 * g4] - mean) * rstd * bf_lo(zv.x), o1 = (accO[e2][4 * g4 + 1] - mean) * rstd * bf_hi(zv.x);
            const float o2 = (accO[e2][4 * g4 + 2] - mean) * rstd * bf_lo(zv.y), o3 = (accO[e2][4 * g4 + 3] - mean) * rstd * bf_hi(zv.y);
            v2u wv; wv.x = cvtpk(o0, o1); wv.y = cvtpk(o2, o3); *(LAS v2u*)(orow + 16u * ((unsigned)(4 * (2 * eh + e2) + g4) ^ sw)) = wv; } }
    LDS_WAIT(); __syncthreads();
    { const int tid = launder(F.tid) & 511;
#pragma unroll
      for (int i = 0; i < 4; ++i) { const unsigned idx = (unsigned)tid + 512u * i, row = idx >> 4, c = idx & 15u;
          const v4u v = *(const LAS v4u*)(oimg + 256u * row + 16u * (c ^ swz16(row)));
          *(v4u*)(AA + (tokb + 128 * (size_t)j + row) * (2 * RW) + hcol + 8 * c) = v; } }
    LDS_WAIT(); __syncthreads();
    if (nj >= 0) ret_stage(lds + 32768, KSg, Vg, tokb + 64 * (size_t)nn0 + 64, hcol, w, launder(F.lane));
}
__device__ __forceinline__ float ps_sum(const float* PS, int b, int n) {
    const float* p = PS + (size_t)b * INC + n; return (p[0] + p[PS_SLAB]) + (p[2 * PS_SLAB] + p[3 * PS_SLAB]);
}
__device__ __forceinline__ void ret_sample_load(f32x4 (&S)[8], float (&px)[2], const float* S0, const float* PS, int v, int tid) {
    const int cg = tid & 31, rg = tid >> 5, b = v / NH, h = v % NH, d = tid & 127, part = tid >> 7;
#pragma unroll
    for (int i = 0; i < 8; ++i) S[i] = __builtin_nontemporal_load((const f32x4*)(S0 + (size_t)(rg + 16 * i) * DK + 4 * cg));
    if (part < 2) { const int dl = d & 63, c1 = 32 * (dl >> 4) + 8 * ((dl >> 2) & 3) + (dl & 3), nb = part * 1024 + h * 128; px[0] = ps_sum(PS, b, nb + c1); px[1] = ps_sum(PS, b, nb + c1 + 4); }
    else { px[0] = ps_sum(PS, b, part * 1024 + h * 128 + d); px[1] = 0.f; }
}
__device__ __forceinline__ void ret_sample_unit(Frame& F, int b, int h, f32x4 (&S)[8], const float (&px)[2], float* Sout) {
    bf16* AA = (bf16*)(F.ws + WS_AAB);
    float* sq = (float*)(F.lds); float* sk = sq + 128; float* sv = sk + 128; float* sz = sv + 128; float* red = sz + 128; float* stat = red + 16 * 128;
    const int tid = launder(F.tid) & 511, cg = tid & 31, rg = tid >> 5;
    const float gam = 1.0f - exp2f(-5.0f - (float)h);
    const size_t ro = (size_t)(MP + b) * (2 * RW) + h * DK;
    { const int d = tid & 127, part = tid >> 7;
      if (part < 2) { const int dl = d & 63;
          const float x1 = px[0], x2 = px[1];
          const int ti = ((dl >> 2) * 2049 + 2048) * 4 + (dl & 3);
          const float cs = ((const float*)(F.ws + WS_TAB + TB_COS))[ti], sn = ((const float*)(F.ws + WS_TAB + TB_SIN))[ti];
          const float o = d < 64 ? x1 * cs - x2 * sn : x1 * sn + x2 * cs;
          if (part == 0) sq[d] = o; else sk[d] = o * (0.08838834764831845f / gam);
      } else { const float x = px[0]; if (part == 2) sv[d] = x; else sz[d] = x * sigmoidf_(x); } }
    __syncthreads();
    const f32x4 vv = *(const f32x4*)(sv + 4 * cg); f32x4 o = (f32x4){0.f, 0.f, 0.f, 0.f};
#pragma unroll
    for (int i = 0; i < 8; ++i) { const float kk = sk[rg + 16 * i], qq = sq[rg + 16 * i]; S[i] = (S[i] + vv * kk) * gam; o += S[i] * qq;
        __builtin_nontemporal_store(S[i], (f32x4*)(Sout + (size_t)(rg + 16 * i) * DK + 4 * cg)); }
    *(f32x4*)(red + rg * 128 + 4 * cg) = o;
    __syncthreads();
    float ov = 0.f;
    if (tid < 128) {
#pragma unroll
        for (int rr = 0; rr < 16; ++rr) ov += red[rr * 128 + tid];
        const float t1 = wave_sum(ov); if (F.lane == 0) stat[F.wave] = t1;
    }
    __syncthreads();
    float dv_ = 0.f;
    if (tid < 128) { const float mu = (stat[0] + stat[1]) * (1.0f / 128.0f); dv_ = ov - mu; const float t2 = wave_sum(dv_ * dv_); if (F.lane == 0) stat[2 + F.wave] = t2; }
    __syncthreads();
    if (tid < 128) { const float var = (stat[2] + stat[3]) * (1.0f / 128.0f); const float on = dv_ * (1.0f / sqrtf(var + EPSF));
        AA[ro + tid] = (bf16)f2bf(on * sz[tid]); }
    __syncthreads();
}
__device__ __forceinline__ void s5_sample_wave(Frame& F, const Args& args, int g, int b0, int bstep, int bend) {
    bf16* Y = (bf16*)(F.ws + WS_Y);
    const int p = launder(F.lane) & 63, gp = g * SP + p;
    const float* PSl = (const float*)(F.ws + WS_PS) + (size_t)(p >> 4) * PS_SLAB + 4096 + g * SN + (p & 15);
    float uq[4], xq[4], yq[4];
#pragma unroll
    for (int k = 0; k < 4; ++k) { const int b = b0 + k * bstep; uq[k] = 0.f; xq[k] = 0.f; yq[k] = 0.f;
        if (b < bend) { uq[k] = PSl[(size_t)b * INC]; xq[k] = args.in[3][(size_t)(b * SG + g) * SP + p]; yq[k] = args.in[4][(size_t)(b * SG + g) * SP + p]; } }
    float br[SN], bi[SN], crv[SN], civ[SN];
    { const f32x4* tb = (const f32x4*)((const float*)(F.ws + WS_TAB + TB_BR) + (size_t)gp * SN); const f32x4* ti = (const f32x4*)((const float*)(F.ws + WS_TAB + TB_BI) + (size_t)gp * SN);
#pragma unroll
      for (int q4 = 0; q4 < 4; ++q4) { const f32x4 a = tb[q4], c = ti[q4]; br[4 * q4] = a[0]; br[4 * q4 + 1] = a[1]; br[4 * q4 + 2] = a[2]; br[4 * q4 + 3] = a[3]; bi[4 * q4] = c[0]; bi[4 * q4 + 1] = c[1]; bi[4 * q4 + 2] = c[2]; bi[4 * q4 + 3] = c[3]; } }
#pragma unroll
    for (int n = 0; n < SN; ++n) { crv[n] = args.in[16][(g * SN + n) * SP + p]; civ[n] = args.in[17][(g * SN + n) * SP + p]; }
    const float ar = ((const float*)(F.ws + WS_TAB + TB_AR))[gp], ai = ((const float*)(F.ws + WS_TAB + TB_AI))[gp];
    const float dnv = args.in[18][g * SN + (p & 15)];
    for (int bb = b0; bb < bend; bb += 4 * bstep) {
        if (bb != b0) {
#pragma unroll
            for (int k = 0; k < 4; ++k) { const int b = bb + k * bstep;
                if (b < bend) { uq[k] = PSl[(size_t)b * INC]; xq[k] = args.in[3][(size_t)(b * SG + g) * SP + p]; yq[k] = args.in[4][(size_t)(b * SG + g) * SP + p]; } }
        }
#pragma unroll
        for (int k = 0; k < 4; ++k) { const int b = bb + k * bstep;
            if (b < bend) {
                float un = uq[k]; un += __shfl_xor(un, 16); un += __shfl_xor(un, 32);
                const float x0r = xq[k], x0i = yq[k];
                float bur = 0.f, bui = 0.f;
#pragma unroll
                for (int n = 0; n < SN; ++n) { const float u = __builtin_bit_cast(float, __builtin_amdgcn_readlane(__builtin_bit_cast(int, un), n)); bur += br[n] * u; bui += bi[n] * u; }
                const float xr = ar * x0r - ai * x0i + bur, xi = ar * x0i + ai * x0r + bui;
                float v8[8], v4[4], v2[2], yv;
                { const bool b3 = (p & 8) != 0, b2 = (p & 4) != 0, b1 = (p & 2) != 0, b0 = (p & 1) != 0;
#pragma unroll
                  for (int n = 0; n < 8; ++n) { const float lo = crv[n] * xr - civ[n] * xi, hi = crv[n + 8] * xr - civ[n + 8] * xi;
                      v8[n] = (b3 ? hi : lo) + dpp_f<0x128, 0xF>(b3 ? lo : hi); }
#pragma unroll
                  for (int n = 0; n < 4; ++n) v4[n] = (b2 ? v8[n + 4] : v8[n]) + dpp_f<0x141, 0xF>(b2 ? v8[n] : v8[n + 4]);
#pragma unroll
                  for (int n = 0; n < 2; ++n) v2[n] = (b1 ? v4[n + 2] : v4[n]) + dpp_f<0x4E, 0xF>(b1 ? v4[n] : v4[n + 2]);
                  yv = (b0 ? v2[1] : v2[0]) + dpp_f<0xB1, 0xF>(b0 ? v2[0] : v2[1]);
                  yv += __shfl_xor(yv, 16); yv += __shfl_xor(yv, 32); }
                F.out[O_RES + (size_t)(b * SG + g) * SP + p] = xr; F.out[O_IMS + (size_t)(b * SG + g) * SP + p] = xi;
                if (p < 16) { const float y = yv + dnv * un; Y[(size_t)(MP + b) * SW + g * SN + p] = (bf16)f2bf(gelu_tanh(y)); }
            }
        }
    }
}
constexpr int S5_XLOC = 0, S5_XIN = 8192, S5_XIM = 32768;
__device__ __forceinline__ void s5_unit(Frame& F, const Args& args, int b, int g) {
    LAS unsigned char* lds = F.lds;
    const bf16* UBg = (const bf16*)(F.ws + WS_UB) + (size_t)g * MPAD * 16; bf16* Y = (bf16*)(F.ws + WS_Y);
    const float* tar = (const float*)(F.ws + WS_TAB + TB_AR); const float* tai = (const float*)(F.ws + WS_TAB + TB_AI);
    const float* tbr = (const float*)(F.ws + WS_TAB + TB_BR); const float* tbi = (const float*)(F.ws + WS_TAB + TB_BI);
    const int w = F.wave, lane = launder(F.lane), c = lane & 31, h = lane >> 5;
    const size_t rb = (size_t)b * SEQ;
    bf16x8 bfr[4];
#pragma unroll
    for (int f = 0; f < 4; ++f) { const float* src = ((f >> 1) ? tbi : tbr) + (size_t)(g * SP + c + 32 * (f & 1)) * SN + 8 * h;
        const f32x4 v0 = *(const f32x4*)src, v1 = *(const f32x4*)(src + 4);
        v4u t; t.x = cvtpk(v0[0], v0[1]); t.y = cvtpk(v0[2], v0[3]); t.z = cvtpk(v1[0], v1[1]); t.w = cvtpk(v1[2], v1[3]); bfr[f] = __builtin_bit_cast(bf16x8, t); }
    float ar[2], ai[2];
#pragma unroll
    for (int ps = 0; ps < 2; ++ps) { ar[ps] = tar[g * SP + c + 32 * ps]; ai[ps] = tai[g * SP + c + 32 * ps]; }
    const int rho = lane & 31, hr = (rho >> 2) & 1, ir = (rho & 3) + 4 * (rho >> 3);
    const bf16* arow = UBg + (rb + 128 * (size_t)(2 * w + hr) + ir) * 16 + 8 * h;
    f32x16 zero16;
#pragma unroll
    for (int i = 0; i < 16; ++i) zero16[i] = 0.f;
    float xr[2] = {0.f, 0.f}, xi[2] = {0.f, 0.f};
    bf16x8 afr[8];
#pragma unroll
    for (int blk = 0; blk < 8; ++blk) afr[blk] = *(const bf16x8*)(arow + (size_t)blk * 256);
#pragma unroll
    for (int blk = 0; blk < 8; ++blk) {
        const bf16x8 A = afr[blk];
        f32x16 bu[4];
#pragma unroll
        for (int f = 0; f < 4; ++f) bu[f] = MFMA32(A, bfr[f], zero16);
#pragma unroll
        for (int i = 0; i < 16; ++i)
#pragma unroll
            for (int ps = 0; ps < 2; ++ps) { const float nr = fmaf(ar[ps], xr[ps], fmaf(-ai[ps], xi[ps], bu[ps][i])), ni = fmaf(ar[ps], xi[ps], fmaf(ai[ps], xr[ps], bu[2 + ps][i])); xr[ps] = nr; xi[ps] = ni; }
    }
    LAS f32x2v* xloc = (LAS f32x2v*)(lds + S5_XLOC); LAS f32x2v* xin = (LAS f32x2v*)(lds + S5_XIN);
#pragma unroll
    for (int ps = 0; ps < 2; ++ps) xloc[(2 * w + h) * 64 + c + 32 * ps] = (f32x2v){xr[ps], xi[ps]};
    LDS_WAIT(); __syncthreads();
    if (w == 0) {
        float a_r = tar[g * SP + lane], a_i = tai[g * SP + lane];
#pragma unroll
        for (int k = 0; k < 7; ++k) { const float nr = a_r * a_r - a_i * a_i, ni = 2.0f * a_r * a_i; a_r = nr; a_i = ni; }
        float sr = 0.f, si = 0.f;
        for (int sgm = 0; sgm < 16; ++sgm) { xin[sgm * 64 + lane] = (f32x2v){sr, si}; const f32x2v l = xloc[sgm * 64 + lane];
            const float nr = a_r * sr - a_i * si + l.x, ni = a_r * si + a_i * sr + l.y; sr = nr; si = ni; }
        F.out[O_REP + (size_t)(b * SG + g) * SP + lane] = sr; F.out[O_IMP + (size_t)(b * SG + g) * SP + lane] = si;
    }
    LDS_WAIT(); __syncthreads();
#pragma unroll
    for (int ps = 0; ps < 2; ++ps) { const f32x2v v = xin[(2 * w + h) * 64 + c + 32 * ps]; xr[ps] = v.x; xi[ps] = v.y; }
    bf16x8 cfr[4];
    { const int n = lane & 15, kq = lane >> 4;
#pragma unroll
      for (int ks = 0; ks < 4; ++ks) { const float* src = ((ks >> 1) ? args.in[17] : args.in[16]) + (size_t)(g * SN + n) * SP + 32 * (ks & 1) + 8 * kq; const float sgn = (ks >> 1) ? -1.0f : 1.0f;
          const f32x4 v0 = *(const f32x4*)src * sgn, v1 = *(const f32x4*)(src + 4) * sgn;
          v4u t; t.x = cvtpk(v0[0], v0[1]); t.y = cvtpk(v0[2], v0[3]); t.z = cvtpk(v1[0], v1[1]); t.w = cvtpk(v1[2], v1[3]); cfr[ks] = __builtin_bit_cast(bf16x8, t); } }
    const int tq = lane & 15, nq = lane >> 4;
    const f32x4 dn = *(const f32x4*)(args.in[18] + g * SN + 4 * nq);
    LAS unsigned char* xim = lds + S5_XIM + w * 8192;
    v2u uvs[8][2];
#pragma unroll
    for (int blk = 0; blk < 8; ++blk)
#pragma unroll
        for (int sq = 0; sq < 2; ++sq) uvs[blk][sq] = *(const v2u*)(UBg + (rb + 128 * (size_t)(2 * w + sq) + 16 * blk + tq) * 16 + 4 * nq);
#pragma unroll
    for (int blk = 0; blk < 8; ++blk) {
        const bf16x8 A = afr[blk];
        f32x16 bu[4];
#pragma unroll
        for (int f = 0; f < 4; ++f) bu[f] = MFMA32(A, bfr[f], zero16);
#pragma unroll
        for (int i = 0; i < 16; ++i)
#pragma unroll
            for (int ps = 0; ps < 2; ++ps) { const float nr = fmaf(ar[ps], xr[ps], fmaf(-ai[ps], xi[ps], bu[ps][i])), ni = fmaf(ar[ps], xi[ps], fmaf(ai[ps], xr[ps], bu[2 + ps][i])); xr[ps] = nr; xi[ps] = ni; bu[ps][i] = nr; bu[2 + ps][i] = ni; }
#pragma unroll
        for (int f = 0; f < 4; ++f) { LAS unsigned char* dst = xim + h * 4096 + ((f >> 1) * 64 + (f & 1) * 32 + c) * 32;
            *(LAS bf16x8*)dst = pack8(bu[f], 0); *(LAS bf16x8*)(dst + 16) = pack8(bu[f], 1); }
        LDS_WAIT(); asm volatile("" ::: "memory");
#pragma unroll
        for (int sq = 0; sq < 2; ++sq) {
            f32x4 yT = (f32x4){0.f, 0.f, 0.f, 0.f};
#pragma unroll
            for (int ks = 0; ks < 4; ++ks) {
                LAS unsigned char* base = xim + sq * 4096 + (32 * ks + 8 * nq + (tq >> 2)) * 32 + 8 * (tq & 3);
                const bf16x8 B = cat8(lds_tr(base), lds_tr(base + 4 * 32));
                yT = MFMA16(cfr[ks], B, yT);
            }
            const size_t row = rb + 128 * (size_t)(2 * w + sq) + 16 * blk + tq;
            const v2u uv = uvs[blk][sq];
            const float y0 = gelu_tanh(yT[0] + dn[0] * bf_lo(uv.x)), y1 = gelu_tanh(yT[1] + dn[1] * bf_hi(uv.x)), y2 = gelu_tanh(yT[2] + dn[2] * bf_lo(uv.y)), y3 = gelu_tanh(yT[3] + dn[3] * bf_hi(uv.y));
            v2u wv; wv.x = cvtpk(y0, y1); wv.y = cvtpk(y2, y3); *(v2u*)(Y + row * SW + g * SN + 4 * nq) = wv;
        }
        LDS_WAIT(); asm volatile("" ::: "memory");
    }
    __syncthreads();
}
__device__ __forceinline__ void p2_phase(Frame& F, const Args& args, int mask) {
    if (mask & 1) for (int pu = F.vcu; pu < 256; pu += F.G) { const int bh = pu >> 3, jj = pu & 7; f32x16 accS[2];
        ret_unit(F, bh >> 3, bh & 7, jj, false, 15 - jj, 0, 2 * jj + 2, true, accS);
        ret_unit(F, bh >> 3, bh & 7, 15 - jj, true, -1, 2 * jj + 2, 0, false, accS); }
    if (mask & 2) for (int u5 = F.vcu; u5 < NBATCH * SG; u5 += F.G) s5_unit(F, args, u5 >> 6, u5 & 63);
    (void)0;
    const float* PSr = (const float*)(F.ws + WS_PS);
    const bool wsplit = F.G == 256; const int jjs = F.vcu & 7;
    const int it0 = wsplit ? (jjs >= 2 ? ((F.vcu >> 3) * 6 + jjs - 2) * NTHR + F.tid : MS * (5120 / 4)) : F.vcu * NTHR + F.tid, its = wsplit ? 192 * NTHR : F.G * NTHR;
    f32x4 xs[2][4];
    if (mask & 8) {
#pragma unroll
      for (int k = 0; k < 2; ++k) { const int it = it0 + k * its;
        if (it < MS * (5120 / 4)) { const float* p = PSr + (size_t)(it / 1280) * INC + 5120 + 4 * (it % 1280);
#pragma unroll
          for (int sl = 0; sl < 4; ++sl) xs[k][sl] = *(const f32x4*)(p + (size_t)sl * PS_SLAB); } }
    }
    const int gw = F.vcu * NWAVES + F.wave, NGW = F.G * NWAVES;
    if (mask & 8) {
      if (F.G == 256) {
          const int bh = F.vcu >> 3, jj = F.vcu & 7;
          const int m = 2 * (int)((0x44322100u >> (4 * jj)) & 15u), o = 8 * (int)((0xC8531000u >> (4 * jj)) & 15u) + (F.wave >> 1) * m;
          if (m) s5_sample_wave(F, args, 2 * bh + (F.wave & 1), o, 1, o + m);
      } else if (NGW % SG == 0) s5_sample_wave(F, args, gw % SG, gw / SG, NGW / SG, MS); else for (int v = gw; v < MS * SG; v += NGW) s5_sample_wave(F, args, v % SG, v / SG, MS, MS); }
    if (mask & 8) {
      for (int it = it0, k = 0; it < MS * (5120 / 4); it += its, ++k) { const int b = it / 1280, n = 5120 + 4 * (it % 1280);
        f32x4 x;
        if (k == 0) x = (xs[0][0] + xs[0][1]) + (xs[0][2] + xs[0][3]);
        else if (k == 1) x = (xs[1][0] + xs[1][1]) + (xs[1][2] + xs[1][3]);
        else { const float* p = PSr + (size_t)b * INC + n; x = (*(const f32x4*)p + *(const f32x4*)(p + PS_SLAB)) + (*(const f32x4*)(p + 2 * PS_SLAB) + *(const f32x4*)(p + 3 * PS_SLAB)); }
        f32x4 o; for (int e = 0; e < 4; ++e) { const float sg = sigmoidf_(x[e]); o[e] = n < 6144 ? x[e] * sg : sg; }
        bf16* dst = n < 6144 ? (bf16*)(F.ws + WS_ZB) + (size_t)(MP + b) * SW + (n - 5120) : (n < 8192 ? (bf16*)(F.ws + WS_GAS) + (size_t)b * DM + (n - 6144) : (bf16*)(F.ws + WS_GBS) + (size_t)b * DM + (n - 8192));
        *(v2u*)dst = pk4(o); } }
}

template <int NT>
__device__ __forceinline__ void sk_acc(f32x4 (&acc)[NT], const bf16* X, const bf16* Wt, int K, int n0, int wave, int lane) {
    const int kq = lane >> 4;
    const bf16* xp = X + (size_t)(16 * wave + (lane & 15)) * K + 8 * kq;
    const bf16* wp = Wt + (size_t)(n0 + (lane & 15)) * K + 8 * kq;
#pragma unroll
    for (int nt = 0; nt < NT; ++nt) acc[nt] = (f32x4){0.f, 0.f, 0.f, 0.f};
#pragma unroll 8
    for (int ks = 0; ks < K / 32; ++ks) {
        const bf16x8 a = *(const bf16x8*)(xp + 32 * ks);
#pragma unroll
        for (int nt = 0; nt < NT; ++nt) { const bf16x8 bw = *(const bf16x8*)(wp + (size_t)nt * 16 * K + 32 * ks); acc[nt] = MFMA16(bw, a, acc[nt]); }
    }
}
__device__ __forceinline__ f32x4 ld4bf(const bf16* p) { const v2u w = *(const v2u*)p; return (f32x4){bf_lo(w.x), bf_hi(w.x), bf_lo(w.y), bf_hi(w.y)}; }
__device__ __forceinline__ void p3_sample_ret(Frame& F, const Args& args, int idx, int nidle, int v0, int v1) {
    f32x4 Scur[8], Snxt[8]; float pc[2], pn[2];
    const float* PS = (const float*)(F.ws + WS_PS);
    int v = v0 + idx;
    if (v < v1) ret_sample_load(Scur, pc, args.in[2] + (size_t)v * DK * DK, PS, v, F.tid);
    for (; v < v1; v += nidle) {
        const bool hasn = v + nidle < v1;
        if (hasn) ret_sample_load(Snxt, pn, args.in[2] + (size_t)(v + nidle) * DK * DK, PS, v + nidle, F.tid);
        ret_sample_unit(F, v / NH, v % NH, Scur, pc, F.out + O_RS + (size_t)v * DK * DK);
        if (hasn) { pc[0] = pn[0]; pc[1] = pn[1];
#pragma unroll
            for (int i = 0; i < 8; ++i) Scur[i] = Snxt[i]; }
    }
}
__device__ __forceinline__ void sk_p3(Frame& F, const Args& args, int idx, int nidle);
template <int KS4>
__device__ __forceinline__ void skw_acc(f32x4 (&acc)[4], const bf16* X, const bf16* Wt, int K, int k0, int n0, int lane) {
    const int kq = lane >> 4;
    const bf16* xp = X + (size_t)(lane & 15) * K + k0 + 8 * kq;
    const bf16* wp = Wt + (size_t)(n0 + (lane & 15)) * K + k0 + 8 * kq;
    bf16x8 af[KS4][4], wf[KS4];
#pragma unroll
    for (int ks = 0; ks < KS4; ++ks) { wf[ks] = *(const bf16x8*)(wp + 32 * ks);
#pragma unroll
        for (int mt = 0; mt < 4; ++mt) af[ks][mt] = *(const bf16x8*)(xp + (size_t)mt * 16 * K + 32 * ks); }
#pragma unroll
    for (int ks = 0; ks < KS4; ++ks)
#pragma unroll
        for (int mt = 0; mt < 4; ++mt) acc[mt] = MFMA16(wf[ks], af[ks][mt], acc[mt]);
}
__device__ __forceinline__ f32x4 skw_reduce(Frame& F, const f32x4 (&acc)[4], int lane) {
    LAS f32x4* red = (LAS f32x4*)F.lds;
#pragma unroll
    for (int mt = 0; mt < 4; ++mt) red[(F.wave * 64 + 16 * mt + (lane & 15)) * 4 + (lane >> 4)] = acc[mt];
    LDS_WAIT(); __syncthreads();
    f32x4 sum = (f32x4){0.f, 0.f, 0.f, 0.f};
    if (F.tid < 256) {
#pragma unroll
        for (int wv = 0; wv < 8; ++wv) sum += red[wv * 256 + F.tid]; }
    LDS_WAIT(); __syncthreads();
    return sum;
}
constexpr int SKL_OFF = 32768, SKL_WAVE = 16 * (512 + 16);
template <int KW>
__device__ __forceinline__ void skl_acc(f32x4 (&acc)[4], const bf16* X, const bf16* Wt, int ld, int k0, int n0, LAS unsigned char* wl, int lane) {
    constexpr int RB = 2 * KW, LPR = RB / 16, RPI = 64 / LPR, NI = 16 / RPI, KS = KW / 32, PB = RB + 16;
    const int lr = lane / LPR, lc = lane % LPR, m15 = lane & 15, kq = lane >> 4;
    const bf16* wsrc = Wt + (size_t)(n0 + lr) * ld + k0 + 8 * lc;
    const bf16* xsrc = X + (size_t)lr * ld + k0 + 8 * lc;
    LAS unsigned char* wdst = wl + lr * PB + 16 * lc;
    LAS unsigned char* frd = wl + m15 * PB + 16 * kq;
    v4u wv[NI], xv[NI];
#pragma unroll
    for (int i = 0; i < NI; ++i) wv[i] = *(const v4u*)(wsrc + (size_t)i * RPI * ld);
#pragma unroll
    for (int i = 0; i < NI; ++i) xv[i] = *(const v4u*)(xsrc + (size_t)i * RPI * ld);
#pragma unroll
    for (int i = 0; i < NI; ++i) *(LAS v4u*)(wdst + i * RPI * PB) = wv[i];
    LDS_WAIT(); asm volatile("" ::: "memory");
    bf16x8 wf[KS];
#pragma unroll
    for (int ks = 0; ks < KS; ++ks) wf[ks] = *(const LAS bf16x8*)(frd + 64 * ks);
    LDS_WAIT(); asm volatile("" ::: "memory");
#pragma unroll
    for (int mt = 0; mt < 4; ++mt) {
#pragma unroll
        for (int i = 0; i < NI; ++i) *(LAS v4u*)(wdst + i * RPI * PB) = xv[i];
        if (mt < 3) {
#pragma unroll
            for (int i = 0; i < NI; ++i) xv[i] = *(const v4u*)(xsrc + (size_t)((mt + 1) * 16 + i * RPI) * ld); }
        LDS_WAIT(); asm volatile("" ::: "memory");
        bf16x8 xf[KS];
#pragma unroll
        for (int ks = 0; ks < KS; ++ks) xf[ks] = *(const LAS bf16x8*)(frd + 64 * ks);
        LDS_WAIT(); asm volatile("" ::: "memory");
#pragma unroll
        for (int ks = 0; ks < KS; ++ks) acc[mt] = MFMA16(wf[ks], xf[ks], acc[mt]);
    }
}
__device__ __forceinline__ void sk_p3(Frame& F, const Args& args, int idx, int nidle) {
    for (int task = idx; task < 2 * (SW / 16); task += nidle) {
        const int ct = task >> 1, r0 = 64 * (task & 1);
        const int lane = launder(F.lane) & 63; f32x4 acc[4];
#pragma unroll
        for (int mt = 0; mt < 4; ++mt) acc[mt] = (f32x4){0.f, 0.f, 0.f, 0.f};
        skl_acc<128>(acc, (const bf16*)(F.ws + WS_Y) + (size_t)(MP + r0) * SW, (const bf16*)(F.ws + WS_WGLU), SW, 128 * F.wave, 16 * ct, F.lds + SKL_OFF + F.wave * SKL_WAVE, lane);
        const f32x4 gsum = skw_reduce(F, acc, lane);
        const int tid = launder(F.tid) & 511;
        if (tid < 256) { const int m = r0 + (tid >> 2), n = 16 * ct + 4 * (tid & 3); const size_t off = (size_t)(MP + m) * SW + n;
            const f32x4 gg = gsum + *(const f32x4*)(args.in[20] + n), yv = ld4bf((const bf16*)(F.ws + WS_Y) + off), zv = ld4bf((const bf16*)(F.ws + WS_ZB) + off);
            f32x4 o; for (int e = 0; e < 4; ++e) o[e] = yv[e] * sigmoidf_(gg[e]) * zv[e];
            *(v2u*)((bf16*)(F.ws + WS_AAB) + (size_t)(MP + m) * (2 * SW) + SW + n) = pk4(o); }
    }
}
__device__ __forceinline__ void sk_p4(Frame& F) {
    for (int task = F.vcu; task < 2 * (DM / 16); task += F.G) {
        const int ct = task >> 1, r0 = 64 * (task & 1);
        const int lane = launder(F.lane) & 63; f32x4 acc[4];
        const bf16* X = (const bf16*)(F.ws + WS_AAB) + (size_t)(MP + r0) * 2 * RW;
#pragma unroll
        for (int mt = 0; mt < 4; ++mt) acc[mt] = (f32x4){0.f, 0.f, 0.f, 0.f};
        skl_acc<128>(acc, X, (const bf16*)(F.ws + WS_WPA), 2 * RW, 128 * F.wave, 16 * ct, F.lds + SKL_OFF + F.wave * SKL_WAVE, lane);
        const f32x4 ya = skw_reduce(F, acc, lane);
#pragma unroll
        for (int mt = 0; mt < 4; ++mt) acc[mt] = (f32x4){0.f, 0.f, 0.f, 0.f};
        skl_acc<128>(acc, X, (const bf16*)(F.ws + WS_WPA), 2 * RW, RW + 128 * F.wave, 16 * ct, F.lds + SKL_OFF + F.wave * SKL_WAVE, lane);
        const f32x4 yb = skw_reduce(F, acc, lane);
        const int tid = launder(F.tid) & 511;
        if (tid < 256) { const size_t goff = (size_t)(r0 + (tid >> 2)) * DM + 16 * ct + 4 * (tid & 3), off = goff + (size_t)MP * DM;
            const f32x4 o = ld4bf((const bf16*)(F.ws + WS_GAS) + goff) * ya + ld4bf((const bf16*)(F.ws + WS_GBS) + goff) * yb;
            *(v2u*)((bf16*)(F.ws + WS_MRG) + off) = pk4(o); }
    }
}
__device__ __forceinline__ void sk_p5(Frame& F) {
    for (int task = F.vcu; task < 2 * (DM / 16); task += F.G) {
        const int ct = task >> 1, r0 = 64 * (task & 1);
        const int lane = launder(F.lane) & 63; f32x4 acc[4];
        const bf16* X = (const bf16*)(F.ws + WS_MRG) + (size_t)(MP + r0) * DM;
#pragma unroll
        for (int mt = 0; mt < 4; ++mt) acc[mt] = (f32x4){0.f, 0.f, 0.f, 0.f};
        skl_acc<256>(acc, X, (const bf16*)(F.ws + WS_WOUT), DM, 256 * F.wave, 16 * ct, F.lds + SKL_OFF + F.wave * SKL_WAVE, lane);
        const f32x4 o = skw_reduce(F, acc, lane);
        const int tid = launder(F.tid) & 511;
        if (tid < 256) *(v2u*)((bf16*)(F.ws + WS_OUT) + (size_t)(MP + r0 + (tid >> 2)) * DM + 16 * ct + 4 * (tid & 3)) = pk4(o);
    }
}

__device__ __forceinline__ void p6_load(v2u (&ov)[8], f32x4 (&xv)[8], const bf16* OUT, const Args& args, int m, int lane) {
    const float* xrow = m < MP ? args.in[0] + (size_t)m * DM : args.in[1] + (size_t)(m - MP) * DM;
    const GAS v2u* orow = (const GAS v2u*)(OUT + (size_t)m * DM) + lane; const GAS f32x4* xr = (const GAS f32x4*)xrow + lane;
#pragma unroll
    for (int j = 0; j < 8; ++j) { ov[j] = orow[64 * j]; xv[j] = __builtin_nontemporal_load(xr + 64 * j); }
}
__device__ __forceinline__ void p6_final(Frame& F, const Args& args) {
    const bf16* OUT = (const bf16*)(F.ws + WS_OUT);
    const int gw = F.vcu * NWAVES + F.wave, NGW = F.G * NWAVES;
    f32x4 gq[8];
    { const GAS f32x4* gr = (const GAS f32x4*)args.in[10] + F.lane;
#pragma unroll
      for (int j = 0; j < 8; ++j) gq[j] = gr[64 * j]; }
    v2u oa[8], ob[8]; f32x4 xa[8], xb[8];
    const bool spread = (NGW == 2048) && (MP % NGW == 0);
    const bool extra = spread && (gw % 16 == 0);
    int m = extra ? MP + gw / 16 : gw, mnext = extra ? gw : gw + NGW;
    const int mend = spread ? MP : MV;
    if (m >= MV) return;
    p6_load(oa, xa, OUT, args, m, F.lane);
    for (;; m = mnext, mnext += NGW) {
        const bool hasn = mnext < mend;
        if (hasn) p6_load(ob, xb, OUT, args, mnext, F.lane);
        float* yrow = m < MP ? F.out + O_YP + (size_t)m * DM : F.out + O_YS + (size_t)(m - MP) * DM;
        f32x4 v[8]; float s = 0.f;
#pragma unroll
        for (int j = 0; j < 8; ++j) { v[j] = (f32x4){bf_lo(oa[j].x), bf_hi(oa[j].x), bf_lo(oa[j].y), bf_hi(oa[j].y)}; s += (v[j].x * v[j].x + v[j].y * v[j].y) + (v[j].z * v[j].z + v[j].w * v[j].w); }
        const float rstd = 1.0f / sqrtf(wave_sum(s) * (1.f / DM) + EPSF);
        GAS f32x4* yo = (GAS f32x4*)yrow + F.lane;
#pragma unroll
        for (int j = 0; j < 8; ++j) __builtin_nontemporal_store(xa[j] + v[j] * rstd * gq[j], yo + 64 * j);
        if (!hasn) break;
#pragma unroll
        for (int j = 0; j < 8; ++j) { oa[j] = ob[j]; xa[j] = xb[j]; }
    }
}

__global__ void __launch_bounds__(NTHR, 2) fwd_kernel(Args args) {
    extern __shared__ __attribute__((aligned(16))) unsigned char lds[];
    Frame F;
    F.lds = (LAS unsigned char*)lds;
    F.MISC = (volatile LAS unsigned*)(F.lds + MISC_OFF);
    F.tid = threadIdx.x; F.lane = F.tid & 63; F.wave = __builtin_amdgcn_readfirstlane(F.tid >> 6);
    F.G = gridDim.x; { const int bx = blockIdx.x; F.vcu = (F.G % 8 == 0) ? (bx % 8) * (F.G / 8) + bx / 8 : bx; }
    F.out = args.out; F.ws = args.ws;
    for (int u = F.tid; u < (LDS_BYTES - LDSCTL_OFF) / 4; u += NTHR) ((LAS unsigned*)(F.lds + LDSCTL_OFF))[u] = 0u;
    __syncthreads();
    unsigned* ctl = (unsigned*)(args.ws + WS_CTL);
    XcdBarrier bar; bar.bar = ctl + CW_BAR + args.li * XCD_BAR_WORDS; bar.x = 0; bar.st = nullptr;
    const int lo = args.ph_lo, hi = args.ph_hi;
    if (hi - lo > 1) bar = xcd_barrier_post(ctl + CW_BAR + args.li * XCD_BAR_WORDS, F.MISC + 8);
#define IN(k) (lo <= (k) && (k) < hi)
#define BOTH(k) (IN(k) && IN((k) + 1))
#define GRID_BAR() xcd_barrier(bar)

    if (IN(0)) for (int rep = 0; rep < (REP_PHASE == 0 ? 2 : 1); ++rep) { p0_prologue(F, args); if (BOTH(0)) GRID_BAR(); }

    if (IN(1)) for (int rep = 0; rep < (REP_PHASE == 1 ? 2 : 1); ++rep) {
        pg8::Gemm g{(const bf16*)(F.ws + WS_H), (const bf16*)(F.ws + WS_WIN), nullptr, nullptr, DM};
        pg8::ProjOrder S; S.init(MP, INC, F.G, (int)blockIdx.x);
        EpiProj E{(bf16*)(F.ws + WS_Q), (bf16*)(F.ws + WS_K), (bf16*)(F.ws + WS_V), (bf16*)(F.ws + WS_ZA), (bf16*)(F.ws + WS_UB), (bf16*)(F.ws + WS_ZB), (bf16*)(F.ws + WS_GA), (bf16*)(F.ws + WS_GB),
                  (const float*)(F.ws + WS_TAB + TB_COS), (const float*)(F.ws + WS_TAB + TB_SIN), (float*)(F.ws + WS_PS)};
        { const int nun = MP / 256 * (INC / 256) + 4 * (INC / 256), rem = nun % F.G;
          if (rem == 0) p1_convert_rest(F, args, (int)blockIdx.x, F.G); else if ((int)blockIdx.x >= rem) p1_convert_rest(F, args, (int)blockIdx.x - rem, F.G - rem);
          __syncthreads(); }
        pg8::gemm_phase<EpiProj, pg8::ProjOrder, true, true>(F.lds, g, S, E);
        if (BOTH(1)) GRID_BAR();
    }

    if (IN(2)) for (int rep = 0; rep < (REP_PHASE == 2 ? 2 : 1); ++rep) { p2_phase(F, args, args.pad ? args.pad : 15); if (BOTH(2)) GRID_BAR(); }

    if (IN(3)) for (int rep = 0; rep < (REP_PHASE == 3 ? 2 : 1); ++rep) {
        pg8::Gemm g{(const bf16*)(F.ws + WS_Y), (const bf16*)(F.ws + WS_WGLU), nullptr, nullptr, SW};
        pg8::StaticOrder S; S.init(MP, SW, F.G, (int)blockIdx.x);
        EpiGlu E{(const bf16*)(F.ws + WS_Y), (const bf16*)(F.ws + WS_ZB), (bf16*)(F.ws + WS_AAB), args.in[20]};
        pg8::gemm_phase<EpiGlu, pg8::StaticOrder, true, true>(F.lds, g, S, E);
        if (F.G > 128) { if ((int)blockIdx.x < 128) sk_p3(F, args, (int)blockIdx.x, 128); } else sk_p3(F, args, (int)blockIdx.x, F.G);
        if (F.G == 256) { if ((int)blockIdx.x >= 128) p3_sample_ret(F, args, (int)blockIdx.x - 128, 128, 0, MS * NH); }
        else if (F.G > 128) { if ((int)blockIdx.x >= 128) p3_sample_ret(F, args, (int)blockIdx.x - 128, F.G - 128, 0, MS * NH); } else p3_sample_ret(F, args, (int)blockIdx.x, F.G, 0, MS * NH);
        if (BOTH(3)) GRID_BAR();
    }

    if (IN(4)) for (int rep = 0; rep < (REP_PHASE == 4 ? 2 : 1); ++rep) {
        pg8::Gemm g{(const bf16*)(F.ws + WS_AAB), (const bf16*)(F.ws + WS_WPA), nullptr, nullptr, 2 * RW};
        pg8::StaticOrder S; S.init(MP, DM, F.G, (int)blockIdx.x);
        EpiMerge E{(const unsigned char*)(F.ws + WS_G8A), (const unsigned char*)(F.ws + WS_G8B), (bf16*)(F.ws + WS_MRG)};
        pg8::gemm_phase<EpiMerge, pg8::StaticOrder, true, true>(F.lds, g, S, E);
        sk_p4(F);
        if (BOTH(4)) GRID_BAR();
    }

    const bool fuse5 = false;
    if (IN(5)) for (int rep = 0; rep < (REP_PHASE == 5 ? 2 : 1); ++rep) {
        pg8::Gemm g{(const bf16*)(F.ws + WS_MRG), (const bf16*)(F.ws + WS_WOUT), nullptr, nullptr, DM};
        pg8::StaticOrder S; S.init(MP, DM, F.G, (int)blockIdx.x);
        {
            EpiOutBf16 E{(bf16*)(F.ws + WS_OUT), DM};
            pg8::gemm_phase<EpiOutBf16, pg8::StaticOrder, true, true>(F.lds, g, S, E);
            sk_p5(F);
            if (BOTH(5)) GRID_BAR();
        }
    }

    if (IN(6) && !fuse5) for (int rep = 0; rep < (REP_PHASE == 6 ? 2 : 1); ++rep) { p6_final(F, args); if (REP_PHASE == 6 && rep == 0) GRID_BAR(); }
#undef IN
#undef BOTH
#undef GRID_BAR
}

extern "C" void kernel_launch(void* const* d_in, const int* in_sizes, int n_in, void* d_out, int out_size, void* d_ws, size_t ws_size, hipStream_t stream) {
    static int grid = 0;
    if (grid == 0) {
        if (n_in != 21 || out_size != (int)O_END || ws_size < WS_END2) { fprintf(stderr, "kernel_launch: unexpected shapes: n_in %d out %d ws %zu\n", n_in, out_size, ws_size); grid = -1; return; }
        int dev = 0, cus = 0, per_cu = 0;
        if (hipGetDevice(&dev) != hipSuccess || hipDeviceGetAttribute(&cus, hipDeviceAttributeMultiprocessorCount, dev) != hipSuccess) { grid = -1; return; }
        if (hipFuncSetAttribute((const void*)fwd_kernel, hipFuncAttributeMaxDynamicSharedMemorySize, LDS_BYTES) != hipSuccess) { fprintf(stderr, "kernel_launch: hipFuncSetAttribute failed\n"); grid = -1; return; }
        if (hipOccupancyMaxActiveBlocksPerMultiprocessor(&per_cu, (const void*)fwd_kernel, NTHR, LDS_BYTES) != hipSuccess || per_cu < 1) { fprintf(stderr, "kernel_launch: occupancy query says %d\n", per_cu); (void)hipGetLastError(); grid = -1; return; }
        grid = cus;
    }
    if (grid < 0) return;
    (void)hipMemsetAsync((char*)d_ws + WS_CTL, 0, CTL_ZERO_BYTES, stream);
    Args a{};
    for (int i = 0; i < 21; ++i) a.in[i] = (const float*)d_in[i];
    a.out = (float*)d_out; a.ws = (unsigned char*)d_ws;
#if MK_N_LAUNCHES == 1
    a.ph_lo = 0; a.ph_hi = N_PHASES; a.li = 0;
    hipLaunchKernelGGL(fwd_kernel, dim3(grid), dim3(NTHR), LDS_BYTES, stream, a);
#else
    { const int seq[] = {PROBE_SEQ};
      for (unsigned q = 0; q < sizeof(seq) / sizeof(seq[0]); ++q) { a.ph_lo = seq[q] & 15; a.ph_hi = (seq[q] & 15) + 1; a.li = 0; a.pad = seq[q] >> 4; hipLaunchKernelGGL(fwd_kernel, dim3(grid), dim3(NTHR), LDS_BYTES, stream, a); } }
#endif
}
```
